# Optimizing an MI355X kernel written in HIP

```python
import jax, jax.numpy as jnp
from jax import lax
import numpy as np

D_MODEL = 1024
BATCH = 8
SEQ = 4096
DEPTH = 2
DEC_BATCH = 32
DEC_SEQ = 1
PAST_LEN = 16384
PAGE_SIZE = 128

N_MIXERS = 2
N_HEADS = 16
HEAD_DIM = 64
N_KV_HEADS = 4
GQA_GROUP = N_HEADS // N_KV_HEADS
ROT_DIM = HEAD_DIM // 4
ROPE_THETA = 500000.0
IDX_HEADS = 8
IDX_DIM = 64
IDX_ROT = IDX_DIM // 4
TOPK_MAX = 256
Q_BLOCK = 128
POOL_WINDOWS = (2, 4, 8, 16)
POOL_GROUPS = len(POOL_WINDOWS)
POOL_CH = D_MODEL // POOL_GROUPS
POOL_BUF = max(POOL_WINDOWS) - 1
D_FF = 2816
LN_EPS = 1e-5
ALPHA = (2 * DEPTH) ** 0.25
BETA = (8 * DEPTH) ** -0.25
N_ATTN_LAYERS = (DEPTH + N_MIXERS - 1) // N_MIXERS
N_POOL_LAYERS = DEPTH // N_MIXERS
Q_COLS = N_HEADS * HEAD_DIM
KV_COLS = N_KV_HEADS * HEAD_DIM
QI_COLS = IDX_HEADS * IDX_DIM
D_IN_ATTN = Q_COLS + 2 * KV_COLS + QI_COLS + IDX_DIM + IDX_HEADS

kernel_name = "dsa_pool_macaron_deepnorm_step"


def _layernorm(x, g, b):
    xf = x.astype(jnp.float32)
    mu = jnp.mean(xf, axis=-1, keepdims=True)
    var = jnp.mean(jnp.square(xf - mu), axis=-1, keepdims=True)
    y = (xf - mu) * lax.rsqrt(var + LN_EPS) * g.astype(jnp.float32) + b.astype(jnp.float32)
    return y.astype(x.dtype)


def _swiglu(x, w_i, w_o):
    h = jnp.einsum('btd,df->btf', x, w_i)
    gate, up = h[..., :D_FF], h[..., D_FF:]
    return jnp.einsum('btf,fd->btd', jax.nn.silu(gate) * up, w_o)


def _rope(x, pos, rot):
    half = rot // 2
    freqs = ROPE_THETA ** (-jnp.arange(half, dtype=jnp.float32) / half)
    ang = pos[:, None] * freqs[None, :]
    cos = jnp.cos(ang)[None, :, None, :]
    sin = jnp.sin(ang)[None, :, None, :]
    xr = x[..., :rot].astype(jnp.float32)
    x1, x2 = xr[..., :half], xr[..., half:]
    r = jnp.concatenate([x1 * cos - x2 * sin, x2 * cos + x1 * sin], axis=-1).astype(x.dtype)
    return jnp.concatenate([r, x[..., rot:]], axis=-1)


def _attn_project(x, w_in, pos):
    B, T, _ = x.shape
    p = jnp.einsum('btd,de->bte', x, w_in)
    o1 = Q_COLS
    o2 = o1 + KV_COLS
    o3 = o2 + KV_COLS
    o4 = o3 + QI_COLS
    o5 = o4 + IDX_DIM
    q = _rope(p[..., :o1].reshape(B, T, N_HEADS, HEAD_DIM), pos, ROT_DIM)
    k = _rope(p[..., o1:o2].reshape(B, T, N_KV_HEADS, HEAD_DIM), pos, ROT_DIM)
    v = p[..., o2:o3].reshape(B, T, N_KV_HEADS, HEAD_DIM)
    qi = _rope(p[..., o3:o4].reshape(B, T, IDX_HEADS, IDX_DIM), pos, IDX_ROT)
    ki = _rope(p[..., o4:o5][:, :, None, :], pos, IDX_ROT)[:, :, 0, :]
    wi = p[..., o5:]
    return q, k, v, qi, ki, wi


def _indexer_select(qi, wi, ki, qpos, topk):
    s = jnp.einsum('bqhd,bsd->bqhs', qi.astype(jnp.float32), ki.astype(jnp.float32)) * (IDX_DIM ** -0.5)
    score = jnp.einsum('bqhs,bqh->bqs', jax.nn.relu(s), wi.astype(jnp.float32) * (IDX_HEADS ** -0.5))
    kpos = jnp.arange(ki.shape[1], dtype=jnp.int32)
    causal = kpos[None, :] <= qpos[:, None]
    score = jnp.where(causal[None], score, -jnp.inf)
    _, idx = lax.top_k(score, topk)
    valid = idx <= qpos[None, :, None]
    return idx, valid


def _sparse_attend(q, ks, vs, valid):
    B, Q, _, _ = q.shape
    qg = q.reshape(B, Q, N_KV_HEADS, GQA_GROUP, HEAD_DIM)
    s = jnp.einsum('bqhgd,bqnhd->bqhgn', qg, ks).astype(jnp.float32) * (HEAD_DIM ** -0.5)
    s = jnp.where(valid[:, :, None, None, :], s, -jnp.inf)
    p = jax.nn.softmax(s, axis=-1).astype(vs.dtype)
    o = jnp.einsum('bqhgn,bqnhd->bqhgd', p, vs)
    return o.reshape(B, Q, N_HEADS * HEAD_DIM)


def _dsa_prompt(x, w_in, w_o):
    B, S, _ = x.shape
    pos_i = jnp.arange(S, dtype=jnp.int32)
    q, k, v, qi, ki, wi = _attn_project(x, w_in, pos_i.astype(jnp.float32))
    topk = min(TOPK_MAX, S // 4)
    nb = S // Q_BLOCK
    bidx = jnp.arange(B)[:, None, None]

    def to_blocks(a):
        return jnp.moveaxis(a.reshape((B, nb, Q_BLOCK) + a.shape[2:]), 1, 0)

    def block(args):
        qb, qib, wib, pb = args
        idx, valid = _indexer_select(qib, wib, ki, pb, topk)
        return _sparse_attend(qb, k[bidx, idx], v[bidx, idx], valid)

    out = lax.map(block, (to_blocks(q), to_blocks(qi), to_blocks(wi), pos_i.reshape(nb, Q_BLOCK)))
    out = jnp.moveaxis(out, 0, 1).reshape(B, S, N_HEADS * HEAD_DIM)
    return jnp.einsum('bte,ed->btd', out, w_o), k, v, ki


def _dsa_sample(x, ck, cv, cki, page_table, w_in, w_o):
    B, T, _ = x.shape
    n_pages = page_table.shape[1]
    P = n_pages * PAGE_SIZE
    pos_i = P + jnp.arange(T, dtype=jnp.int32)
    q, k, v, qi, ki, wi = _attn_project(x, w_in, pos_i.astype(jnp.float32))
    ki_past = cki[page_table].reshape(B, P, IDX_DIM)
    ki_all = jnp.concatenate([ki_past, ki], axis=1)
    topk = min(TOPK_MAX, (P + T) // 4)
    idx, valid = _indexer_select(qi, wi, ki_all, pos_i, topk)
    in_past = idx < P
    pidx = jnp.minimum(idx, P - 1)
    phys = jnp.take_along_axis(page_table, (pidx // PAGE_SIZE).reshape(B, -1), axis=1).reshape(idx.shape)
    off = pidx % PAGE_SIZE
    bidx = jnp.arange(B)[:, None, None]
    nidx = jnp.clip(idx - P, 0, T - 1)
    sel = in_past[..., None, None]
    ks = jnp.where(sel, ck[phys, off], k[bidx, nidx])
    vs = jnp.where(sel, cv[phys, off], v[bidx, nidx])
    out = _sparse_attend(q, ks, vs, valid)
    return jnp.einsum('bte,ed->btd', out, w_o), k, v, ki


def _multiscale_pool(x_ext, n_prefix, w_pool, scale):
    B, L, D = x_ext.shape
    xf = x_ext.astype(jnp.float32)
    cs = jnp.concatenate([jnp.zeros((B, 1, D), jnp.float32), jnp.cumsum(xf, axis=1)], axis=1)
    i = jnp.arange(n_prefix, L)
    diffs = []
    for g, w in enumerate(POOL_WINDOWS):
        sl = slice(g * POOL_CH, (g + 1) * POOL_CH)
        cs_g = cs[..., sl]
        lo = jnp.maximum(i + 1 - w, 0)
        cnt = (i + 1 - lo).astype(jnp.float32)
        mean = (cs_g[:, i + 1] - cs_g[:, lo]) / cnt[None, :, None]
        diffs.append(mean - xf[:, n_prefix:, sl])
    d = jnp.stack(diffs, axis=2).astype(x_ext.dtype)
    out = jnp.einsum('btgc,gce->btge', d, w_pool).reshape(B, L - n_prefix, D)
    return out * scale


def setup_inputs(seed: int = 0) -> dict:
    key = jax.random.key(seed)
    ks = jax.random.split(key, 20)
    f32 = jnp.float32
    n_pages = PAST_LEN // PAGE_SIZE
    n_used = DEC_BATCH * n_pages
    n_phys = n_used + n_used // 4
    page_table = jax.random.permutation(ks[0], n_phys)[:n_used].reshape(DEC_BATCH, n_pages).astype(jnp.int32)
    return {
        "x_prompt": jax.random.normal(ks[1], (BATCH, SEQ, D_MODEL), f32),
        "x_sample": jax.random.normal(ks[2], (DEC_BATCH, DEC_SEQ, D_MODEL), f32),
        "cache_k": jax.random.normal(ks[3], (N_ATTN_LAYERS, n_phys, PAGE_SIZE, N_KV_HEADS, HEAD_DIM), f32),
        "cache_v": jax.random.normal(ks[4], (N_ATTN_LAYERS, n_phys, PAGE_SIZE, N_KV_HEADS, HEAD_DIM), f32),
        "cache_kidx": jax.random.normal(ks[5], (N_ATTN_LAYERS, n_phys, PAGE_SIZE, IDX_DIM), f32),
        "state_pool": jax.random.normal(ks[6], (N_POOL_LAYERS, DEC_BATCH, POOL_BUF, D_MODEL), f32),
        "page_table": page_table,
        "ln_g": 1.0 + 0.02 * jax.random.normal(ks[7], (DEPTH, 3, D_MODEL), f32),
        "ln_b": 0.02 * jax.random.normal(ks[8], (DEPTH, 3, D_MODEL), f32),
        "ffn1_wi": jax.random.normal(ks[9], (DEPTH, D_MODEL, 2 * D_FF), f32) * D_MODEL ** -0.5,
        "ffn1_wo": jax.random.normal(ks[10], (DEPTH, D_FF, D_MODEL), f32) * (D_FF ** -0.5 * BETA),
        "ffn2_wi": jax.random.normal(ks[11], (DEPTH, D_MODEL, 2 * D_FF), f32) * D_MODEL ** -0.5,
        "ffn2_wo": jax.random.normal(ks[12], (DEPTH, D_FF, D_MODEL), f32) * (D_FF ** -0.5 * BETA),
        "attn_w_in": jax.random.normal(ks[13], (N_ATTN_LAYERS, D_MODEL, D_IN_ATTN), f32) * D_MODEL ** -0.5,
        "attn_w_o": jax.random.normal(ks[14], (N_ATTN_LAYERS, Q_COLS, D_MODEL), f32) * (Q_COLS ** -0.5 * BETA),
        "pool_w": jax.random.normal(ks[15], (N_POOL_LAYERS, POOL_GROUPS, POOL_CH, POOL_CH), f32) * (POOL_CH ** -0.5 * BETA),
        "pool_scale": 1.0 + 0.02 * jax.random.normal(ks[16], (N_POOL_LAYERS, D_MODEL), f32),
    }


def reference(x_prompt, x_sample, cache_k, cache_v, cache_kidx, state_pool, page_table,
              ln_g, ln_b, ffn1_wi, ffn1_wo, ffn2_wi, ffn2_wo,
              attn_w_in, attn_w_o, pool_w, pool_scale):
    yp, ys = x_prompt, x_sample
    kp_l, vp_l, kip_l, poolp_l = [], [], [], []
    ks_l, vs_l, kis_l, pools_l = [], [], [], []
    for l in range(DEPTH):
        j = l // N_MIXERS
        yp = _layernorm(ALPHA * yp + 0.5 * _swiglu(yp, ffn1_wi[l], ffn1_wo[l]), ln_g[l, 0], ln_b[l, 0])
        ys = _layernorm(ALPHA * ys + 0.5 * _swiglu(ys, ffn1_wi[l], ffn1_wo[l]), ln_g[l, 0], ln_b[l, 0])
        if l % N_MIXERS == 0:
            mp, kp, vp, kip = _dsa_prompt(yp, attn_w_in[j], attn_w_o[j])
            ms, kn, vn, kin = _dsa_sample(ys, cache_k[j], cache_v[j], cache_kidx[j], page_table,
                                          attn_w_in[j], attn_w_o[j])
            kp_l.append(kp); vp_l.append(vp); kip_l.append(kip)
            ks_l.append(kn); vs_l.append(vn); kis_l.append(kin)
        else:
            mp = _multiscale_pool(yp, 0, pool_w[j], pool_scale[j])
            poolp_l.append(yp[:, yp.shape[1] - POOL_BUF:])
            ext = jnp.concatenate([state_pool[j], ys], axis=1)
            ms = _multiscale_pool(ext, POOL_BUF, pool_w[j], pool_scale[j])
            pools_l.append(ext[:, ext.shape[1] - POOL_BUF:])
        yp = _layernorm(ALPHA * yp + mp, ln_g[l, 1], ln_b[l, 1])
        ys = _layernorm(ALPHA * ys + ms, ln_g[l, 1], ln_b[l, 1])
        yp = _layernorm(ALPHA * yp + 0.5 * _swiglu(yp, ffn2_wi[l], ffn2_wo[l]), ln_g[l, 2], ln_b[l, 2])
        ys = _layernorm(ALPHA * ys + 0.5 * _swiglu(ys, ffn2_wi[l], ffn2_wo[l]), ln_g[l, 2], ln_b[l, 2])
    return (yp, ys,
            jnp.stack(kp_l), jnp.stack(vp_l), jnp.stack(kip_l), jnp.stack(poolp_l),
            jnp.stack(ks_l), jnp.stack(vs_l), jnp.stack(kis_l), jnp.stack(pools_l))
```

```cpp
#include <hip/hip_runtime.h>
#include <cstdio>
#include <cstdint>
#include <cmath>
namespace pg8 {
#define PG8_LAS __attribute__((address_space(3)))
typedef unsigned short bf16_t;
typedef short bf16x8 __attribute__((ext_vector_type(8)));
typedef float f32x4 __attribute__((ext_vector_type(4)));
typedef unsigned u32x4 __attribute__((ext_vector_type(4)));
constexpr int BM = 256, BK = 64, HALF = 128, HTB = HALF * BK * 2  , STAGE_BYTES = 8 * HTB, NXCD = 8, WGM = 8;

__host__ __device__ __forceinline__ int lds_byte(int r, int c) { const int st = (r >> 4) * 2 + (c >> 5), rr = r & 15, cc = c & 31, ob = rr * 64 + cc * 2; return st * 1024 + (ob ^ (((ob >> 9) & 1) << 5)); }
__host__ __device__ __forceinline__ void stage_rc(int b, int& R, int& C) { const int st = b / 1024, sb = b % 1024, swz = sb ^ (((sb >> 9) & 1) << 5); R = (st >> 1) * 16 + swz / 64; C = (st & 1) * 32 + (swz % 64) / 2; }
__host__ __device__ __forceinline__ int perm32(int rho) { const int n = rho >> 4, i = rho & 15; return 8 * (i >> 2) + 4 * n + (i & 3); }

struct Unit { int pm, pn; };
struct Gemm { const bf16_t* A; const bf16_t* Bt; int lda, ldb, K, a_pn_step; };

struct StaticOrder {
    int nM, nN, nwg, G, c;
    __host__ __device__ void init(int M, int N, int G_, int c_) { nM = M / BM; nN = N / BM; nwg = nM * nN; G = G_; c = c_; }
    __host__ __device__ bool next(int i, Unit& u) const {
        const long L = (long)i * G + c; if (L >= nwg) return false;
        int wgid = (int)L; { const int q = nwg / NXCD, r = nwg % NXCD, xcd = wgid % NXCD, off = wgid / NXCD; wgid = (xcd < r ? xcd * (q + 1) : r * (q + 1) + (xcd - r) * q) + off; }
        const int nig = WGM * nN, gid = wgid / nig, fm = gid * WGM, gsz = (nM - fm) < WGM ? (nM - fm) : WGM;
        u.pm = fm + ((wgid % nig) % gsz); u.pn = (wgid % nig) / gsz; return true;
    }
    __device__ __forceinline__ void a_ready(const Unit&) const {}
    __device__ __forceinline__ void done(const Unit&) const {}
};
__device__ __forceinline__ unsigned cvt_pk_bf16(float lo, float hi) { unsigned r; asm volatile("v_cvt_pk_bf16_f32 %0, %1, %2" : "=v"(r) : "v"(lo), "v"(hi)); return r; }
template <class Epi, class Sched, bool ALIGN_EPI = false, bool SP2 = false>
__device__ __forceinline__ void gemm_phase(PG8_LAS unsigned char* lds, const Gemm g, const Sched& S, const Epi& E, int tid_in) {
    int tid_l = tid_in; asm volatile("" : "+v"(tid_l));
    const int tid = tid_l, wid = __builtin_amdgcn_readfirstlane(tid >> 6), lane = tid & 63, wr = wid >> 2, wc = wid & 3, fr = lane & 15, fq = lane >> 4;
    const int K = g.K, nt = K / BK;
    unsigned voffA[2], voffB[2];
#pragma unroll
    for (int i = 0; i < 2; ++i) { int R, C; stage_rc(tid * 16 + i * 8192, R, C); const int Rb = Epi::PERM ? ((R & ~31) + perm32(R & 31)) : R;
        voffA[i] = (unsigned)(R * g.lda + C) * 2u; voffB[i] = (unsigned)(Rb * g.ldb + C) * 2u; }
    const size_t kstep = (size_t)(BK * 2);
    const size_t hstepA = (size_t)HALF * g.lda * 2, hstepB = (size_t)HALF * g.ldb * 2;
    const size_t tstepA = 2 * hstepA, tstepB = 2 * hstepB;
    const unsigned ldsw = (unsigned)wid * 1024u;
    const int aoff = lds_byte(wr * 64 + fr, fq * 8), boff = lds_byte(wc * 32 + fr, fq * 8);
#define PG8_SA(b, h) (((b) * 2 + (h)) * HTB)
#define PG8_SB(b, h) ((4 + (b) * 2 + (h)) * HTB)
#define PG8_STAGE(bufoff, gbase, voff) do { _Pragma("unroll") for (int _i = 0; _i < 2; ++_i) \
        __builtin_amdgcn_global_load_lds((const unsigned*)((const char*)(gbase) + (voff)[_i]), (PG8_LAS unsigned*)(lds + (bufoff) + ldsw + _i * 8192), 16, 0, 0); } while (0)
#define PG8_LDA(dst, b, h) do { _Pragma("unroll") for (int m = 0; m < 4; ++m) _Pragma("unroll") for (int k = 0; k < 2; ++k) dst[m][k] = *(const PG8_LAS bf16x8*)(lds + PG8_SA(b, h) + aoff + m * 2048 + k * 1024); } while (0)
#define PG8_LDB(dst, b, h) do { _Pragma("unroll") for (int n = 0; n < 2; ++n) _Pragma("unroll") for (int k = 0; k < 2; ++k) dst[n][k] = *(const PG8_LAS bf16x8*)(lds + PG8_SB(b, h) + boff + n * 2048 + k * 1024); } while (0)
#define PG8_MMA(ai, bj, At, Bt) do { __builtin_amdgcn_s_setprio(1); _Pragma("unroll") for (int m = 0; m < 4; ++m) _Pragma("unroll") for (int n = 0; n < 2; ++n) _Pragma("unroll") for (int k = 0; k < 2; ++k) \
        acc[ai][bj][m][n] = __builtin_amdgcn_mfma_f32_16x16x32_bf16(Bt[n][k], At[m][k], acc[ai][bj][m][n], 0, 0, 0); __builtin_amdgcn_s_setprio(0); } while (0)
#define PG8_WAIT_V(n) asm volatile("s_waitcnt vmcnt(" #n ")" ::: "memory")
#define PG8_WAIT_L(n) asm volatile("s_waitcnt lgkmcnt(" #n ")" ::: "memory")
#define PG8_BAR __builtin_amdgcn_s_barrier()
#define PG8_SCHED __builtin_amdgcn_sched_barrier(0)
    Unit cur, nxt; int ui = 0;
    if (!S.next(0, cur)) return;
    f32x4 acc[2][2][4][2];
#pragma unroll
    for (int a = 0; a < 2; ++a)
#pragma unroll
        for (int b = 0; b < 2; ++b)
#pragma unroll
            for (int m = 0; m < 4; ++m)
#pragma unroll
                for (int n = 0; n < 2; ++n) acc[a][b][m][n] = (f32x4){0.f, 0.f, 0.f, 0.f};
    bf16x8 At[4][2], B0[2][2], B1[2][2];
    const char* cA = (const char*)g.A + (size_t)cur.pm * tstepA + (size_t)cur.pn * g.a_pn_step; const char* cB = (const char*)g.Bt + (size_t)cur.pn * tstepB;
    S.a_ready(cur);
    if constexpr (SP2) {
        PG8_STAGE(PG8_SB(0, 0), cB, voffB); PG8_STAGE(PG8_SB(0, 1), cB + hstepB, voffB); PG8_STAGE(PG8_SA(0, 0), cA, voffA); PG8_STAGE(PG8_SA(0, 1), cA + hstepA, voffA);
        if (wr == 1) PG8_BAR;
        PG8_WAIT_V(2); PG8_BAR;
        PG8_STAGE(PG8_SB(1, 0), cB + kstep, voffB); PG8_STAGE(PG8_SA(1, 0), cA + kstep, voffA); PG8_STAGE(PG8_SB(1, 1), cB + hstepB + kstep, voffB);
        PG8_WAIT_V(6); PG8_BAR;
    } else {
        PG8_STAGE(PG8_SB(0, 0), cB, voffB); PG8_STAGE(PG8_SA(0, 0), cA, voffA); PG8_STAGE(PG8_SB(0, 1), cB + hstepB, voffB); PG8_STAGE(PG8_SA(0, 1), cA + hstepA, voffA);
        if (wr == 1) PG8_BAR;
        PG8_WAIT_V(4); PG8_BAR;
        PG8_STAGE(PG8_SB(1, 0), cB + kstep, voffB); PG8_STAGE(PG8_SA(1, 0), cA + kstep, voffA); PG8_STAGE(PG8_SB(1, 1), cB + hstepB + kstep, voffB);
        PG8_WAIT_V(6); PG8_BAR;
    }
    for (;;) {
        const bool has_next = S.next(ui + 1, nxt);
        const char* nA = has_next ? (const char*)g.A + (size_t)nxt.pm * tstepA + (size_t)nxt.pn * g.a_pn_step : cA; const char* nB = has_next ? (const char*)g.Bt + (size_t)nxt.pn * tstepB : cB;
        for (int t = 0; t < nt; t += 2) {
            const bool last = (t == nt - 2);
            const char* a1 = cA + (size_t)(t + 1) * kstep;
            const char* a2 = last ? nA : cA + (size_t)(t + 2) * kstep; const char* b2 = last ? nB : cB + (size_t)(t + 2) * kstep;
            const char* a3 = a2 + kstep; const char* b3 = b2 + kstep;
            if (last && has_next) S.a_ready(nxt);
            if constexpr (SP2) {
            PG8_LDB(B0, 0, 0); PG8_LDB(B1, 0, 1); PG8_SCHED; PG8_LDA(At, 0, 0); PG8_STAGE(PG8_SA(1, 1), a1 + hstepA, voffA);
            PG8_WAIT_V(8); PG8_WAIT_L(0); PG8_BAR; PG8_MMA(0, 0, At, B0); PG8_MMA(0, 1, At, B1); PG8_BAR; PG8_SCHED;
            PG8_LDA(At, 0, 1); PG8_STAGE(PG8_SB(0, 0), b2, voffB); PG8_STAGE(PG8_SB(0, 1), b2 + hstepB, voffB); PG8_STAGE(PG8_SA(0, 0), a2, voffA);
            PG8_WAIT_V(8); PG8_WAIT_L(0); PG8_BAR; PG8_MMA(1, 0, At, B0); PG8_MMA(1, 1, At, B1); PG8_BAR; PG8_SCHED;
            PG8_LDB(B0, 1, 0); PG8_LDB(B1, 1, 1); PG8_SCHED; PG8_LDA(At, 1, 0); PG8_STAGE(PG8_SA(0, 1), a2 + hstepA, voffA);
            PG8_WAIT_V(8); PG8_WAIT_L(0); PG8_BAR; PG8_MMA(0, 0, At, B0); PG8_MMA(0, 1, At, B1); PG8_BAR; PG8_SCHED;
            PG8_LDA(At, 1, 1); PG8_STAGE(PG8_SB(1, 0), b3, voffB); PG8_STAGE(PG8_SB(1, 1), b3 + hstepB, voffB); PG8_STAGE(PG8_SA(1, 0), a3, voffA);
            PG8_WAIT_V(8); PG8_WAIT_L(0); PG8_BAR; PG8_MMA(1, 0, At, B0); PG8_MMA(1, 1, At, B1); PG8_BAR; PG8_SCHED;
            } else {
            PG8_LDB(B0, 0, 0); PG8_SCHED; PG8_LDA(At, 0, 0); PG8_STAGE(PG8_SA(1, 1), a1 + hstepA, voffA);
            PG8_WAIT_L(8); PG8_BAR; PG8_WAIT_L(0); PG8_MMA(0, 0, At, B0); PG8_BAR; PG8_SCHED;
            PG8_LDB(B1, 0, 1); PG8_STAGE(PG8_SB(0, 0), b2, voffB);
            PG8_BAR; PG8_WAIT_L(0); PG8_MMA(0, 1, At, B1); PG8_BAR;
            PG8_LDA(At, 0, 1); PG8_STAGE(PG8_SA(0, 0), a2, voffA);
            PG8_BAR; PG8_WAIT_L(0); PG8_MMA(1, 0, At, B0); PG8_BAR; PG8_SCHED;
            PG8_STAGE(PG8_SB(0, 1), b2 + hstepB, voffB);
            PG8_WAIT_V(6); PG8_BAR; PG8_MMA(1, 1, At, B1); PG8_BAR;
            PG8_LDB(B0, 1, 0); PG8_SCHED; PG8_LDA(At, 1, 0); PG8_STAGE(PG8_SA(0, 1), a2 + hstepA, voffA);
            PG8_WAIT_L(8); PG8_BAR; PG8_WAIT_L(0); PG8_MMA(0, 0, At, B0); PG8_BAR; PG8_SCHED;
            PG8_LDB(B1, 1, 1); PG8_STAGE(PG8_SB(1, 0), b3, voffB);
            PG8_BAR; PG8_WAIT_L(0); PG8_MMA(0, 1, At, B1); PG8_BAR;
            PG8_LDA(At, 1, 1); PG8_STAGE(PG8_SA(1, 0), a3, voffA);
            PG8_BAR; PG8_WAIT_L(0); PG8_MMA(1, 0, At, B0); PG8_BAR; PG8_SCHED;
            PG8_STAGE(PG8_SB(1, 1), b3 + hstepB, voffB);
            PG8_WAIT_V(6); PG8_BAR; PG8_MMA(1, 1, At, B1); PG8_BAR;
            }
        }
        if constexpr (ALIGN_EPI) { if (wr == 0) PG8_BAR; }
        if constexpr (!Epi::AFTER_DRAIN) { int l2_; asm volatile("v_mbcnt_lo_u32_b32 %0, -1, 0\n\tv_mbcnt_hi_u32_b32 %0, -1, %0" : "=v"(l2_)); E(acc, cur, wr, wc, l2_ & 15, l2_ >> 4); S.done(cur); }
        if (!has_next) break;
#pragma unroll
        for (int a = 0; a < 2; ++a)
#pragma unroll
            for (int b = 0; b < 2; ++b)
#pragma unroll
                for (int m = 0; m < 4; ++m)
#pragma unroll
                    for (int n = 0; n < 2; ++n) acc[a][b][m][n] = (f32x4){0.f, 0.f, 0.f, 0.f};
        cur = nxt; cA = nA; cB = nB; ++ui;
        if constexpr (ALIGN_EPI) { if (wr == 1) PG8_BAR; }
    }
    PG8_WAIT_V(0);
    if constexpr (!ALIGN_EPI) { if (wr == 0) PG8_BAR; }
    PG8_BAR;
    if constexpr (Epi::AFTER_DRAIN) { E.fused(acc, cur, wr, wc, fr, fq, lds, wid, lane); S.done(cur); }
#undef PG8_SA
#undef PG8_SB
#undef PG8_STAGE
#undef PG8_LDA
#undef PG8_LDB
#undef PG8_MMA
#undef PG8_WAIT_V
#undef PG8_WAIT_L
#undef PG8_BAR
#undef PG8_SCHED
}
}

constexpr int D = 1024, BATCH = 8, SEQ = 4096, M = BATCH * SEQ, SBT = 32;
constexpr int FF = 2816, NWI = 2 * FF;
constexpr int NKV = 4, KVW = 256;
constexpr int NPROJ = 2120, NPROJP = 2304;
constexpr int PAST = 16384, PAGE = 128, NPAGES = 128;
constexpr int NKEYS_S = PAST + 1, SCLD = 16448;
constexpr int TOPK = 256;
constexpr float LN_EPS = 1e-5f;
constexpr float ALPHA = 1.4142135623730951f;
constexpr float QSCALE = 0.125f * 1.4426950408889634f;
constexpr float WSCALE = 0.125f * 0.35355339059327373f;

constexpr size_t O_YP = 0, O_YS = 33554432, O_KP = 33587200, O_VP = 41975808, O_KIP = 50364416, O_PP = 52461568,
                 O_KS = 52584448, O_VS = 52592640, O_KIS = 52600832, O_PS = 52602880, O_END = 53094400;

constexpr size_t MiB = 1u << 20;
constexpr size_t WS_CTL = 0, CTL_ZERO_BYTES = 1 * MiB;
constexpr size_t WS_WI = 2 * MiB;
constexpr size_t WI_STRIDE = 11 * MiB;
constexpr size_t WS_WO = 46 * MiB;
constexpr size_t WO_STRIDE = (size_t)D * FF * 2;
constexpr size_t WS_WIN = 68 * MiB;
constexpr size_t WS_WOA = 73 * MiB;
constexpr size_t WS_WPOOL = 75 * MiB;
constexpr size_t WS_ROPE = 76 * MiB;
constexpr size_t WS_XB = 80 * MiB;
constexpr size_t WS_XA = 144 * MiB;
constexpr size_t WS_PRE = 272 * MiB;
constexpr size_t WS_G = 400 * MiB;
constexpr size_t WS_QB = 576 * MiB;
constexpr size_t WS_OB = 640 * MiB;
constexpr size_t WS_KB = 704 * MiB;
constexpr size_t WS_VB = 720 * MiB;
constexpr size_t WS_QIB = 736 * MiB;
constexpr size_t WS_KIB = 768 * MiB;
constexpr size_t WS_WIF = 772 * MiB;
constexpr size_t WS_MASK = 776 * MiB;
constexpr size_t WS_LIST = 792 * MiB;
constexpr size_t WS_DB = 808 * MiB;
constexpr size_t WS_S = 880 * MiB;
constexpr size_t S_XS = 0, S_PRES = 131072, S_XSB = 262144, S_GS = 327680, S_QS = 524288, S_QIS = 655360, S_WIS = 720896,
                 S_OS = 786432, S_DS = 851968, S_SC = 1048576;
constexpr size_t WS_END = 884 * MiB;

constexpr int CW_BAR = 4096;

constexpr int RING_OFF = 0, RING_BYTES = 131072;
constexpr int MISC_OFF = RING_BYTES;
constexpr int LDS_BYTES = 147456;
constexpr int NWAVES = 8, NTHREADS = 512;

#define GAS __attribute__((address_space(1)))
#define LAS __attribute__((address_space(3)))
typedef unsigned short bf16;
typedef unsigned v4u __attribute__((ext_vector_type(4)));
typedef unsigned v2u __attribute__((ext_vector_type(2)));
typedef float f32x4 __attribute__((ext_vector_type(4)));
typedef float f32x2 __attribute__((ext_vector_type(2)));
typedef float f32x16 __attribute__((ext_vector_type(16)));
typedef short bf16x8 __attribute__((ext_vector_type(8)));
#define LDS_WAIT() asm volatile("s_waitcnt lgkmcnt(0)" ::: "memory")
#define VM_WAIT() asm volatile("s_waitcnt vmcnt(0)" ::: "memory")
__device__ __forceinline__ unsigned f2bf(float f) { unsigned u = __builtin_bit_cast(unsigned, f); return (u + 0x7fffu + ((u >> 16) & 1u)) >> 16; }
__device__ __forceinline__ unsigned pk2(float lo, float hi) { return f2bf(lo) | (f2bf(hi) << 16); }
__device__ __forceinline__ float bf2f(unsigned short b) { return __builtin_bit_cast(float, (unsigned)b << 16); }
__device__ __forceinline__ float wave_sum(float v) {
#pragma unroll
    for (int o = 1; o < 64; o <<= 1) v += __shfl_xor(v, o);
    return v;
}
__device__ __forceinline__ float wave_max(float v) {
#pragma unroll
    for (int o = 1; o < 64; o <<= 1) v = fmaxf(v, __shfl_xor(v, o));
    return v;
}
__device__ __forceinline__ float wave_min(float v) {
#pragma unroll
    for (int o = 1; o < 64; o <<= 1) v = fminf(v, __shfl_xor(v, o));
    return v;
}
__device__ __forceinline__ float silu_f(float x) { return x * __builtin_amdgcn_rcpf(1.0f + __builtin_amdgcn_exp2f(-1.4426950408889634f * x)); }
__device__ __forceinline__ int mbcnt64(unsigned long long m) { return (int)__builtin_amdgcn_mbcnt_hi((unsigned)(m >> 32), __builtin_amdgcn_mbcnt_lo((unsigned)m, 0u)); }

namespace pg8 {
struct EpiSwiglu {
    static constexpr bool PERM = true, AFTER_DRAIN = false;
    bf16_t* G;
    __device__ __forceinline__ void operator()(const f32x4 (&acc)[2][2][4][2], const Unit& u, int wr, int wc, int fr, int fq) const {
        const int row0 = u.pm * BM + wr * 64 + fr; const int col0 = u.pn * HALF + wc * 32 + 8 * fq;
#pragma unroll
        for (int ai = 0; ai < 2; ++ai)
#pragma unroll
            for (int m = 0; m < 4; ++m) {
                bf16_t* rowp = G + (size_t)(row0 + ai * HALF + m * 16) * FF + col0;
                const f32x4 g0 = acc[ai][0][m][0], g1 = acc[ai][0][m][1], u0 = acc[ai][1][m][0], u1 = acc[ai][1][m][1];
                u32x4 w;
                w.x = cvt_pk_bf16(silu_f(g0[0]) * u0[0], silu_f(g0[1]) * u0[1]); w.y = cvt_pk_bf16(silu_f(g0[2]) * u0[2], silu_f(g0[3]) * u0[3]);
                w.z = cvt_pk_bf16(silu_f(g1[0]) * u1[0], silu_f(g1[1]) * u1[1]); w.w = cvt_pk_bf16(silu_f(g1[2]) * u1[2], silu_f(g1[3]) * u1[3]);
                *(u32x4*)rowp = w;
            }
    }
};
template <bool HAS_CS> struct EpiResid {
    static constexpr bool PERM = false, AFTER_DRAIN = false;
    const float* X; float* P; float s; const float* cs;
    __device__ __forceinline__ void operator()(const f32x4 (&acc)[2][2][4][2], const Unit& u, int wr, int wc, int fr, int fq) const {
        const int row0 = u.pm * BM + wr * 64 + fr; const int col0 = u.pn * BM + wc * 32 + 4 * fq;
        f32x4 sc[2][2];
        if (HAS_CS) {
#pragma unroll
            for (int bj = 0; bj < 2; ++bj)
#pragma unroll
                for (int n = 0; n < 2; ++n) sc[bj][n] = *(const f32x4*)(cs + col0 + bj * HALF + n * 16) * s;
        }
#pragma unroll
        for (int ai = 0; ai < 2; ++ai)
#pragma unroll
            for (int m = 0; m < 4; ++m) {
                const size_t off = (size_t)(row0 + ai * HALF + m * 16) * D + col0;
                const float* xp = X + off; float* pp = P + off;
#pragma unroll
                for (int bj = 0; bj < 2; ++bj)
#pragma unroll
                    for (int n = 0; n < 2; ++n) {
                        const f32x4 x = *(const f32x4*)(xp + bj * HALF + n * 16);
                        if (HAS_CS) *(f32x4*)(pp + bj * HALF + n * 16) = x * ALPHA + acc[ai][bj][m][n] * sc[bj][n];
                        else *(f32x4*)(pp + bj * HALF + n * 16) = x * ALPHA + acc[ai][bj][m][n] * s;
                    }
                asm volatile("" ::: "memory");
            }
    }
};
struct EpiProj {
    static constexpr bool PERM = false, AFTER_DRAIN = false;
    unsigned char* wsb; float* outb;
    __device__ __forceinline__ void operator()(const f32x4 (&acc)[2][2][4][2], const Unit& u, int wr, int wc, int fr, int fq) const {
        const int pn = u.pn;
        const int row0 = u.pm * BM + wr * 64 + fr;
        const bool rot_tile = (pn != 5) && ((wc & 1) == 0) && (pn < 8 || wc == 0);
        const f32x2* rope = (const f32x2*)(wsb + WS_ROPE);
        const float sg = (fq < 2) ? -1.f : 1.f;
        size_t bf_off, f_off = 0; int ldb_, ldf_ = 0, colmax = 256; float scl = 1.f; bool hasf = false;
        if (pn < 4)       { bf_off = WS_QB + (size_t)pn * BM * 2; ldb_ = D; scl = QSCALE; }
        else if (pn == 4) { bf_off = WS_KB; ldb_ = KVW; f_off = O_KP; ldf_ = KVW; hasf = true; }
        else if (pn == 5) { bf_off = WS_VB; ldb_ = KVW; f_off = O_VP; ldf_ = KVW; hasf = true; }
        else if (pn < 8)  { bf_off = WS_QIB + (size_t)(pn - 6) * BM * 2; ldb_ = 512; }
        else              { bf_off = WS_KIB; ldb_ = 64; f_off = O_KIP; ldf_ = 64; hasf = true; colmax = 64; }
        bf16_t* bfb = (bf16_t*)(wsb + bf_off); float* fb = outb + f_off;
#pragma unroll
        for (int ai = 0; ai < 2; ++ai)
#pragma unroll
            for (int m = 0; m < 4; ++m) {
                const int row = row0 + ai * HALF + m * 16; const int pos = row & (SEQ - 1);
#pragma unroll
                for (int bj = 0; bj < 2; ++bj)
#pragma unroll
                    for (int n = 0; n < 2; ++n) {
                        f32x4 v = acc[ai][bj][m][n];
                        const int cit = bj * HALF + wc * 32 + n * 16 + 4 * fq;
                        if (n == 0 && rot_tile && (pn < 8 || bj == 0)) {
                            const f32x2* rp = rope + pos * 8 + 4 * (fq & 1);
#pragma unroll
                            for (int j = 0; j < 4; ++j) {
                                const auto rr = __builtin_amdgcn_permlane32_swap(__float_as_uint(v[j]), __float_as_uint(v[j]), false, false);
                                const float p = __uint_as_float((fq < 2) ? rr[1] : rr[0]);
                                const f32x2 cs = rp[j];
                                v[j] = v[j] * cs.x + sg * p * cs.y;
                            }
                        }
                        if (cit < colmax) {
                            if (hasf) *(f32x4*)(fb + (size_t)row * ldf_ + cit) = v;
                            v = v * scl; v2u w; w.x = cvt_pk_bf16(v[0], v[1]); w.y = cvt_pk_bf16(v[2], v[3]);
                            *(v2u*)(bfb + (size_t)row * ldb_ + cit) = w;
                        } else if (cit < 72) {
                            *(f32x4*)((float*)(wsb + WS_WIF) + (size_t)row * 8 + (cit - 64)) = v;
                        }
                    }
                asm volatile("" ::: "memory");
            }
    }
};
}

#define XB_TMO      128
#define XB_XCNT(j)  (256  + 64 * (j))
#define XB_XSUB(j)  (1280 + 64 * (j))
#define XB_XGEN(j)  (2304 + 64 * (j))
#define XB_TOP      3328
#define XB_TOPGEN   3392
#define XCD_BAR_WORDS 3456
#define XB_SPIN_CAP (1u << 18)
__device__ __forceinline__ unsigned xb_ld(unsigned* p)              { return __hip_atomic_load(p, __ATOMIC_RELAXED, __HIP_MEMORY_SCOPE_AGENT); }
__device__ __forceinline__ unsigned xb_add(unsigned* p, unsigned v) { return __hip_atomic_fetch_add(p, v, __ATOMIC_RELAXED, __HIP_MEMORY_SCOPE_AGENT); }
__device__ __forceinline__ unsigned xb_xcc_id() { return (unsigned)__builtin_amdgcn_s_getreg((3 << 11) | 20) & 0xFu; }
#define XB_SPIN(cond, bar) do { unsigned _sp = 0; while (cond) { __builtin_amdgcn_s_sleep(1); \
    if ((++_sp & 255u) == 0u) { if (xb_ld(&(bar)[XB_TMO])) break; if (_sp > XB_SPIN_CAP) { atomicAdd(&(bar)[XB_TMO], 1u); break; } } } } while (0)
struct XcdBarrier { unsigned* bar; unsigned x; volatile LAS unsigned* st; };
__device__ __forceinline__ XcdBarrier xcd_barrier_post(unsigned* bar, volatile LAS unsigned* st, int tid) {
    XcdBarrier b; b.bar = bar; b.x = xb_xcc_id(); b.st = st;
    if (tid == 0) (void)xb_add(&bar[XB_XCNT(b.x)], 1u);
    return b;
}
__device__ __forceinline__ void xcd_barrier_complete(unsigned* bar, unsigned x, unsigned& nloc, unsigned& nx) {
    const unsigned G = gridDim.x * gridDim.y * gridDim.z;
    unsigned sum, cnt, mine, sp = 0u;
    for (;;) {
        sum = 0u; cnt = 0u; mine = 0u;
#pragma unroll
        for (unsigned j = 0; j < 16; ++j) { const unsigned c = xb_ld(&bar[XB_XCNT(j)]); sum += c; cnt += (c > 0u) ? 1u : 0u; mine = (j == x) ? c : mine; }
        if (sum == G) break;
        __builtin_amdgcn_s_sleep(1);
        if ((++sp & 255u) == 0u) { if (xb_ld(&bar[XB_TMO])) break; if (sp > XB_SPIN_CAP) { atomicAdd(&bar[XB_TMO], 1u); break; } }
    }
    nloc = mine > 0u ? mine : 1u; nx = cnt > 0u ? cnt : 1u;
}
__device__ __forceinline__ void xcd_barrier(const XcdBarrier& b, int tid) {
    asm volatile("s_waitcnt vmcnt(0)" ::: "memory");
    __syncthreads();
    if (tid == 0) {
        unsigned* bar = b.bar;
        __builtin_amdgcn_s_waitcnt(0);
        unsigned nloc = b.st[0], nx = b.st[1];
        if (nloc == 0u) { xcd_barrier_complete(bar, b.x, nloc, nx); b.st[0] = nloc; b.st[1] = nx; }
        const unsigned old = xb_add(&bar[XB_XSUB(b.x)], 1u);
        const unsigned gen = old / nloc;
        if (old + 1u == (gen + 1u) * nloc) {
            __builtin_amdgcn_fence(__ATOMIC_RELEASE, "agent");
            asm volatile("s_waitcnt vmcnt(0)" ::: "memory");
            const unsigned og = xb_add(&bar[XB_TOP], 1u);
            const unsigned tg = og / nx;
            if (og + 1u == (tg + 1u) * nx) xb_add(&bar[XB_TOPGEN], 1u);
            else XB_SPIN(xb_ld(&bar[XB_TOPGEN]) == tg, bar);
            __builtin_amdgcn_fence(__ATOMIC_ACQUIRE, "agent");
            xb_add(&bar[XB_XGEN(b.x)], 1u);
            asm volatile("s_waitcnt vmcnt(0)" ::: "memory");
        } else {
            XB_SPIN(xb_ld(&bar[XB_XGEN(b.x)]) == gen, bar);
            __builtin_amdgcn_fence(__ATOMIC_ACQUIRE, "agent");
            asm volatile("s_waitcnt vmcnt(0)" ::: "memory");
        }
    }
    __syncthreads();
}

__device__ __forceinline__ void tr_item(const float* W, int ldw, int k0, int c0, int ncv, bf16* WT, int ldt, int r0, LAS float* scr, int lane) {
#pragma unroll 8
    for (int i = 0; i < 32; ++i) { const int kk = 2 * i + (lane >> 5), c = lane & 31; scr[kk * 33 + c] = (c < ncv) ? W[(size_t)(k0 + kk) * ldw + c0 + c] : 0.f; }
    LDS_WAIT(); asm volatile("" ::: "memory");
    const int c8 = lane & 7;
#pragma unroll
    for (int j = 0; j < 4; ++j) { const int n = (lane >> 3) + 8 * j; const LAS float* s = scr + (8 * c8) * 33 + n;
        v4u o; o.x = pk2(s[0 * 33], s[1 * 33]); o.y = pk2(s[2 * 33], s[3 * 33]); o.z = pk2(s[4 * 33], s[5 * 33]); o.w = pk2(s[6 * 33], s[7 * 33]);
        *(GAS v4u*)(WT + (size_t)(r0 + n) * ldt + k0 + 8 * c8) = o; }
    LDS_WAIT(); asm volatile("" ::: "memory");
}

__device__ __forceinline__ void ln_row(const float* prow, const float* g, const float* b, float* xf, bf16* xb, float* extra, int lane) {
    const GAS f32x4* xr = (const GAS f32x4*)prow + lane;
    f32x4 v[4]; float s = 0.f;
#pragma unroll
    for (int j = 0; j < 4; ++j) { v[j] = xr[64 * j]; s += (v[j].x + v[j].y) + (v[j].z + v[j].w); }
    const float mean = wave_sum(s) * (1.f / D); float s2 = 0.f;
#pragma unroll
    for (int j = 0; j < 4; ++j) { v[j] = v[j] - mean; s2 += (v[j].x * v[j].x + v[j].y * v[j].y) + (v[j].z * v[j].z + v[j].w * v[j].w); }
    const float rstd = 1.f / sqrtf(wave_sum(s2) * (1.f / D) + LN_EPS);
#pragma unroll
    for (int j = 0; j < 4; ++j) {
        const f32x4 gg = *((const GAS f32x4*)g + lane + 64 * j), bb = *((const GAS f32x4*)b + lane + 64 * j);
        const f32x4 y = v[j] * rstd * gg + bb;
        if (xf) *((GAS f32x4*)xf + lane + 64 * j) = y;
        if (extra) *((GAS f32x4*)extra + lane + 64 * j) = y;
        if (xb) { v2u w; w.x = pk2(y.x, y.y); w.y = pk2(y.z, y.w); *((GAS v2u*)xb + lane + 64 * j) = w; }
    }
}

template <int NT, class Desc>
__device__ __forceinline__ void sgemm32(const bf16* Xb, int lda, const bf16* Bt, int ldb, int K, int nitems, int wg, int nwg, LAS float* red, int tid, const Desc& dsc) {
    asm volatile("" : "+v"(tid));
    const int lane = tid & 63, wid = tid >> 6, r = lane & 31, h = lane >> 5;
    const int kper = K >> 3;
    LAS float* T = red + 8 * NT * 1024;
    for (int it = wg; it < nitems; it += nwg) {
        f32x16 acc[NT];
#pragma unroll
        for (int nt = 0; nt < NT; ++nt) acc[nt] = (f32x16){};
        const bf16* ap = Xb + (size_t)r * lda + dsc.aoff(it) + wid * kper + h * 8;
        const bf16* bp[NT];
#pragma unroll
        for (int nt = 0; nt < NT; ++nt) bp[nt] = Bt + (size_t)(dsc.ct(it, nt) * 32 + r) * ldb + wid * kper + h * 8;
        for (int k = 0; k < kper; k += 16) {
            const bf16x8 a = *(const bf16x8*)(ap + k);
#pragma unroll
            for (int nt = 0; nt < NT; ++nt) { const bf16x8 b = *(const bf16x8*)(bp[nt] + k); acc[nt] = __builtin_amdgcn_mfma_f32_32x32x16_bf16(a, b, acc[nt], 0, 0, 0); }
        }
#pragma unroll
        for (int nt = 0; nt < NT; ++nt)
#pragma unroll
            for (int rr = 0; rr < 16; ++rr) red[(wid * NT + nt) * 1024 + rr * 64 + lane] = acc[nt][rr];
        __syncthreads();
        for (int e = tid; e < NT * 1024; e += NTHREADS) {
            const int nt = e >> 10, x = e & 1023; float s = 0.f;
#pragma unroll
            for (int w = 0; w < 8; ++w) s += red[(w * NT + nt) * 1024 + x];
            const int rr = x >> 6, l = x & 63, j = l & 31, i = (rr & 3) + 8 * (rr >> 2) + 4 * (l >> 5);
            T[nt * 1056 + i * 33 + j] = s;
        }
        __syncthreads();
        dsc.epi(it, T, tid);
        __syncthreads();
    }
}
struct SDescG1 {
    bf16* GS;
    __device__ __forceinline__ int aoff(int) const { return 0; }
    __device__ __forceinline__ int ct(int it, int nt) const { return 8 * (it >> 2) + (it & 3) + 4 * nt; }
    __device__ __forceinline__ void epi(int it, const LAS float* T, int tid) const {
        for (int e = tid; e < 1024; e += NTHREADS) { const int i = e >> 5, j = e & 31; const float g = T[i * 33 + j], u = T[1056 + i * 33 + j];
            GS[i * FF + 128 * (it >> 2) + 32 * (it & 3) + j] = (bf16)f2bf(silu_f(g) * u); }
    }
};
struct SDescResid {
    const float* X; float* P; float s; const float* cs; int agroup;
    __device__ __forceinline__ int aoff(int it) const { return agroup ? 256 * (it >> 3) : 0; }
    __device__ __forceinline__ int ct(int it, int) const { return it; }
    __device__ __forceinline__ void epi(int it, const LAS float* T, int tid) const {
        for (int e = tid; e < 1024; e += NTHREADS) { const int i = e >> 5, j = e & 31, col = it * 32 + j; float a = T[i * 33 + j] * s; if (cs) a *= cs[col];
            P[i * D + col] = ALPHA * X[i * D + col] + a; }
    }
};
struct SDescProj {
    float *QS, *QIS, *WIS, *outK, *outV, *outKI; const f32x2* rope;
    __device__ __forceinline__ int aoff(int) const { return 0; }
    __device__ __forceinline__ int ct(int it, int) const { return it; }
    __device__ __forceinline__ void epi(int it, const LAS float* T, int tid) const {
        for (int e = tid; e < 1024; e += NTHREADS) {
            const int i = e >> 5, j = e & 31, col = it * 32 + j;
            if (col >= NPROJ) continue;
            float v = T[i * 33 + j];
            const bool rot_region = (col < 1280) || (col >= 1536 && col < 2112);
            if (rot_region && ((it & 1) == 0) && j < 16) {
                const int f = j & 7; const float x1 = T[i * 33 + f], x2 = T[i * 33 + f + 8]; const f32x2 cs = rope[f];
                v = (j < 8) ? (x1 * cs.x - x2 * cs.y) : (x2 * cs.x + x1 * cs.y);
            }
            if (col < 1024) QS[i * D + col] = v * QSCALE;
            else if (col < 1280) outK[i * KVW + col - 1024] = v;
            else if (col < 1536) outV[i * KVW + col - 1280] = v;
            else if (col < 2048) QIS[i * 512 + col - 1536] = v;
            else if (col < 2112) outKI[i * 64 + col - 2048] = v;
            else WIS[i * 8 + col - 2112] = v;
        }
    }
};

#define IDX_CNT(OUT, PRED) do { int c_ = 0; _Pragma("unroll") for (int i_ = 0; i_ < 64; ++i_) if (i_ < nreg) c_ += __builtin_popcountll(__ballot(v[i_] PRED)); OUT = c_; } while (0)
__device__ __forceinline__ void index_select_phase(const bf16* QIb, const bf16* KIb, const float* WIf, unsigned* MASK, unsigned short* LIST,
                                                   LAS float* S, int wg, int nwg, int tid) {
    const int wid = __builtin_amdgcn_readfirstlane(tid >> 6);
    const int ngroups = M / 8;
    for (int rd = 0; rd * nwg < ngroups; ++rd) {
        { int l_ = tid; asm volatile("" : "+v"(l_)); tid = l_; }
        const int lane = tid & 63, r = lane & 31, hh = lane >> 5;
        const int o = rd * nwg + ((rd & 1) ? (nwg - 1 - wg) : wg);
        if (o < ngroups) {
            const int qg = o >> 3, b = o & 7, t0 = qg * 8, rb = b * SEQ + t0;
            const int nkt = (t0 + 8 + 31) >> 5;
            bf16x8 A[2][4]; float W[2][16];
#pragma unroll
            for (int mt = 0; mt < 2; ++mt) {
#pragma unroll
                for (int d0 = 0; d0 < 4; ++d0) A[mt][d0] = *(const bf16x8*)(QIb + (size_t)(rb + 4 * mt + (r >> 3)) * 512 + (r & 7) * 64 + d0 * 16 + hh * 8);
#pragma unroll
                for (int rr = 0; rr < 16; ++rr) W[mt][rr] = WIf[(size_t)(rb + 4 * mt + (rr >> 2)) * 8 + (rr & 3) + 4 * hh] * WSCALE;
            }
            for (int kt = wid; kt < nkt; kt += 8) {
                bf16x8 Bf[4];
#pragma unroll
                for (int d0 = 0; d0 < 4; ++d0) Bf[d0] = *(const bf16x8*)(KIb + (size_t)(b * SEQ + kt * 32 + r) * 64 + d0 * 16 + hh * 8);
#pragma unroll
                for (int mt = 0; mt < 2; ++mt) {
                    f32x16 acc = (f32x16){};
#pragma unroll
                    for (int d0 = 0; d0 < 4; ++d0) acc = __builtin_amdgcn_mfma_f32_32x32x16_bf16(A[mt][d0], Bf[d0], acc, 0, 0, 0);
                    float sc[4];
#pragma unroll
                    for (int qq = 0; qq < 4; ++qq) {
                        float a = 0.f;
#pragma unroll
                        for (int e = 0; e < 4; ++e) a += fmaxf(acc[4 * qq + e], 0.f) * W[mt][4 * qq + e];
                        sc[qq] = a + __shfl_xor(a, 32);
                    }
                    const float v0 = hh ? sc[2] : sc[0], v1 = hh ? sc[3] : sc[1];
                    S[(4 * mt + 2 * hh) * 4096 + kt * 32 + r] = v0;
                    S[(4 * mt + 2 * hh + 1) * 4096 + kt * 32 + r] = v1;
                }
            }
        }
        __syncthreads();
        if (o < ngroups) {
            int lane_s = lane; asm volatile("" : "+v"(lane_s));
            const int qg = o >> 3, b = o & 7, t = qg * 8 + wid;
            const size_t grow = (size_t)b * SEQ + t;
            const int nreg = (t >> 6) + 1;
            float v[64];
#pragma unroll
            for (int i = 0; i < 64; ++i) { const int key = i * 64 + lane_s; v[i] = -INFINITY; if (i < nreg) { const float x = S[wid * 4096 + key] + 0.0f; v[i] = (key <= t) ? x : -INFINITY; } }
            const bool all = (t + 1 <= TOPK);
            float T = -INFINITY; int need = 0;
            if (!all) {
                float mn = INFINITY, mx = -INFINITY;
#pragma unroll
                for (int i = 0; i < 64; ++i) { mx = fmaxf(mx, v[i]); mn = fminf(mn, (v[i] == -INFINITY) ? INFINITY : v[i]); }
                float lo = wave_min(mn), hi = wave_max(mx);
                int c; IDX_CNT(c, >= hi);
                if (c >= TOPK) T = hi;
                else {
                    T = lo;
                    for (int itn = 0; itn < 400; ++itn) {
                        const float mid = lo + (hi - lo) * 0.5f;
                        if (!(mid > lo) || !(mid < hi)) { T = lo; break; }
                        IDX_CNT(c, >= mid);
                        if (c == TOPK) { T = mid; break; }
                        if (c > TOPK) lo = mid; else hi = mid;
                        T = lo;
                    }
                }
                int cgt; IDX_CNT(cgt, > T);
                need = TOPK - cgt;
            }
            unsigned mlo = 0u, mhi = 0u; int base = 0;
#pragma unroll
            for (int i = 0; i < 64; ++i) {
                if (i < nreg) {
                    const int key = i * 64 + lane_s;
                    bool gt = all ? (key <= t) : (v[i] > T);
                    bool eq = all ? false : (v[i] == T);
                    unsigned long long meq = __ballot(eq); int k = __builtin_popcountll(meq);
                    if (k > need) { eq = eq && (mbcnt64(meq) < need); meq = __ballot(eq); k = need; }
                    need -= k;
                    const bool sel = gt || eq;
                    const unsigned long long m = __ballot(sel);
                    { const unsigned m0_ = (unsigned)m, m1_ = (unsigned)(m >> 32); asm volatile("v_writelane_b32 %0, %1, %2" : "+v"(mlo) : "s"(m0_), "n"(i)); asm volatile("v_writelane_b32 %0, %1, %2" : "+v"(mhi) : "s"(m1_), "n"(i)); }
                    if (sel) LIST[grow * 256 + base + mbcnt64(m)] = (unsigned short)key;
                    base += __builtin_popcountll(m);
                }
            }
            v2u mw; mw.x = mlo; mw.y = mhi;
            *((v2u*)(MASK + grow * 128) + lane_s) = mw;
        }
        __syncthreads();
    }
}

template <class KR, class VR>
__device__ __forceinline__ void gather_attend(const LAS float* qf, const LAS int* keys, LAS float* pl, int cnt, const KR& kr, const VR& vr, bf16* orow  , int lane) {
    float s[4][4];
#pragma unroll
    for (int c = 0; c < 4; ++c) {
        const int slot = lane + 64 * c; const bool valid = slot < cnt;
        const int key = keys[valid ? slot : 0];
        const float* kp = kr(key);
        float a[4] = {0.f, 0.f, 0.f, 0.f};
#pragma unroll 4
        for (int d4 = 0; d4 < 16; ++d4) {
            const f32x4 kv = *(const f32x4*)(kp + 4 * d4);
#pragma unroll
            for (int g = 0; g < 4; ++g) { const f32x4 qv = *(const LAS f32x4*)(qf + g * 64 + 4 * d4); a[g] += (kv.x * qv.x + kv.y * qv.y) + (kv.z * qv.z + kv.w * qv.w); }
        }
#pragma unroll
        for (int g = 0; g < 4; ++g) s[c][g] = valid ? a[g] : -INFINITY;
    }
    float linv[4];
#pragma unroll
    for (int g = 0; g < 4; ++g) {
        const float mx = wave_max(fmaxf(fmaxf(s[0][g], s[1][g]), fmaxf(s[2][g], s[3][g])));
        float sum = 0.f;
#pragma unroll
        for (int c = 0; c < 4; ++c) { const float p = __builtin_amdgcn_exp2f(s[c][g] - mx); sum += p; pl[g * 256 + lane + 64 * c] = p; }
        linv[g] = 1.0f / wave_sum(sum);
    }
    LDS_WAIT(); asm volatile("" ::: "memory");
    float o[4] = {0.f, 0.f, 0.f, 0.f};
    for (int slot = 0; slot < cnt; ++slot) {
        const int key = keys[slot];
        const float vv = vr(key)[lane];
#pragma unroll
        for (int g = 0; g < 4; ++g) o[g] += pl[g * 256 + slot] * vv;
    }
#pragma unroll
    for (int g = 0; g < 4; ++g) orow[g * 64 + lane] = (bf16)f2bf(o[g] * linv[g]);
    LDS_WAIT(); asm volatile("" ::: "memory");
}
struct RowPlain { const float* base; __device__ __forceinline__ const float* operator()(int key) const { return base + (size_t)key * KVW; } };
struct RowPaged { const float* cache; const float* newrow; const int* pt; int j;
    __device__ __forceinline__ const float* operator()(int key) const {
        if (key >= PAST) return newrow;
        const int phys = pt[key >> 7];
        return cache + ((size_t)(phys * PAGE + (key & (PAGE - 1))) * NKV + j) * 64;
    } };

__device__ __forceinline__ void attn_gather_phase(const bf16* Qb, const float* outK, const float* outV, const unsigned short* LIST, bf16* Ob, LAS unsigned char* lds, int wg, int nwg, int tid) {
    asm volatile("" : "+v"(tid));
    const int lane = tid & 63, wid = tid >> 6;
    LAS float* qf = (LAS float*)(lds + wid * 8192); LAS int* keys = (LAS int*)(lds + wid * 8192 + 1024); LAS float* pl = (LAS float*)(lds + wid * 8192 + 2048);
    const int j = wid & 3;
    for (int pr = wg; pr < M / 2; pr += nwg) {
        const int row = pr * 2 + (wid >> 2); const int b = row >> 12, t = row & (SEQ - 1);
        const int cnt = (t + 1 < TOPK) ? t + 1 : TOPK;
#pragma unroll
        for (int g = 0; g < 4; ++g) qf[g * 64 + lane] = bf2f(Qb[(size_t)row * D + (4 * j + g) * 64 + lane]);
#pragma unroll
        for (int c = 0; c < 4; ++c) keys[lane + 64 * c] = (lane + 64 * c < cnt) ? (int)LIST[(size_t)row * 256 + lane + 64 * c] : 0;
        LDS_WAIT(); asm volatile("" ::: "memory");
        RowPlain kr{outK + (size_t)b * SEQ * KVW + j * 64}, vr{outV + (size_t)b * SEQ * KVW + j * 64};
        gather_attend(qf, keys, pl, cnt, kr, vr, Ob + (size_t)row * D + 4 * j * 64, lane);
    }
}

__device__ __forceinline__ void sample_scores_phase(const float* QIS, const float* WIS, const float* cki, const float* kinew, const int* ptab, float* SC, LAS unsigned char* lds, int wg, int nwg, int tid) {
    asm volatile("" : "+v"(tid));
    const int lane = tid & 63, wid = tid >> 6;
    LAS float* qs = (LAS float*)(lds + wid * 4096);
    for (int it = wg * NWAVES + wid; it < SBT * NPAGES; it += nwg * NWAVES) {
        const int b = it >> 7, pg = it & 127;
#pragma unroll
        for (int i = 0; i < 8; ++i) qs[i * 64 + lane] = QIS[b * 512 + i * 64 + lane];
        if (lane < 8) qs[512 + lane] = WIS[b * 8 + lane] * WSCALE;
        LDS_WAIT(); asm volatile("" ::: "memory");
        const int phys = ptab[b * NPAGES + pg];
#pragma unroll
        for (int kk = 0; kk < 2; ++kk) {
            const int key = lane + 64 * kk;
            const float* kp = cki + ((size_t)phys * PAGE + key) * 64;
            float dot[8] = {0.f, 0.f, 0.f, 0.f, 0.f, 0.f, 0.f, 0.f};
#pragma unroll 4
            for (int d4 = 0; d4 < 16; ++d4) {
                const f32x4 kv = *(const f32x4*)(kp + 4 * d4);
#pragma unroll
                for (int h = 0; h < 8; ++h) { const f32x4 qv = *(const LAS f32x4*)(qs + h * 64 + 4 * d4); dot[h] += (kv.x * qv.x + kv.y * qv.y) + (kv.z * qv.z + kv.w * qv.w); }
            }
            float sc = 0.f;
#pragma unroll
            for (int h = 0; h < 8; ++h) sc += fmaxf(dot[h], 0.f) * qs[512 + h];
            SC[(size_t)b * SCLD + pg * PAGE + key] = sc;
        }
        LDS_WAIT(); asm volatile("" ::: "memory");
    }
    if (wg == nwg - 1 && tid < SBT) {
        const int b = tid; float sc = 0.f;
        for (int h = 0; h < 8; ++h) { float dsum = 0.f; for (int d = 0; d < 64; ++d) dsum += QIS[b * 512 + h * 64 + d] * kinew[b * 64 + d]; sc += fmaxf(dsum, 0.f) * WIS[b * 8 + h] * WSCALE; }
        SC[(size_t)b * SCLD + PAST] = sc;
    }
}

#define SS_CNT(OUT, PRED) do { int c_ = 0; _Pragma("unroll") for (int i_ = 0; i_ < 33; ++i_) c_ += __builtin_popcountll(__ballot(v[i_] PRED)); \
        if (lane == 0) cw[par * 8 + wid] = c_; __syncthreads(); int t_ = 0; _Pragma("unroll") for (int w_ = 0; w_ < 8; ++w_) t_ += cw[par * 8 + w_]; par ^= 1; OUT = t_; } while (0)
__device__ __forceinline__ void sample_select_attend(int b, const float* SC, const float* QS, const float* ck, const float* cv, const float* knew, const float* vnew, const int* ptab,
                                                     bf16* OS, LAS unsigned char* lds, int tid) {
    asm volatile("" : "+v"(tid));
    const int lane = tid & 63, wid = tid >> 6;
    LAS int* cw = (LAS int*)(lds);
    LAS float* cwf = (LAS float*)(lds);
    LAS int* keysL = (LAS int*)(lds + 1024);
    float v[33];
#pragma unroll
    for (int i = 0; i < 33; ++i) { const int key = i * NTHREADS + tid; v[i] = (key < NKEYS_S) ? SC[(size_t)b * SCLD + key] + 0.0f : -INFINITY; }
    float mn = INFINITY, mx = -INFINITY;
#pragma unroll
    for (int i = 0; i < 33; ++i) { mx = fmaxf(mx, v[i]); mn = fminf(mn, (v[i] == -INFINITY) ? INFINITY : v[i]); }
    mn = wave_min(mn); mx = wave_max(mx);
    if (lane == 0) { cwf[16 + wid] = mn; cwf[24 + wid] = mx; }
    if (tid == 0) cw[32] = 0;
    __syncthreads();
    float lo = cwf[16], hi = cwf[24];
#pragma unroll
    for (int w = 1; w < 8; ++w) { lo = fminf(lo, cwf[16 + w]); hi = fmaxf(hi, cwf[24 + w]); }
    int par = 0; int c; float T;
    SS_CNT(c, >= hi);
    if (c >= TOPK) T = hi;
    else {
        T = lo;
        for (int itn = 0; itn < 400; ++itn) {
            const float mid = lo + (hi - lo) * 0.5f;
            if (!(mid > lo) || !(mid < hi)) { T = lo; break; }
            SS_CNT(c, >= mid);
            if (c == TOPK) { T = mid; break; }
            if (c > TOPK) lo = mid; else hi = mid;
            T = lo;
        }
    }
    int cgt; SS_CNT(cgt, > T);
    int need = TOPK - cgt;
    int ceq; SS_CNT(ceq, == T);
#pragma unroll
    for (int i = 0; i < 33; ++i) {
        const bool sel = v[i] > T; const unsigned long long m = __ballot(sel);
        if (m) { int bs = 0; if (lane == 0) bs = atomicAdd((int*)&cw[32], __builtin_popcountll(m)); bs = __builtin_amdgcn_readfirstlane(bs);
            if (sel) keysL[bs + mbcnt64(m)] = i * NTHREADS + tid; }
    }
    if (ceq <= need) {
#pragma unroll
        for (int i = 0; i < 33; ++i) {
            const bool sel = v[i] == T; const unsigned long long m = __ballot(sel);
            if (m) { int bs = 0; if (lane == 0) bs = atomicAdd((int*)&cw[32], __builtin_popcountll(m)); bs = __builtin_amdgcn_readfirstlane(bs);
                if (sel) keysL[bs + mbcnt64(m)] = i * NTHREADS + tid; }
        }
    } else {
        int taken = 0;
#pragma unroll
        for (int i = 0; i < 33; ++i) {
            const bool eq = v[i] == T; const unsigned long long m = __ballot(eq);
            if (lane == 0) cw[40 + wid] = __builtin_popcountll(m);
            __syncthreads();
            int before = taken, tot = 0;
#pragma unroll
            for (int w = 0; w < 8; ++w) { const int kw = cw[40 + w]; if (w < wid) before += kw; tot += kw; }
            const int rank = before + mbcnt64(m);
            if (eq && rank < need) keysL[cgt + rank] = i * NTHREADS + tid;
            taken += tot;
            __syncthreads();
        }
    }
    __syncthreads();
    if (wid < NKV) {
        const int j = wid;
        LAS float* qf = (LAS float*)(lds + 4096 + wid * 8192); LAS float* pl = (LAS float*)(lds + 4096 + wid * 8192 + 1024);
#pragma unroll
        for (int g = 0; g < 4; ++g) qf[g * 64 + lane] = QS[b * D + (4 * j + g) * 64 + lane];
        LDS_WAIT(); asm volatile("" ::: "memory");
        RowPaged kr{ck, knew + b * KVW + j * 64, ptab + b * NPAGES, j}, vr{cv, vnew + b * KVW + j * 64, ptab + b * NPAGES, j};
        gather_attend(qf, keysL, pl, TOPK, kr, vr, OS + b * D + 4 * j * 64, lane);
    }
    __syncthreads();
}

#define RELAUNDER() (({ asm volatile("" : "+s"(pa)); G = G0; wg = wg0; asm volatile("" : "+s"(G), "+s"(wg)); gw = wg * NWAVES + wave; NGW = G * NWAVES; asm volatile("v_mbcnt_lo_u32_b32 %0, -1, 0\n\tv_mbcnt_hi_u32_b32 %0, -1, %0" : "=v"(lane)); tid = wave * 64 + lane; }), true)
struct Args { const void* in[17]; float* out; unsigned char* ws; int ph_lo, ph_hi; };
constexpr int N_PHASES = 21;

__global__ void __launch_bounds__(NTHREADS, 2) fwd(Args args) {
    extern __shared__ __attribute__((aligned(16))) unsigned char lds_raw[];
    LAS unsigned char* lds = (LAS unsigned char*)lds_raw;
#define MISC ((volatile LAS unsigned*)(lds + MISC_OFF))
    int wave = __builtin_amdgcn_readfirstlane((int)threadIdx.x >> 6); asm volatile("" : "+s"(wave));
    int lane, tid; asm volatile("v_mbcnt_lo_u32_b32 %0, -1, 0\n\tv_mbcnt_hi_u32_b32 %0, -1, %0" : "=v"(lane)); tid = wave * 64 + lane;
    const int G0 = gridDim.x, wg0 = blockIdx.x;
    int G = G0, wg = wg0, gw = wg * NWAVES + wave, NGW = G * NWAVES;
    typedef __attribute__((address_space(4))) const Args* kargs_t;
    kargs_t pa = (kargs_t)__builtin_amdgcn_kernarg_segment_ptr();
#define ws (pa->ws)
#define out (pa->out)
#define x_prompt ((const float*)pa->in[0])
#define x_sample ((const float*)pa->in[1])
#define cache_k ((const float*)pa->in[2])
#define cache_v ((const float*)pa->in[3])
#define cache_kidx ((const float*)pa->in[4])
#define state_pool ((const float*)pa->in[5])
#define page_table ((const int*)pa->in[6])
#define ln_g ((const float*)pa->in[7])
#define ln_b ((const float*)pa->in[8])
#define ffn1_wi ((const float*)pa->in[9])
#define ffn1_wo ((const float*)pa->in[10])
#define ffn2_wi ((const float*)pa->in[11])
#define ffn2_wo ((const float*)pa->in[12])
#define attn_w_in ((const float*)pa->in[13])
#define attn_w_o ((const float*)pa->in[14])
#define pool_w ((const float*)pa->in[15])
#define pool_scale ((const float*)pa->in[16])
#define W_WI ((bf16*)(ws + WS_WI))
#define W_WO ((bf16*)(ws + WS_WO))
#define W_IN ((bf16*)(ws + WS_WIN))
#define W_OA ((bf16*)(ws + WS_WOA))
#define W_POOL ((bf16*)(ws + WS_WPOOL))
#define ROPE ((f32x2*)(ws + WS_ROPE))
#define XB ((bf16*)(ws + WS_XB))
#define XA ((float*)(ws + WS_XA))
#define PRE ((float*)(ws + WS_PRE))
#define GB ((bf16*)(ws + WS_G))
#define QB ((bf16*)(ws + WS_QB))
#define OB ((bf16*)(ws + WS_OB))
#define KB ((bf16*)(ws + WS_KB))
#define VB ((bf16*)(ws + WS_VB))
#define QIB ((bf16*)(ws + WS_QIB))
#define KIB ((bf16*)(ws + WS_KIB))
#define WIF ((float*)(ws + WS_WIF))
#define MASK ((unsigned*)(ws + WS_MASK))
#define LIST ((unsigned short*)(ws + WS_LIST))
#define DB ((bf16*)(ws + WS_DB))
#define XS ((float*)(ws + WS_S + S_XS))
#define PRES ((float*)(ws + WS_S + S_PRES))
#define XSB ((bf16*)(ws + WS_S + S_XSB))
#define GS ((bf16*)(ws + WS_S + S_GS))
#define QS ((float*)(ws + WS_S + S_QS))
#define QIS ((float*)(ws + WS_S + S_QIS))
#define WIS ((float*)(ws + WS_S + S_WIS))
#define OS ((bf16*)(ws + WS_S + S_OS))
#define DS ((bf16*)(ws + WS_S + S_DS))
#define SC ((float*)(ws + WS_S + S_SC))
    for (int u = tid; u < 64; u += NTHREADS) MISC[u] = 0u;
    __syncthreads();
    const int lo = pa->ph_lo, hi = pa->ph_hi;
    if (hi - lo > 1) (void)xcd_barrier_post((unsigned*)(ws + WS_CTL) + CW_BAR, MISC + 8, tid);
    int ph = 0;
#define LAUNDER_V(x) asm volatile("" : "+v"(x))
#define LAUNDER_S(x) asm volatile("" : "+s"(x))
#ifndef SITEMASK
#define SITEMASK 0xFFFFFFFFu
#endif
#define PH_ON(k) (((SITEMASK >> (k)) & 1u) && ph >= lo && ph < hi && RELAUNDER())
#define PH_END do { if (ph >= lo && ph + 1 < hi) { RELAUNDER(); XcdBarrier bar_; bar_.bar = (unsigned*)(ws + WS_CTL) + CW_BAR; bar_.x = xb_xcc_id(); bar_.st = (volatile LAS unsigned*)(lds + MISC_OFF) + 8; xcd_barrier(bar_, tid); } ++ph; } while (0)
    LAS float* redS = (LAS float*)(lds + RING_OFF);

    if (PH_ON(0)) {
        LAS float* scr = (LAS float*)(lds + RING_OFF + wave * 16384);
        constexpr int I_WI = 16 * 176, I_WO = 44 * 32, I_IN = 16 * 72, I_OA = 16 * 32, I_PL = 4 * 8;
        constexpr int NIT = 4 * I_WI + 4 * I_WO + I_IN + I_OA + 4 * I_PL;
        for (int it = gw; it < NIT; it += NGW) {
            int r = it;
            if (r < 4 * I_WI) { const int mi = r / I_WI; r -= mi * I_WI; const int kb = r / 176, nb = r % 176; const int n0 = nb * 32, pn = n0 >> 8, i = n0 & 255;
                const int c0 = (i < 128) ? (128 * pn + i) : (FF + 128 * pn + (i - 128));
                tr_item(((mi & 1) ? ffn2_wi : ffn1_wi) + (size_t)(mi >> 1) * D * NWI, NWI, kb * 64, c0, 32, (bf16*)((unsigned char*)W_WI + (size_t)mi * WI_STRIDE), D, n0, scr, lane); continue; }
            r -= 4 * I_WI;
            if (r < 4 * I_WO) { const int mi = r / I_WO; r -= mi * I_WO; const int kb = r / 32, nb = r % 32;
                tr_item(((mi & 1) ? ffn2_wo : ffn1_wo) + (size_t)(mi >> 1) * FF * D, D, kb * 64, nb * 32, 32, (bf16*)((unsigned char*)W_WO + (size_t)mi * WO_STRIDE), FF, nb * 32, scr, lane); continue; }
            r -= 4 * I_WO;
            if (r < I_IN) { const int kb = r / 72, nb = r % 72; const int ncv = NPROJ - nb * 32;
                tr_item(attn_w_in, NPROJ, kb * 64, (ncv > 0) ? nb * 32 : 0, ncv, W_IN, D, nb * 32, scr, lane); continue; }
            r -= I_IN;
            if (r < I_OA) { const int kb = r / 32, nb = r % 32; tr_item(attn_w_o, D, kb * 64, nb * 32, 32, W_OA, D, nb * 32, scr, lane); continue; }
            r -= I_OA;
            { const int g = r / I_PL; r -= g * I_PL; const int kb = r / 8, nb = r % 8; tr_item(pool_w + (size_t)g * 65536, 256, kb * 64, nb * 32, 32, W_POOL, 256, g * 256 + nb * 32, scr, lane); }
        }
        for (size_t i = (size_t)wg * NTHREADS + tid; i < (size_t)(M + SBT) * D / 8; i += (size_t)G * NTHREADS) {
            const float* src = (i < (size_t)M * D / 8) ? x_prompt + i * 8 : x_sample + (i - (size_t)M * D / 8) * 8;
            bf16* dst = (i < (size_t)M * D / 8) ? XB + i * 8 : XSB + (i - (size_t)M * D / 8) * 8;
            const f32x4 a = *(const f32x4*)src, c = *(const f32x4*)(src + 4);
            v4u o; o.x = pk2(a.x, a.y); o.y = pk2(a.z, a.w); o.z = pk2(c.x, c.y); o.w = pk2(c.z, c.w); *(v4u*)dst = o;
        }
        for (int i = wg * NTHREADS + tid; i < 4097 * 8; i += G * NTHREADS) {
            const int p = i >> 3, f = i & 7; const float pos = (p < 4096) ? (float)p : (float)PAST;
            const float freq = (float)pow(500000.0, -(double)f / 8.0);
            const float ang = pos * freq;
            f32x2 cs; cs.x = (float)cos((double)ang); cs.y = (float)sin((double)ang); ROPE[i] = cs;
        }
    }
    PH_END;

    for (int f = 0; f < 4; ++f) {
        const int layer = f >> 1, which = f & 1;
        const bf16* Wi = (const bf16*)((const unsigned char*)W_WI + (size_t)(layer * 2 + which) * WI_STRIDE);
        const bf16* Wo = (const bf16*)((const unsigned char*)W_WO + (size_t)(layer * 2 + which) * WO_STRIDE);
        const float* Xres = (f == 0) ? x_prompt : XA;
        const float* XSres = (f == 0) ? x_sample : XS;
        const int lni = which ? 2 : 0;
        if (PH_ON(1)) {
            { SDescG1 dsc{GS}; sgemm32<2>(XSB, D, Wi, D, D, 88, wg, G, redS, tid, dsc); }
            pg8::Gemm g{XB, Wi, D, D, D, 0}; pg8::StaticOrder S; S.init(M, NWI, G, wg);
            pg8::EpiSwiglu E{GB};
            pg8::gemm_phase<pg8::EpiSwiglu, pg8::StaticOrder, true, true>(lds + RING_OFF, g, S, E, tid);
        }
        PH_END;
        if (PH_ON(2)) {
            { SDescResid dsc{XSres, PRES, 0.5f, nullptr, 0}; sgemm32<1>(GS, FF, Wo, FF, FF, 32, wg, G, redS, tid, dsc); }
            pg8::Gemm g{GB, Wo, FF, FF, FF, 0}; pg8::StaticOrder S; S.init(M, D, G, wg);
            pg8::EpiResid<false> E{Xres, PRE, 0.5f, nullptr};
            pg8::gemm_phase<pg8::EpiResid<false>, pg8::StaticOrder, true, true>(lds + RING_OFF, g, S, E, tid);
        }
        PH_END;
        if (PH_ON(3)) {
            const float* gg = ln_g + (layer * 3 + lni) * D; const float* bb = ln_b + (layer * 3 + lni) * D;
            const bool last = (f == 3);
            for (int m = gw; m < M + SBT; m += NGW) {
                if (m < M) {
                    float* extra = nullptr;
                    if (f == 2 && (m & (SEQ - 1)) >= SEQ - 15) extra = out + O_PP + ((size_t)(m >> 12) * 15 + ((m & (SEQ - 1)) - (SEQ - 15))) * D;
                    ln_row(PRE + (size_t)m * D, gg, bb, last ? out + O_YP + (size_t)m * D : XA + (size_t)m * D, last ? nullptr : XB + (size_t)m * D, extra, lane);
                } else {
                    const int sr = m - M;
                    float* extra = (f == 2) ? out + O_PS + ((size_t)sr * 15 + 14) * D : nullptr;
                    ln_row(PRES + (size_t)sr * D, gg, bb, last ? out + O_YS + (size_t)sr * D : XS + (size_t)sr * D, last ? nullptr : XSB + (size_t)sr * D, extra, lane);
                }
            }
        }
        PH_END;
        if (f == 0) {
            if (PH_ON(4)) {
                { SDescProj dsc{QS, QIS, WIS, out + O_KS, out + O_VS, out + O_KIS, ROPE + 4096 * 8}; sgemm32<1>(XSB, D, W_IN, D, D, 67, wg, G, redS, tid, dsc); }
                pg8::Gemm g{XB, W_IN, D, D, D, 0}; pg8::StaticOrder S; S.init(M, NPROJP, G, wg);
                pg8::EpiProj E{ws, out};
                pg8::gemm_phase<pg8::EpiProj, pg8::StaticOrder, true, true>(lds + RING_OFF, g, S, E, tid);
            }
            PH_END;
            if (PH_ON(5)) {
                sample_scores_phase(QIS, WIS, cache_kidx, out + O_KIS, page_table, SC, lds + RING_OFF, wg, G, tid);
                __syncthreads();
                index_select_phase(QIB, KIB, WIF, MASK, LIST, (LAS float*)(lds + RING_OFF), wg, G, tid);
            }
            PH_END;
            if (PH_ON(6)) {
                if (wg < SBT) sample_select_attend(wg, SC, QS, cache_k, cache_v, out + O_KS, out + O_VS, page_table, OS, lds + RING_OFF, tid);
                __syncthreads();
                attn_gather_phase(QB, out + O_KP, out + O_VP, LIST, OB, lds + RING_OFF, wg, G, tid);
            }
            PH_END;
            if (PH_ON(7)) {
                { SDescResid dsc{XS, PRES, 1.0f, nullptr, 0}; sgemm32<1>(OS, D, W_OA, D, D, 32, wg, G, redS, tid, dsc); }
                pg8::Gemm g{OB, W_OA, D, D, D, 0}; pg8::StaticOrder S; S.init(M, D, G, wg);
                pg8::EpiResid<false> E{XA, PRE, 1.0f, nullptr};
                pg8::gemm_phase<pg8::EpiResid<false>, pg8::StaticOrder, true, true>(lds + RING_OFF, g, S, E, tid);
            }
            PH_END;
            if (PH_ON(8)) {
                const float* gg = ln_g + 1 * D; const float* bb = ln_b + 1 * D;
                for (int m = gw; m < M + SBT; m += NGW) {
                    if (m < M) ln_row(PRE + (size_t)m * D, gg, bb, XA + (size_t)m * D, XB + (size_t)m * D, nullptr, lane);
                    else ln_row(PRES + (size_t)(m - M) * D, gg, bb, XS + (size_t)(m - M) * D, XSB + (size_t)(m - M) * D, nullptr, lane);
                }
            }
            PH_END;
        }
        if (f == 2) {
            if (PH_ON(9)) {
                for (size_t it = (size_t)wg * NTHREADS + tid; it < (size_t)M * 256; it += (size_t)G * NTHREADS) {
                    const int row = (int)(it >> 8), c4 = (int)(it & 255), col = 4 * c4, t = row & (SEQ - 1);
                    const int w = 2 << (c4 >> 6); const int cnt = (t + 1 < w) ? t + 1 : w;
                    const f32x4 xt = *(const f32x4*)(XA + (size_t)row * D + col); f32x4 sum = xt;
                    for (int r = 1; r < cnt; ++r) sum = sum + *(const f32x4*)(XA + (size_t)(row - r) * D + col);
                    const f32x4 d = sum * (1.0f / (float)cnt) - xt;
                    v2u o; o.x = pk2(d.x, d.y); o.y = pk2(d.z, d.w); *(v2u*)(DB + (size_t)row * D + col) = o;
                }
                for (int it = wg * NTHREADS + tid; it < SBT * 256; it += G * NTHREADS) {
                    const int b = it >> 8, c4 = it & 255, col = 4 * c4; const int w = 2 << (c4 >> 6);
                    const f32x4 xt = *(const f32x4*)(XS + b * D + col); f32x4 sum = xt;
                    for (int r = 1; r < w; ++r) sum = sum + *(const f32x4*)(state_pool + ((size_t)b * 15 + (15 - r)) * D + col);
                    const f32x4 d = sum * (1.0f / (float)w) - xt;
                    v2u o; o.x = pk2(d.x, d.y); o.y = pk2(d.z, d.w); *(v2u*)(DS + b * D + col) = o;
                }
                for (int it = wg * NTHREADS + tid; it < SBT * 14 * 256; it += G * NTHREADS) {
                    const int b = it / (14 * 256), rem = it % (14 * 256), r = rem >> 8, c4 = rem & 255;
                    *(f32x4*)(out + O_PS + ((size_t)b * 15 + r) * D + 4 * c4) = *(const f32x4*)(state_pool + ((size_t)b * 15 + r + 1) * D + 4 * c4);
                }
            }
            PH_END;
            if (PH_ON(10)) {
                { SDescResid dsc{XS, PRES, 1.0f, pool_scale, 1}; sgemm32<1>(DS, D, W_POOL, 256, 256, 32, wg, G, redS, tid, dsc); }
                pg8::Gemm g{DB, W_POOL, D, 256, 256, 512}; pg8::StaticOrder S; S.init(M, D, G, wg);
                pg8::EpiResid<true> E{XA, PRE, 1.0f, pool_scale};
                pg8::gemm_phase<pg8::EpiResid<true>, pg8::StaticOrder, true, true>(lds + RING_OFF, g, S, E, tid);
            }
            PH_END;
            if (PH_ON(11)) {
                const float* gg = ln_g + 4 * D; const float* bb = ln_b + 4 * D;
                for (int m = gw; m < M + SBT; m += NGW) {
                    if (m < M) ln_row(PRE + (size_t)m * D, gg, bb, XA + (size_t)m * D, XB + (size_t)m * D, nullptr, lane);
                    else ln_row(PRES + (size_t)(m - M) * D, gg, bb, XS + (size_t)(m - M) * D, XSB + (size_t)(m - M) * D, nullptr, lane);
                }
            }
            PH_END;
        }
    }
#undef PH_ON
#undef PH_END
#undef ws
#undef out
#undef MISC
}

extern "C" void kernel_launch(void* const* d_in, const int* in_sizes, int n_in, void* d_out, int out_size, void* d_ws, size_t ws_size, hipStream_t stream) {
    static int grid = 0;
    if (grid == 0) {
        if (n_in != 17 || out_size != (int)O_END || ws_size < WS_END) { fprintf(stderr, "kernel_launch: unexpected sizes n_in %d out %d ws %zu\n", n_in, out_size, ws_size); grid = -1; return; }
        int dev = 0, cus = 0, per_cu = 0;
        if (hipGetDevice(&dev) != hipSuccess || hipDeviceGetAttribute(&cus, hipDeviceAttributeMultiprocessorCount, dev) != hipSuccess) { grid = -1; return; }
        if (hipFuncSetAttribute((const void*)fwd, hipFuncAttributeMaxDynamicSharedMemorySize, LDS_BYTES) != hipSuccess) { fprintf(stderr, "kernel_launch: hipFuncSetAttribute failed\n"); grid = -1; return; }
        if (hipOccupancyMaxActiveBlocksPerMultiprocessor(&per_cu, (const void*)fwd, NTHREADS, LDS_BYTES) != hipSuccess || per_cu < 1)
            fprintf(stderr, "kernel_launch: note: occupancy query reports %d workgroups per CU\n", per_cu);
        (void)hipGetLastError();
        grid = cus;
    }
    if (grid < 0) return;
    (void)hipMemsetAsync((char*)d_ws + WS_CTL, 0, CTL_ZERO_BYTES, stream);
    Args a{};
    for (int i = 0; i < 17; ++i) a.in[i] = d_in[i];
    a.out = (float*)d_out; a.ws = (unsigned char*)d_ws;
#ifndef MK_ONE_LAUNCH
#define MK_ONE_LAUNCH 0
#endif
    if (MK_ONE_LAUNCH) {
        a.ph_lo = 0; a.ph_hi = N_PHASES;
        hipLaunchKernelGGL(fwd, dim3(grid), dim3(NTHREADS), LDS_BYTES, stream, a);
    } else {
        for (int p = 0; p < N_PHASES; ++p) { a.ph_lo = p; a.ph_hi = p + 1; hipLaunchKernelGGL(fwd, dim3(grid), dim3(NTHREADS), LDS_BYTES, stream, a); }
    }
}
```

```cpp
#include <hip/hip_runtime.h>
#include <cstdio>
#include <cstdint>
#include <cmath>
namespace pg8 {
#define PG8_LAS __attribute__((address_space(3)))
typedef unsigned short bf16_t;
typedef short bf16x8 __attribute__((ext_vector_type(8)));
typedef float f32x4 __attribute__((ext_vector_type(4)));
typedef unsigned u32x4 __attribute__((ext_vector_type(4)));
constexpr int BM = 256, BK = 64, HALF = 128, HTB = HALF * BK * 2  , STAGE_BYTES = 8 * HTB, NXCD = 8, WGM = 8;

__host__ __device__ __forceinline__ int lds_byte(int r, int c) { const int st = (r >> 4) * 2 + (c >> 5), rr = r & 15, cc = c & 31, ob = rr * 64 + cc * 2; return st * 1024 + (ob ^ (((ob >> 9) & 1) << 5)); }
__host__ __device__ __forceinline__ void stage_rc(int b, int& R, int& C) { const int st = b / 1024, sb = b % 1024, swz = sb ^ (((sb >> 9) & 1) << 5); R = (st >> 1) * 16 + swz / 64; C = (st & 1) * 32 + (swz % 64) / 2; }
__host__ __device__ __forceinline__ int perm32(int rho) { const int n = rho >> 4, i = rho & 15; return 8 * (i >> 2) + 4 * n + (i & 3); }

struct Unit { int pm, pn; };
struct Gemm { const bf16_t* A; const bf16_t* Bt; int lda, ldb, K, a_pn_step; };

struct StaticOrder {
    int nM, nN, nwg, G, c;
    __host__ __device__ void init(int M, int N, int G_, int c_) { nM = M / BM; nN = N / BM; nwg = nM * nN; G = G_; c = c_; }
    __host__ __device__ bool next(int i, Unit& u) const {
        const long L = (long)i * G + c; if (L >= nwg) return false;
        int wgid = (int)L; { const int q = nwg / NXCD, r = nwg % NXCD, xcd = wgid % NXCD, off = wgid / NXCD; wgid = (xcd < r ? xcd * (q + 1) : r * (q + 1) + (xcd - r) * q) + off; }
        const int nig = WGM * nN, gid = wgid / nig, fm = gid * WGM, gsz = (nM - fm) < WGM ? (nM - fm) : WGM;
        u.pm = fm + ((wgid % nig) % gsz); u.pn = (wgid % nig) / gsz; return true;
    }
    __device__ __forceinline__ void a_ready(const Unit&) const {}
    __device__ __forceinline__ void done(const Unit&) const {}
};
__device__ __forceinline__ unsigned cvt_pk_bf16(float lo, float hi) { unsigned r; asm volatile("v_cvt_pk_bf16_f32 %0, %1, %2" : "=v"(r) : "v"(lo), "v"(hi)); return r; }
template <class Epi, class Sched, bool ALIGN_EPI = false, bool SP2 = false>
__device__ __forceinline__ void gemm_phase(PG8_LAS unsigned char* lds, const Gemm g, const Sched& S, const Epi& E, int tid_in) {
    int tid_l = tid_in; asm volatile("" : "+v"(tid_l));
    const int tid = tid_l, wid = __builtin_amdgcn_readfirstlane(tid >> 6), lane = tid & 63, wr = wid >> 2, wc = wid & 3, fr = lane & 15, fq = lane >> 4;
    const int K = g.K, nt = K / BK;
    unsigned voffA[2], voffB[2];
#pragma unroll
    for (int i = 0; i < 2; ++i) { int R, C; stage_rc(tid * 16 + i * 8192, R, C); const int Rb = Epi::PERM ? ((R & ~31) + perm32(R & 31)) : R;
        voffA[i] = (unsigned)(R * g.lda + C) * 2u; voffB[i] = (unsigned)(Rb * g.ldb + C) * 2u; }
    const size_t kstep = (size_t)(BK * 2);
    const size_t hstepA = (size_t)HALF * g.lda * 2, hstepB = (size_t)HALF * g.ldb * 2;
    const size_t tstepA = 2 * hstepA, tstepB = 2 * hstepB;
    const unsigned ldsw = (unsigned)wid * 1024u;
    const int aoff = lds_byte(wr * 64 + fr, fq * 8), boff = lds_byte(wc * 32 + fr, fq * 8);
#define PG8_SA(b, h) (((b) * 2 + (h)) * HTB)
#define PG8_SB(b, h) ((4 + (b) * 2 + (h)) * HTB)
#define PG8_STAGE(bufoff, gbase, voff) do { _Pragma("unroll") for (int _i = 0; _i < 2; ++_i) \
        __builtin_amdgcn_global_load_lds((const unsigned*)((const char*)(gbase) + (voff)[_i]), (PG8_LAS unsigned*)(lds + (bufoff) + ldsw + _i * 8192), 16, 0, 0); } while (0)
#define PG8_LDA(dst, b, h) do { _Pragma("unroll") for (int m = 0; m < 4; ++m) _Pragma("unroll") for (int k = 0; k < 2; ++k) dst[m][k] = *(const PG8_LAS bf16x8*)(lds + PG8_SA(b, h) + aoff + m * 2048 + k * 1024); } while (0)
#define PG8_LDB(dst, b, h) do { _Pragma("unroll") for (int n = 0; n < 2; ++n) _Pragma("unroll") for (int k = 0; k < 2; ++k) dst[n][k] = *(const PG8_LAS bf16x8*)(lds + PG8_SB(b, h) + boff + n * 2048 + k * 1024); } while (0)
#define PG8_MMA(ai, bj, At, Bt) do { __builtin_amdgcn_s_setprio(1); _Pragma("unroll") for (int m = 0; m < 4; ++m) _Pragma("unroll") for (int n = 0; n < 2; ++n) _Pragma("unroll") for (int k = 0; k < 2; ++k) \
        acc[ai][bj][m][n] = __builtin_amdgcn_mfma_f32_16x16x32_bf16(Bt[n][k], At[m][k], acc[ai][bj][m][n], 0, 0, 0); __builtin_amdgcn_s_setprio(0); } while (0)
#define PG8_WAIT_V(n) asm volatile("s_waitcnt vmcnt(" #n ")" ::: "memory")
#define PG8_WAIT_L(n) asm volatile("s_waitcnt lgkmcnt(" #n ")" ::: "memory")
#define PG8_BAR __builtin_amdgcn_s_barrier()
#define PG8_SCHED __builtin_amdgcn_sched_barrier(0)
    Unit cur, nxt; int ui = 0;
    if (!S.next(0, cur)) return;
    f32x4 acc[2][2][4][2];
#pragma unroll
    for (int a = 0; a < 2; ++a)
#pragma unroll
        for (int b = 0; b < 2; ++b)
#pragma unroll
            for (int m = 0; m < 4; ++m)
#pragma unroll
                for (int n = 0; n < 2; ++n) acc[a][b][m][n] = (f32x4){0.f, 0.f, 0.f, 0.f};
    bf16x8 At[4][2], B0[2][2], B1[2][2];
    const char* cA = (const char*)g.A + (size_t)cur.pm * tstepA + (size_t)cur.pn * g.a_pn_step; const char* cB = (const char*)g.Bt + (size_t)cur.pn * tstepB;
    S.a_ready(cur);
    if constexpr (SP2) {
        PG8_STAGE(PG8_SB(0, 0), cB, voffB); PG8_STAGE(PG8_SB(0, 1), cB + hstepB, voffB); PG8_STAGE(PG8_SA(0, 0), cA, voffA); PG8_STAGE(PG8_SA(0, 1), cA + hstepA, voffA);
        if (wr == 1) PG8_BAR;
        PG8_WAIT_V(2); PG8_BAR;
        PG8_STAGE(PG8_SB(1, 0), cB + kstep, voffB); PG8_STAGE(PG8_SA(1, 0), cA + kstep, voffA); PG8_STAGE(PG8_SB(1, 1), cB + hstepB + kstep, voffB);
        PG8_WAIT_V(6); PG8_BAR;
    } else {
        PG8_STAGE(PG8_SB(0, 0), cB, voffB); PG8_STAGE(PG8_SA(0, 0), cA, voffA); PG8_STAGE(PG8_SB(0, 1), cB + hstepB, voffB); PG8_STAGE(PG8_SA(0, 1), cA + hstepA, voffA);
        if (wr == 1) PG8_BAR;
        PG8_WAIT_V(4); PG8_BAR;
        PG8_STAGE(PG8_SB(1, 0), cB + kstep, voffB); PG8_STAGE(PG8_SA(1, 0), cA + kstep, voffA); PG8_STAGE(PG8_SB(1, 1), cB + hstepB + kstep, voffB);
        PG8_WAIT_V(6); PG8_BAR;
    }
    for (;;) {
        const bool has_next = S.next(ui + 1, nxt);
        const char* nA = has_next ? (const char*)g.A + (size_t)nxt.pm * tstepA + (size_t)nxt.pn * g.a_pn_step : cA; const char* nB = has_next ? (const char*)g.Bt + (size_t)nxt.pn * tstepB : cB;
        for (int t = 0; t < nt; t += 2) {
            const bool last = (t == nt - 2);
            const char* a1 = cA + (size_t)(t + 1) * kstep;
            const char* a2 = last ? nA : cA + (size_t)(t + 2) * kstep; const char* b2 = last ? nB : cB + (size_t)(t + 2) * kstep;
            const char* a3 = a2 + kstep; const char* b3 = b2 + kstep;
            if (last && has_next) S.a_ready(nxt);
            if constexpr (SP2) {
            PG8_LDB(B0, 0, 0); PG8_LDB(B1, 0, 1); PG8_SCHED; PG8_LDA(At, 0, 0); PG8_STAGE(PG8_SA(1, 1), a1 + hstepA, voffA);
            PG8_WAIT_V(8); PG8_WAIT_L(0); PG8_BAR; PG8_MMA(0, 0, At, B0); PG8_MMA(0, 1, At, B1); PG8_BAR; PG8_SCHED;
            PG8_LDA(At, 0, 1); PG8_STAGE(PG8_SB(0, 0), b2, voffB); PG8_STAGE(PG8_SB(0, 1), b2 + hstepB, voffB); PG8_STAGE(PG8_SA(0, 0), a2, voffA);
            PG8_WAIT_V(8); PG8_WAIT_L(0); PG8_BAR; PG8_MMA(1, 0, At, B0); PG8_MMA(1, 1, At, B1); PG8_BAR; PG8_SCHED;
            PG8_LDB(B0, 1, 0); PG8_LDB(B1, 1, 1); PG8_SCHED; PG8_LDA(At, 1, 0); PG8_STAGE(PG8_SA(0, 1), a2 + hstepA, voffA);
            PG8_WAIT_V(8); PG8_WAIT_L(0); PG8_BAR; PG8_MMA(0, 0, At, B0); PG8_MMA(0, 1, At, B1); PG8_BAR; PG8_SCHED;
            PG8_LDA(At, 1, 1); PG8_STAGE(PG8_SB(1, 0), b3, voffB); PG8_STAGE(PG8_SB(1, 1), b3 + hstepB, voffB); PG8_STAGE(PG8_SA(1, 0), a3, voffA);
            PG8_WAIT_V(8); PG8_WAIT_L(0); PG8_BAR; PG8_MMA(1, 0, At, B0); PG8_MMA(1, 1, At, B1); PG8_BAR; PG8_SCHED;
            } else {
            PG8_LDB(B0, 0, 0); PG8_SCHED; PG8_LDA(At, 0, 0); PG8_STAGE(PG8_SA(1, 1), a1 + hstepA, voffA);
            PG8_WAIT_L(8); PG8_BAR; PG8_WAIT_L(0); PG8_MMA(0, 0, At, B0); PG8_BAR; PG8_SCHED;
            PG8_LDB(B1, 0, 1); PG8_STAGE(PG8_SB(0, 0), b2, voffB);
            PG8_BAR; PG8_WAIT_L(0); PG8_MMA(0, 1, At, B1); PG8_BAR;
            PG8_LDA(At, 0, 1); PG8_STAGE(PG8_SA(0, 0), a2, voffA);
            PG8_BAR; PG8_WAIT_L(0); PG8_MMA(1, 0, At, B0); PG8_BAR; PG8_SCHED;
            PG8_STAGE(PG8_SB(0, 1), b2 + hstepB, voffB);
            PG8_WAIT_V(6); PG8_BAR; PG8_MMA(1, 1, At, B1); PG8_BAR;
            PG8_LDB(B0, 1, 0); PG8_SCHED; PG8_LDA(At, 1, 0); PG8_STAGE(PG8_SA(0, 1), a2 + hstepA, voffA);
            PG8_WAIT_L(8); PG8_BAR; PG8_WAIT_L(0); PG8_MMA(0, 0, At, B0); PG8_BAR; PG8_SCHED;
            PG8_LDB(B1, 1, 1); PG8_STAGE(PG8_SB(1, 0), b3, voffB);
            PG8_BAR; PG8_WAIT_L(0); PG8_MMA(0, 1, At, B1); PG8_BAR;
            PG8_LDA(At, 1, 1); PG8_STAGE(PG8_SA(1, 0), a3, voffA);
            PG8_BAR; PG8_WAIT_L(0); PG8_MMA(1, 0, At, B0); PG8_BAR; PG8_SCHED;
            PG8_STAGE(PG8_SB(1, 1), b3 + hstepB, voffB);
            PG8_WAIT_V(6); PG8_BAR; PG8_MMA(1, 1, At, B1); PG8_BAR;
            }
        }
        if constexpr (ALIGN_EPI) { if (wr == 0) PG8_BAR; }
        if constexpr (!Epi::AFTER_DRAIN) { int l2_; asm volatile("v_mbcnt_lo_u32_b32 %0, -1, 0\n\tv_mbcnt_hi_u32_b32 %0, -1, %0" : "=v"(l2_)); E(acc, cur, wr, wc, l2_ & 15, l2_ >> 4); S.done(cur); }
        if (!has_next) break;
#pragma unroll
        for (int a = 0; a < 2; ++a)
#pragma unroll
            for (int b = 0; b < 2; ++b)
#pragma unroll
                for (int m = 0; m < 4; ++m)
#pragma unroll
                    for (int n = 0; n < 2; ++n) acc[a][b][m][n] = (f32x4){0.f, 0.f, 0.f, 0.f};
        cur = nxt; cA = nA; cB = nB; ++ui;
        if constexpr (ALIGN_EPI) { if (wr == 1) PG8_BAR; }
    }
    PG8_WAIT_V(0);
    if constexpr (!ALIGN_EPI) { if (wr == 0) PG8_BAR; }
    PG8_BAR;
    if constexpr (Epi::AFTER_DRAIN) { E.fused(acc, cur, wr, wc, fr, fq, lds, wid, lane); S.done(cur); }
#undef PG8_SA
#undef PG8_SB
#undef PG8_STAGE
#undef PG8_LDA
#undef PG8_LDB
#undef PG8_MMA
#undef PG8_WAIT_V
#undef PG8_WAIT_L
#undef PG8_BAR
#undef PG8_SCHED
}
}

constexpr int D = 1024, BATCH = 8, SEQ = 4096, M = BATCH * SEQ, SBT = 32;
constexpr int FF = 2816, NWI = 2 * FF;
constexpr int NKV = 4, KVW = 256;
constexpr int NPROJ = 2120, NPROJP = 2304;
constexpr int PAST = 16384, PAGE = 128, NPAGES = 128;
constexpr int NKEYS_S = PAST + 1, SCLD = 16448;
constexpr int TOPK = 256;
constexpr float LN_EPS = 1e-5f;
constexpr float ALPHA = 1.4142135623730951f;
constexpr float QSCALE = 0.125f * 1.4426950408889634f;
constexpr float WSCALE = 0.125f * 0.35355339059327373f;

constexpr size_t O_YP = 0, O_YS = 33554432, O_KP = 33587200, O_VP = 41975808, O_KIP = 50364416, O_PP = 52461568,
                 O_KS = 52584448, O_VS = 52592640, O_KIS = 52600832, O_PS = 52602880, O_END = 53094400;

constexpr size_t MiB = 1u << 20;
constexpr size_t WS_CTL = 0, CTL_ZERO_BYTES = 1 * MiB;
constexpr size_t WS_WI = 2 * MiB;
constexpr size_t WI_STRIDE = 11 * MiB;
constexpr size_t WS_WO = 46 * MiB;
constexpr size_t WO_STRIDE = (size_t)D * FF * 2;
constexpr size_t WS_WIN = 68 * MiB;
constexpr size_t WS_WOA = 73 * MiB;
constexpr size_t WS_WPOOL = 75 * MiB;
constexpr size_t WS_ROPE = 76 * MiB;
constexpr size_t WS_XB = 80 * MiB;
constexpr size_t WS_XA = 144 * MiB;
constexpr size_t WS_PRE = 272 * MiB;
constexpr size_t WS_G = 400 * MiB;
constexpr size_t WS_QB = 576 * MiB;
constexpr size_t WS_OB = 640 * MiB;
constexpr size_t WS_KB = 704 * MiB;
constexpr size_t WS_VB = 720 * MiB;
constexpr size_t WS_QIB = 736 * MiB;
constexpr size_t WS_KIB = 768 * MiB;
constexpr size_t WS_WIF = 772 * MiB;
constexpr size_t WS_MASK = 776 * MiB;
constexpr size_t WS_LIST = 792 * MiB;
constexpr size_t WS_DB = 808 * MiB;
constexpr size_t WS_S = 880 * MiB;
constexpr size_t S_XS = 0, S_PRES = 131072, S_XSB = 262144, S_GS = 327680, S_QS = 524288, S_QIS = 655360, S_WIS = 720896,
                 S_OS = 786432, S_DS = 851968, S_SC = 1048576;
constexpr size_t WS_END = 884 * MiB;

constexpr int CW_BAR = 4096;

constexpr int RING_OFF = 0, RING_BYTES = 131072;
constexpr int MISC_OFF = RING_BYTES;
constexpr int LDS_BYTES = 147456;
constexpr int NWAVES = 8, NTHREADS = 512;

#define GAS __attribute__((address_space(1)))
#define LAS __attribute__((address_space(3)))
typedef unsigned short bf16;
typedef unsigned v4u __attribute__((ext_vector_type(4)));
typedef unsigned v2u __attribute__((ext_vector_type(2)));
typedef float f32x4 __attribute__((ext_vector_type(4)));
typedef float f32x2 __attribute__((ext_vector_type(2)));
typedef float f32x16 __attribute__((ext_vector_type(16)));
typedef short bf16x8 __attribute__((ext_vector_type(8)));
#define LDS_WAIT() asm volatile("s_waitcnt lgkmcnt(0)" ::: "memory")
#define VM_WAIT() asm volatile("s_waitcnt vmcnt(0)" ::: "memory")
__device__ __forceinline__ unsigned f2bf(float f) { unsigned u = __builtin_bit_cast(unsigned, f); return (u + 0x7fffu + ((u >> 16) & 1u)) >> 16; }
__device__ __forceinline__ unsigned pk2(float lo, float hi) { return f2bf(lo) | (f2bf(hi) << 16); }
__device__ __forceinline__ float bf2f(unsigned short b) { return __builtin_bit_cast(float, (unsigned)b << 16); }
__device__ __forceinline__ float wave_sum(float v) {
#pragma unroll
    for (int o = 1; o < 64; o <<= 1) v += __shfl_xor(v, o);
    return v;
}
__device__ __forceinline__ float wave_max(float v) {
#pragma unroll
    for (int o = 1; o < 64; o <<= 1) v = fmaxf(v, __shfl_xor(v, o));
    return v;
}
__device__ __forceinline__ float wave_min(float v) {
#pragma unroll
    for (int o = 1; o < 64; o <<= 1) v = fminf(v, __shfl_xor(v, o));
    return v;
}
__device__ __forceinline__ float silu_f(float x) { return x * __builtin_amdgcn_rcpf(1.0f + __builtin_amdgcn_exp2f(-1.4426950408889634f * x)); }
__device__ __forceinline__ int mbcnt64(unsigned long long m) { return (int)__builtin_amdgcn_mbcnt_hi((unsigned)(m >> 32), __builtin_amdgcn_mbcnt_lo((unsigned)m, 0u)); }

namespace pg8 {
struct EpiSwiglu {
    static constexpr bool PERM = true, AFTER_DRAIN = false;
    bf16_t* G;
    __device__ __forceinline__ void operator()(const f32x4 (&acc)[2][2][4][2], const Unit& u, int wr, int wc, int fr, int fq) const {
        const int row0 = u.pm * BM + wr * 64 + fr; const int col0 = u.pn * HALF + wc * 32 + 8 * fq;
#pragma unroll
        for (int ai = 0; ai < 2; ++ai)
#pragma unroll
            for (int m = 0; m < 4; ++m) {
                bf16_t* rowp = G + (size_t)(row0 + ai * HALF + m * 16) * FF + col0;
                const f32x4 g0 = acc[ai][0][m][0], g1 = acc[ai][0][m][1], u0 = acc[ai][1][m][0], u1 = acc[ai][1][m][1];
                u32x4 w;
                w.x = cvt_pk_bf16(silu_f(g0[0]) * u0[0], silu_f(g0[1]) * u0[1]); w.y = cvt_pk_bf16(silu_f(g0[2]) * u0[2], silu_f(g0[3]) * u0[3]);
                w.z = cvt_pk_bf16(silu_f(g1[0]) * u1[0], silu_f(g1[1]) * u1[1]); w.w = cvt_pk_bf16(silu_f(g1[2]) * u1[2], silu_f(g1[3]) * u1[3]);
                *(u32x4*)rowp = w;
            }
    }
};
template <bool HAS_CS> struct EpiResid {
    static constexpr bool PERM = false, AFTER_DRAIN = false;
    const float* X; float* P; float s; const float* cs;
    __device__ __forceinline__ void operator()(const f32x4 (&acc)[2][2][4][2], const Unit& u, int wr, int wc, int fr, int fq) const {
        const int row0 = u.pm * BM + wr * 64 + fr; const int col0 = u.pn * BM + wc * 32 + 4 * fq;
        f32x4 sc[2][2];
        if (HAS_CS) {
#pragma unroll
            for (int bj = 0; bj < 2; ++bj)
#pragma unroll
                for (int n = 0; n < 2; ++n) sc[bj][n] = *(const f32x4*)(cs + col0 + bj * HALF + n * 16) * s;
        }
#pragma unroll
        for (int ai = 0; ai < 2; ++ai)
#pragma unroll
            for (int m = 0; m < 4; ++m) {
                const size_t off = (size_t)(row0 + ai * HALF + m * 16) * D + col0;
                const float* xp = X + off; float* pp = P + off;
#pragma unroll
                for (int bj = 0; bj < 2; ++bj)
#pragma unroll
                    for (int n = 0; n < 2; ++n) {
                        const f32x4 x = *(const f32x4*)(xp + bj * HALF + n * 16);
                        if (HAS_CS) *(f32x4*)(pp + bj * HALF + n * 16) = x * ALPHA + acc[ai][bj][m][n] * sc[bj][n];
                        else *(f32x4*)(pp + bj * HALF + n * 16) = x * ALPHA + acc[ai][bj][m][n] * s;
                    }
                asm volatile("" ::: "memory");
            }
    }
};
struct EpiProj {
    static constexpr bool PERM = false, AFTER_DRAIN = false;
    unsigned char* wsb; float* outb;
    __device__ __forceinline__ void operator()(const f32x4 (&acc)[2][2][4][2], const Unit& u, int wr, int wc, int fr, int fq) const {
        const int pn = u.pn;
        const int row0 = u.pm * BM + wr * 64 + fr;
        const bool rot_tile = (pn != 5) && ((wc & 1) == 0) && (pn < 8 || wc == 0);
        const f32x2* rope = (const f32x2*)(wsb + WS_ROPE);
        const float sg = (fq < 2) ? -1.f : 1.f;
        size_t bf_off, f_off = 0; int ldb_, ldf_ = 0, colmax = 256; float scl = 1.f; bool hasf = false;
        if (pn < 4)       { bf_off = WS_QB + (size_t)pn * BM * 2; ldb_ = D; scl = QSCALE; }
        else if (pn == 4) { bf_off = WS_KB; ldb_ = KVW; f_off = O_KP; ldf_ = KVW; hasf = true; }
        else if (pn == 5) { bf_off = WS_VB; ldb_ = KVW; f_off = O_VP; ldf_ = KVW; hasf = true; }
        else if (pn < 8)  { bf_off = WS_QIB + (size_t)(pn - 6) * BM * 2; ldb_ = 512; }
        else              { bf_off = WS_KIB; ldb_ = 64; f_off = O_KIP; ldf_ = 64; hasf = true; colmax = 64; }
        bf16_t* bfb = (bf16_t*)(wsb + bf_off); float* fb = outb + f_off;
#pragma unroll
        for (int ai = 0; ai < 2; ++ai)
#pragma unroll
            for (int m = 0; m < 4; ++m) {
                const int row = row0 + ai * HALF + m * 16; const int pos = row & (SEQ - 1);
#pragma unroll
                for (int bj = 0; bj < 2; ++bj)
#pragma unroll
                    for (int n = 0; n < 2; ++n) {
                        f32x4 v = acc[ai][bj][m][n];
                        const int cit = bj * HALF + wc * 32 + n * 16 + 4 * fq;
                        if (n == 0 && rot_tile && (pn < 8 || bj == 0)) {
                            const f32x2* rp = rope + pos * 8 + 4 * (fq & 1);
#pragma unroll
                            for (int j = 0; j < 4; ++j) {
                                const auto rr = __builtin_amdgcn_permlane32_swap(__float_as_uint(v[j]), __float_as_uint(v[j]), false, false);
                                const float p = __uint_as_float((fq < 2) ? rr[1] : rr[0]);
                                const f32x2 cs = rp[j];
                                v[j] = v[j] * cs.x + sg * p * cs.y;
                            }
                        }
                        if (cit < colmax) {
                            if (hasf) *(f32x4*)(fb + (size_t)row * ldf_ + cit) = v;
                            v = v * scl; v2u w; w.x = cvt_pk_bf16(v[0], v[1]); w.y = cvt_pk_bf16(v[2], v[3]);
                            *(v2u*)(bfb + (size_t)row * ldb_ + cit) = w;
                        } else if (cit < 72) {
                            *(f32x4*)((float*)(wsb + WS_WIF) + (size_t)row * 8 + (cit - 64)) = v;
                        }
                    }
                asm volatile("" ::: "memory");
            }
    }
};
}

#define XB_TMO      128
#define XB_XCNT(j)  (256  + 64 * (j))
#define XB_XSUB(j)  (1280 + 64 * (j))
#define XB_XGEN(j)  (2304 + 64 * (j))
#define XB_TOP      3328
#define XB_TOPGEN   3392
#define XCD_BAR_WORDS 3456
#define XB_SPIN_CAP (1u << 18)
__device__ __forceinline__ unsigned xb_ld(unsigned* p)              { return __hip_atomic_load(p, __ATOMIC_RELAXED, __HIP_MEMORY_SCOPE_AGENT); }
__device__ __forceinline__ unsigned xb_add(unsigned* p, unsigned v) { return __hip_atomic_fetch_add(p, v, __ATOMIC_RELAXED, __HIP_MEMORY_SCOPE_AGENT); }
__device__ __forceinline__ unsigned xb_xcc_id() { return (unsigned)__builtin_amdgcn_s_getreg((3 << 11) | 20) & 0xFu; }
#define XB_SPIN(cond, bar) do { unsigned _sp = 0; while (cond) { __builtin_amdgcn_s_sleep(1); \
    if ((++_sp & 255u) == 0u) { if (xb_ld(&(bar)[XB_TMO])) break; if (_sp > XB_SPIN_CAP) { atomicAdd(&(bar)[XB_TMO], 1u); break; } } } } while (0)
struct XcdBarrier { unsigned* bar; unsigned x; volatile LAS unsigned* st; };
__device__ __forceinline__ XcdBarrier xcd_barrier_post(unsigned* bar, volatile LAS unsigned* st, int tid) {
    XcdBarrier b; b.bar = bar; b.x = xb_xcc_id(); b.st = st;
    if (tid == 0) (void)xb_add(&bar[XB_XCNT(b.x)], 1u);
    return b;
}
__device__ __forceinline__ void xcd_barrier_complete(unsigned* bar, unsigned x, unsigned& nloc, unsigned& nx) {
    const unsigned G = gridDim.x * gridDim.y * gridDim.z;
    unsigned sum, cnt, mine, sp = 0u;
    for (;;) {
        sum = 0u; cnt = 0u; mine = 0u;
#pragma unroll
        for (unsigned j = 0; j < 16; ++j) { const unsigned c = xb_ld(&bar[XB_XCNT(j)]); sum += c; cnt += (c > 0u) ? 1u : 0u; mine = (j == x) ? c : mine; }
        if (sum == G) break;
        __builtin_amdgcn_s_sleep(1);
        if ((++sp & 255u) == 0u) { if (xb_ld(&bar[XB_TMO])) break; if (sp > XB_SPIN_CAP) { atomicAdd(&bar[XB_TMO], 1u); break; } }
    }
    nloc = mine > 0u ? mine : 1u; nx = cnt > 0u ? cnt : 1u;
}
__device__ __forceinline__ void xcd_barrier(const XcdBarrier& b, int tid) {
    asm volatile("s_waitcnt vmcnt(0)" ::: "memory");
    __syncthreads();
    if (tid == 0) {
        unsigned* bar = b.bar;
        __builtin_amdgcn_s_waitcnt(0);
        unsigned nloc = b.st[0], nx = b.st[1];
        if (nloc == 0u) { xcd_barrier_complete(bar, b.x, nloc, nx); b.st[0] = nloc; b.st[1] = nx; }
        const unsigned old = xb_add(&bar[XB_XSUB(b.x)], 1u);
        const unsigned gen = old / nloc;
        if (old + 1u == (gen + 1u) * nloc) {
            __builtin_amdgcn_fence(__ATOMIC_RELEASE, "agent");
            asm volatile("s_waitcnt vmcnt(0)" ::: "memory");
            const unsigned og = xb_add(&bar[XB_TOP], 1u);
            const unsigned tg = og / nx;
            if (og + 1u == (tg + 1u) * nx) xb_add(&bar[XB_TOPGEN], 1u);
            else XB_SPIN(xb_ld(&bar[XB_TOPGEN]) == tg, bar);
            __builtin_amdgcn_fence(__ATOMIC_ACQUIRE, "agent");
            xb_add(&bar[XB_XGEN(b.x)], 1u);
            asm volatile("s_waitcnt vmcnt(0)" ::: "memory");
        } else {
            XB_SPIN(xb_ld(&bar[XB_XGEN(b.x)]) == gen, bar);
            __builtin_amdgcn_fence(__ATOMIC_ACQUIRE, "agent");
            asm volatile("s_waitcnt vmcnt(0)" ::: "memory");
        }
    }
    __syncthreads();
}

__device__ __forceinline__ void tr_item(const float* W, int ldw, int k0, int c0, int ncv, bf16* WT, int ldt, int r0, LAS float* scr, int lane) {
#pragma unroll 8
    for (int i = 0; i < 32; ++i) { const int kk = 2 * i + (lane >> 5), c = lane & 31; scr[kk * 33 + c] = (c < ncv) ? W[(size_t)(k0 + kk) * ldw + c0 + c] : 0.f; }
    LDS_WAIT(); asm volatile("" ::: "memory");
    const int c8 = lane & 7;
#pragma unroll
    for (int j = 0; j < 4; ++j) { const int n = (lane >> 3) + 8 * j; const LAS float* s = scr + (8 * c8) * 33 + n;
        v4u o; o.x = pk2(s[0 * 33], s[1 * 33]); o.y = pk2(s[2 * 33], s[3 * 33]); o.z = pk2(s[4 * 33], s[5 * 33]); o.w = pk2(s[6 * 33], s[7 * 33]);
        *(GAS v4u*)(WT + (size_t)(r0 + n) * ldt + k0 + 8 * c8) = o; }
    LDS_WAIT(); asm volatile("" ::: "memory");
}

__device__ __forceinline__ void ln_row(const float* prow, const float* g, const float* b, float* xf, bf16* xb, float* extra, int lane) {
    const GAS f32x4* xr = (const GAS f32x4*)prow + lane;
    f32x4 v[4]; float s = 0.f;
#pragma unroll
    for (int j = 0; j < 4; ++j) { v[j] = xr[64 * j]; s += (v[j].x + v[j].y) + (v[j].z + v[j].w); }
    const float mean = wave_sum(s) * (1.f / D); float s2 = 0.f;
#pragma unroll
    for (int j = 0; j < 4; ++j) { v[j] = v[j] - mean; s2 += (v[j].x * v[j].x + v[j].y * v[j].y) + (v[j].z * v[j].z + v[j].w * v[j].w); }
    const float rstd = 1.f / sqrtf(wave_sum(s2) * (1.f / D) + LN_EPS);
#pragma unroll
    for (int j = 0; j < 4; ++j) {
        const f32x4 gg = *((const GAS f32x4*)g + lane + 64 * j), bb = *((const GAS f32x4*)b + lane + 64 * j);
        const f32x4 y = v[j] * rstd * gg + bb;
        if (xf) *((GAS f32x4*)xf + lane + 64 * j) = y;
        if (extra) *((GAS f32x4*)extra + lane + 64 * j) = y;
        if (xb) { v2u w; w.x = pk2(y.x, y.y); w.y = pk2(y.z, y.w); *((GAS v2u*)xb + lane + 64 * j) = w; }
    }
}

template <int NT, class Desc>
__device__ __forceinline__ void sgemm32(const bf16* Xb, int lda, const bf16* Bt, int ldb, int K, int nitems, int wg, int nwg, LAS float* red, int tid, const Desc& dsc) {
    asm volatile("" : "+v"(tid));
    const int lane = tid & 63, wid = tid >> 6, r = lane & 31, h = lane >> 5;
    const int kper = K >> 3;
    LAS float* T = red + 8 * NT * 1024;
    for (int it = wg; it < nitems; it += nwg) {
        f32x16 acc[NT];
#pragma unroll
        for (int nt = 0; nt < NT; ++nt) acc[nt] = (f32x16){};
        const bf16* ap = Xb + (size_t)r * lda + dsc.aoff(it) + wid * kper + h * 8;
        const bf16* bp[NT];
#pragma unroll
        for (int nt = 0; nt < NT; ++nt) bp[nt] = Bt + (size_t)(dsc.ct(it, nt) * 32 + r) * ldb + wid * kper + h * 8;
        for (int k = 0; k < kper; k += 16) {
            const bf16x8 a = *(const bf16x8*)(ap + k);
#pragma unroll
            for (int nt = 0; nt < NT; ++nt) { const bf16x8 b = *(const bf16x8*)(bp[nt] + k); acc[nt] = __builtin_amdgcn_mfma_f32_32x32x16_bf16(a, b, acc[nt], 0, 0, 0); }
        }
#pragma unroll
        for (int nt = 0; nt < NT; ++nt)
#pragma unroll
            for (int rr = 0; rr < 16; ++rr) red[(wid * NT + nt) * 1024 + rr * 64 + lane] = acc[nt][rr];
        __syncthreads();
        for (int e = tid; e < NT * 1024; e += NTHREADS) {
            const int nt = e >> 10, x = e & 1023; float s = 0.f;
#pragma unroll
            for (int w = 0; w < 8; ++w) s += red[(w * NT + nt) * 1024 + x];
            const int rr = x >> 6, l = x & 63, j = l & 31, i = (rr & 3) + 8 * (rr >> 2) + 4 * (l >> 5);
            T[nt * 1056 + i * 33 + j] = s;
        }
        __syncthreads();
        dsc.epi(it, T, tid);
        __syncthreads();
    }
}
struct SDescG1 {
    bf16* GS;
    __device__ __forceinline__ int aoff(int) const { return 0; }
    __device__ __forceinline__ int ct(int it, int nt) const { return 8 * (it >> 2) + (it & 3) + 4 * nt; }
    __device__ __forceinline__ void epi(int it, const LAS float* T, int tid) const {
        for (int e = tid; e < 1024; e += NTHREADS) { const int i = e >> 5, j = e & 31; const float g = T[i * 33 + j], u = T[1056 + i * 33 + j];
            GS[i * FF + 128 * (it >> 2) + 32 * (it & 3) + j] = (bf16)f2bf(silu_f(g) * u); }
    }
};
struct SDescResid {
    const float* X; float* P; float s; const float* cs; int agroup;
    __device__ __forceinline__ int aoff(int it) const { return agroup ? 256 * (it >> 3) : 0; }
    __device__ __forceinline__ int ct(int it, int) const { return it; }
    __device__ __forceinline__ void epi(int it, const LAS float* T, int tid) const {
        for (int e = tid; e < 1024; e += NTHREADS) { const int i = e >> 5, j = e & 31, col = it * 32 + j; float a = T[i * 33 + j] * s; if (cs) a *= cs[col];
            P[i * D + col] = ALPHA * X[i * D + col] + a; }
    }
};
struct SDescProj {
    float *QS, *QIS, *WIS, *outK, *outV, *outKI; const f32x2* rope;
    __device__ __forceinline__ int aoff(int) const { return 0; }
    __device__ __forceinline__ int ct(int it, int) const { return it; }
    __device__ __forceinline__ void epi(int it, const LAS float* T, int tid) const {
        for (int e = tid; e < 1024; e += NTHREADS) {
            const int i = e >> 5, j = e & 31, col = it * 32 + j;
            if (col >= NPROJ) continue;
            float v = T[i * 33 + j];
            const bool rot_region = (col < 1280) || (col >= 1536 && col < 2112);
            if (rot_region && ((it & 1) == 0) && j < 16) {
                const int f = j & 7; const float x1 = T[i * 33 + f], x2 = T[i * 33 + f + 8]; const f32x2 cs = rope[f];
                v = (j < 8) ? (x1 * cs.x - x2 * cs.y) : (x2 * cs.x + x1 * cs.y);
            }
            if (col < 1024) QS[i * D + col] = v * QSCALE;
            else if (col < 1280) outK[i * KVW + col - 1024] = v;
            else if (col < 1536) outV[i * KVW + col - 1280] = v;
            else if (col < 2048) QIS[i * 512 + col - 1536] = v;
            else if (col < 2112) outKI[i * 64 + col - 2048] = v;
            else WIS[i * 8 + col - 2112] = v;
        }
    }
};

#define IDX_CNT(OUT, PRED) do { int c_ = 0; _Pragma("unroll") for (int i_ = 0; i_ < 64; ++i_) if (i_ < nreg) c_ += __builtin_popcountll(__ballot(v[i_] PRED)); OUT = c_; } while (0)
__device__ __forceinline__ void index_select_phase(const bf16* QIb, const bf16* KIb, const float* WIf, unsigned* MASK, unsigned short* LIST,
                                                   LAS float* S, int wg, int nwg, int tid) {
    const int wid = __builtin_amdgcn_readfirstlane(tid >> 6);
    const int ngroups = M / 8;
    for (int rd = 0; rd * nwg < ngroups; ++rd) {
        { int l_ = tid; asm volatile("" : "+v"(l_)); tid = l_; }
        const int lane = tid & 63, r = lane & 31, hh = lane >> 5;
        const int o = rd * nwg + ((rd & 1) ? (nwg - 1 - wg) : wg);
        if (o < ngroups) {
            const int qg = o >> 3, b = o & 7, t0 = qg * 8, rb = b * SEQ + t0;
            const int nkt = (t0 + 8 + 31) >> 5;
            bf16x8 A[2][4]; float W[2][16];
#pragma unroll
            for (int mt = 0; mt < 2; ++mt) {
#pragma unroll
                for (int d0 = 0; d0 < 4; ++d0) A[mt][d0] = *(const bf16x8*)(QIb + (size_t)(rb + 4 * mt + (r >> 3)) * 512 + (r & 7) * 64 + d0 * 16 + hh * 8);
#pragma unroll
                for (int rr = 0; rr < 16; ++rr) W[mt][rr] = WIf[(size_t)(rb + 4 * mt + (rr >> 2)) * 8 + (rr & 3) + 4 * hh] * WSCALE;
            }
            for (int kt = wid; kt < nkt; kt += 8) {
                bf16x8 Bf[4];
#pragma unroll
                for (int d0 = 0; d0 < 4; ++d0) Bf[d0] = *(const bf16x8*)(KIb + (size_t)(b * SEQ + kt * 32 + r) * 64 + d0 * 16 + hh * 8);
#pragma unroll
                for (int mt = 0; mt < 2; ++mt) {
                    f32x16 acc = (f32x16){};
#pragma unroll
                    for (int d0 = 0; d0 < 4; ++d0) acc = __builtin_amdgcn_mfma_f32_32x32x16_bf16(A[mt][d0], Bf[d0], acc, 0, 0, 0);
                    float sc[4];
#pragma unroll
                    for (int qq = 0; qq < 4; ++qq) {
                        float a = 0.f;
#pragma unroll
                        for (int e = 0; e < 4; ++e) a += fmaxf(acc[4 * qq + e], 0.f) * W[mt][4 * qq + e];
                        sc[qq] = a + __shfl_xor(a, 32);
                    }
                    const float v0 = hh ? sc[2] : sc[0], v1 = hh ? sc[3] : sc[1];
                    S[(4 * mt + 2 * hh) * 4096 + kt * 32 + r] = v0;
                    S[(4 * mt + 2 * hh + 1) * 4096 + kt * 32 + r] = v1;
                }
            }
        }
        __syncthreads();
        if (o < ngroups) {
            int lane_s = lane; asm volatile("" : "+v"(lane_s));
            const int qg = o >> 3, b = o & 7, t = qg * 8 + wid;
            const size_t grow = (size_t)b * SEQ + t;
            const int nreg = (t >> 6) + 1;
            float v[64];
#pragma unroll
            for (int i = 0; i < 64; ++i) { const int key = i * 64 + lane_s; v[i] = -INFINITY; if (i < nreg) { const float x = S[wid * 4096 + key] + 0.0f; v[i] = (key <= t) ? x : -INFINITY; } }
            const bool all = (t + 1 <= TOPK);
            float T = -INFINITY; int need = 0;
            if (!all) {
                float mn = INFINITY, mx = -INFINITY;
#pragma unroll
                for (int i = 0; i < 64; ++i) { mx = fmaxf(mx, v[i]); mn = fminf(mn, (v[i] == -INFINITY) ? INFINITY : v[i]); }
                float lo = wave_min(mn), hi = wave_max(mx);
                int c; IDX_CNT(c, >= hi);
                if (c >= TOPK) T = hi;
                else {
                    T = lo;
                    for (int itn = 0; itn < 400; ++itn) {
                        const float mid = lo + (hi - lo) * 0.5f;
                        if (!(mid > lo) || !(mid < hi)) { T = lo; break; }
                        IDX_CNT(c, >= mid);
                        if (c == TOPK) { T = mid; break; }
                        if (c > TOPK) lo = mid; else hi = mid;
                        T = lo;
                    }
                }
                int cgt; IDX_CNT(cgt, > T);
                need = TOPK - cgt;
            }
            unsigned mlo = 0u, mhi = 0u; int base = 0;
#pragma unroll
            for (int i = 0; i < 64; ++i) {
                if (i < nreg) {
                    const int key = i * 64 + lane_s;
                    bool gt = all ? (key <= t) : (v[i] > T);
                    bool eq = all ? false : (v[i] == T);
                    unsigned long long meq = __ballot(eq); int k = __builtin_popcountll(meq);
                    if (k > need) { eq = eq && (mbcnt64(meq) < need); meq = __ballot(eq); k = need; }
                    need -= k;
                    const bool sel = gt || eq;
                    const unsigned long long m = __ballot(sel);
                    { const unsigned m0_ = (unsigned)m, m1_ = (unsigned)(m >> 32); asm volatile("v_writelane_b32 %0, %1, %2" : "+v"(mlo) : "s"(m0_), "n"(i)); asm volatile("v_writelane_b32 %0, %1, %2" : "+v"(mhi) : "s"(m1_), "n"(i)); }
                    if (sel) LIST[grow * 256 + base + mbcnt64(m)] = (unsigned short)key;
                    base += __builtin_popcountll(m);
                }
            }
            v2u mw; mw.x = mlo; mw.y = mhi;
            *((v2u*)(MASK + grow * 128) + lane_s) = mw;
        }
        __syncthreads();
    }
}

template <class KR, class VR>
__device__ __forceinline__ void gather_attend(const LAS float* qf, const LAS int* keys, LAS float* pl, int cnt, const KR& kr, const VR& vr, bf16* orow  , int lane) {
    float s[4][4];
#pragma unroll
    for (int c = 0; c < 4; ++c) {
        const int slot = lane + 64 * c; const bool valid = slot < cnt;
        const int key = keys[valid ? slot : 0];
        const float* kp = kr(key);
        float a[4] = {0.f, 0.f, 0.f, 0.f};
#pragma unroll 4
        for (int d4 = 0; d4 < 16; ++d4) {
            const f32x4 kv = *(const f32x4*)(kp + 4 * d4);
#pragma unroll
            for (int g = 0; g < 4; ++g) { const f32x4 qv = *(const LAS f32x4*)(qf + g * 64 + 4 * d4); a[g] += (kv.x * qv.x + kv.y * qv.y) + (kv.z * qv.z + kv.w * qv.w); }
        }
#pragma unroll
        for (int g = 0; g < 4; ++g) s[c][g] = valid ? a[g] : -INFINITY;
    }
    float linv[4];
#pragma unroll
    for (int g = 0; g < 4; ++g) {
        const float mx = wave_max(fmaxf(fmaxf(s[0][g], s[1][g]), fmaxf(s[2][g], s[3][g])));
        float sum = 0.f;
#pragma unroll
        for (int c = 0; c < 4; ++c) { const float p = __builtin_amdgcn_exp2f(s[c][g] - mx); sum += p; pl[g * 256 + lane + 64 * c] = p; }
        linv[g] = 1.0f / wave_sum(sum);
    }
    LDS_WAIT(); asm volatile("" ::: "memory");
    float o[4] = {0.f, 0.f, 0.f, 0.f};
    for (int slot = 0; slot < cnt; ++slot) {
        const int key = keys[slot];
        const float vv = vr(key)[lane];
#pragma unroll
        for (int g = 0; g < 4; ++g) o[g] += pl[g * 256 + slot] * vv;
    }
#pragma unroll
    for (int g = 0; g < 4; ++g) orow[g * 64 + lane] = (bf16)f2bf(o[g] * linv[g]);
    LDS_WAIT(); asm volatile("" ::: "memory");
}
struct RowPlain { const float* base; __device__ __forceinline__ const float* operator()(int key) const { return base + (size_t)key * KVW; } };
struct RowPaged { const float* cache; const float* newrow; const int* pt; int j;
    __device__ __forceinline__ const float* operator()(int key) const {
        if (key >= PAST) return newrow;
        const int phys = pt[key >> 7];
        return cache + ((size_t)(phys * PAGE + (key & (PAGE - 1))) * NKV + j) * 64;
    } };

__device__ __forceinline__ void attn_gather_phase(const bf16* Qb, const float* outK, const float* outV, const unsigned short* LIST, bf16* Ob, LAS unsigned char* lds, int wg, int nwg, int tid) {
    asm volatile("" : "+v"(tid));
    const int lane = tid & 63, wid = tid >> 6;
    LAS float* qf = (LAS float*)(lds + wid * 8192); LAS int* keys = (LAS int*)(lds + wid * 8192 + 1024); LAS float* pl = (LAS float*)(lds + wid * 8192 + 2048);
    const int j = wid & 3;
    for (int pr = wg; pr < M / 2; pr += nwg) {
        const int row = pr * 2 + (wid >> 2); const int b = row >> 12, t = row & (SEQ - 1);
        const int cnt = (t + 1 < TOPK) ? t + 1 : TOPK;
#pragma unroll
        for (int g = 0; g < 4; ++g) qf[g * 64 + lane] = bf2f(Qb[(size_t)row * D + (4 * j + g) * 64 + lane]);
#pragma unroll
        for (int c = 0; c < 4; ++c) keys[lane + 64 * c] = (lane + 64 * c < cnt) ? (int)LIST[(size_t)row * 256 + lane + 64 * c] : 0;
        LDS_WAIT(); asm volatile("" ::: "memory");
        RowPlain kr{outK + (size_t)b * SEQ * KVW + j * 64}, vr{outV + (size_t)b * SEQ * KVW + j * 64};
        gather_attend(qf, keys, pl, cnt, kr, vr, Ob + (size_t)row * D + 4 * j * 64, lane);
    }
}

__device__ __forceinline__ void sample_scores_phase(const float* QIS, const float* WIS, const float* cki, const float* kinew, const int* ptab, float* SC, LAS unsigned char* lds, int wg, int nwg, int tid) {
    asm volatile("" : "+v"(tid));
    const int lane = tid & 63, wid = tid >> 6;
    LAS float* qs = (LAS float*)(lds + wid * 4096);
    for (int it = wg * NWAVES + wid; it < SBT * NPAGES; it += nwg * NWAVES) {
        const int b = it >> 7, pg = it & 127;
#pragma unroll
        for (int i = 0; i < 8; ++i) qs[i * 64 + lane] = QIS[b * 512 + i * 64 + lane];
        if (lane < 8) qs[512 + lane] = WIS[b * 8 + lane] * WSCALE;
        LDS_WAIT(); asm volatile("" ::: "memory");
        const int phys = ptab[b * NPAGES + pg];
#pragma unroll
        for (int kk = 0; kk < 2; ++kk) {
            const int key = lane + 64 * kk;
            const float* kp = cki + ((size_t)phys * PAGE + key) * 64;
            float dot[8] = {0.f, 0.f, 0.f, 0.f, 0.f, 0.f, 0.f, 0.f};
#pragma unroll 4
            for (int d4 = 0; d4 < 16; ++d4) {
                const f32x4 kv = *(const f32x4*)(kp + 4 * d4);
#pragma unroll
                for (int h = 0; h < 8; ++h) { const f32x4 qv = *(const LAS f32x4*)(qs + h * 64 + 4 * d4); dot[h] += (kv.x * qv.x + kv.y * qv.y) + (kv.z * qv.z + kv.w * qv.w); }
            }
            float sc = 0.f;
#pragma unroll
            for (int h = 0; h < 8; ++h) sc += fmaxf(dot[h], 0.f) * qs[512 + h];
            SC[(size_t)b * SCLD + pg * PAGE + key] = sc;
        }
        LDS_WAIT(); asm volatile("" ::: "memory");
    }
    if (wg == nwg - 1 && tid < SBT) {
        const int b = tid; float sc = 0.f;
        for (int h = 0; h < 8; ++h) { float dsum = 0.f; for (int d = 0; d < 64; ++d) dsum += QIS[b * 512 + h * 64 + d] * kinew[b * 64 + d]; sc += fmaxf(dsum, 0.f) * WIS[b * 8 + h] * WSCALE; }
        SC[(size_t)b * SCLD + PAST] = sc;
    }
}

#define SS_CNT(OUT, PRED) do { int c_ = 0; _Pragma("unroll") for (int i_ = 0; i_ < 33; ++i_) c_ += __builtin_popcountll(__ballot(v[i_] PRED)); \
        if (lane == 0) cw[par * 8 + wid] = c_; __syncthreads(); int t_ = 0; _Pragma("unroll") for (int w_ = 0; w_ < 8; ++w_) t_ += cw[par * 8 + w_]; par ^= 1; OUT = t_; } while (0)
__device__ __forceinline__ void sample_select_attend(int b, const float* SC, const float* QS, const float* ck, const float* cv, const float* knew, const float* vnew, const int* ptab,
                                                     bf16* OS, LAS unsigned char* lds, int tid) {
    asm volatile("" : "+v"(tid));
    const int lane = tid & 63, wid = tid >> 6;
    LAS int* cw = (LAS int*)(lds);
    LAS float* cwf = (LAS float*)(lds);
    LAS int* keysL = (LAS int*)(lds + 1024);
    float v[33];
#pragma unroll
    for (int i = 0; i < 33; ++i) { const int key = i * NTHREADS + tid; v[i] = (key < NKEYS_S) ? SC[(size_t)b * SCLD + key] + 0.0f : -INFINITY; }
    float mn = INFINITY, mx = -INFINITY;
#pragma unroll
    for (int i = 0; i < 33; ++i) { mx = fmaxf(mx, v[i]); mn = fminf(mn, (v[i] == -INFINITY) ? INFINITY : v[i]); }
    mn = wave_min(mn); mx = wave_max(mx);
    if (lane == 0) { cwf[16 + wid] = mn; cwf[24 + wid] = mx; }
    if (tid == 0) cw[32] = 0;
    __syncthreads();
    float lo = cwf[16], hi = cwf[24];
#pragma unroll
    for (int w = 1; w < 8; ++w) { lo = fminf(lo, cwf[16 + w]); hi = fmaxf(hi, cwf[24 + w]); }
    int par = 0; int c; float T;
    SS_CNT(c, >= hi);
    if (c >= TOPK) T = hi;
    else {
        T = lo;
        for (int itn = 0; itn < 400; ++itn) {
            const float mid = lo + (hi - lo) * 0.5f;
            if (!(mid > lo) || !(mid < hi)) { T = lo; break; }
            SS_CNT(c, >= mid);
            if (c == TOPK) { T = mid; break; }
            if (c > TOPK) lo = mid; else hi = mid;
            T = lo;
        }
    }
    int cgt; SS_CNT(cgt, > T);
    int need = TOPK - cgt;
    int ceq; SS_CNT(ceq, == T);
#pragma unroll
    for (int i = 0; i < 33; ++i) {
        const bool sel = v[i] > T; const unsigned long long m = __ballot(sel);
        if (m) { int bs = 0; if (lane == 0) bs = atomicAdd((int*)&cw[32], __builtin_popcountll(m)); bs = __builtin_amdgcn_readfirstlane(bs);
            if (sel) keysL[bs + mbcnt64(m)] = i * NTHREADS + tid; }
    }
    if (ceq <= need) {
#pragma unroll
        for (int i = 0; i < 33; ++i) {
            const bool sel = v[i] == T; const unsigned long long m = __ballot(sel);
            if (m) { int bs = 0; if (lane == 0) bs = atomicAdd((int*)&cw[32], __builtin_popcountll(m)); bs = __builtin_amdgcn_readfirstlane(bs);
                if (sel) keysL[bs + mbcnt64(m)] = i * NTHREADS + tid; }
        }
    } else {
        int taken = 0;
#pragma unroll
        for (int i = 0; i < 33; ++i) {
            const bool eq = v[i] == T; const unsigned long long m = __ballot(eq);
            if (lane == 0) cw[40 + wid] = __builtin_popcountll(m);
            __syncthreads();
            int before = taken, tot = 0;
#pragma unroll
            for (int w = 0; w < 8; ++w) { const int kw = cw[40 + w]; if (w < wid) before += kw; tot += kw; }
            const int rank = before + mbcnt64(m);
            if (eq && rank < need) keysL[cgt + rank] = i * NTHREADS + tid;
            taken += tot;
            __syncthreads();
        }
    }
    __syncthreads();
    if (wid < NKV) {
        const int j = wid;
        LAS float* qf = (LAS float*)(lds + 4096 + wid * 8192); LAS float* pl = (LAS float*)(lds + 4096 + wid * 8192 + 1024);
#pragma unroll
        for (int g = 0; g < 4; ++g) qf[g * 64 + lane] = QS[b * D + (4 * j + g) * 64 + lane];
        LDS_WAIT(); asm volatile("" ::: "memory");
        RowPaged kr{ck, knew + b * KVW + j * 64, ptab + b * NPAGES, j}, vr{cv, vnew + b * KVW + j * 64, ptab + b * NPAGES, j};
        gather_attend(qf, keysL, pl, TOPK, kr, vr, OS + b * D + 4 * j * 64, lane);
    }
    __syncthreads();
}

#define RELAUNDER() (({ asm volatile("" : "+s"(pa)); G = G0; wg = wg0; asm volatile("" : "+s"(G), "+s"(wg)); gw = wg * NWAVES + wave; NGW = G * NWAVES; asm volatile("v_mbcnt_lo_u32_b32 %0, -1, 0\n\tv_mbcnt_hi_u32_b32 %0, -1, %0" : "=v"(lane)); tid = wave * 64 + lane; }), true)
struct Args { const void* in[17]; float* out; unsigned char* ws; int ph_lo, ph_hi; };
constexpr int N_PHASES = 21;

__global__ void __launch_bounds__(NTHREADS, 2) fwd(Args args) {
    extern __shared__ __attribute__((aligned(16))) unsigned char lds_raw[];
    LAS unsigned char* lds = (LAS unsigned char*)lds_raw;
#define MISC ((volatile LAS unsigned*)(lds + MISC_OFF))
    int wave = __builtin_amdgcn_readfirstlane((int)threadIdx.x >> 6); asm volatile("" : "+s"(wave));
    int lane, tid; asm volatile("v_mbcnt_lo_u32_b32 %0, -1, 0\n\tv_mbcnt_hi_u32_b32 %0, -1, %0" : "=v"(lane)); tid = wave * 64 + lane;
    const int G0 = gridDim.x, wg0 = blockIdx.x;
    int G = G0, wg = wg0, gw = wg * NWAVES + wave, NGW = G * NWAVES;
    typedef __attribute__((address_space(4))) const Args* kargs_t;
    kargs_t pa = (kargs_t)__builtin_amdgcn_kernarg_segment_ptr();
#define ws (pa->ws)
#define out (pa->out)
#define x_prompt ((const float*)pa->in[0])
#define x_sample ((const float*)pa->in[1])
#define cache_k ((const float*)pa->in[2])
#define cache_v ((const float*)pa->in[3])
#define cache_kidx ((const float*)pa->in[4])
#define state_pool ((const float*)pa->in[5])
#define page_table ((const int*)pa->in[6])
#define ln_g ((const float*)pa->in[7])
#define ln_b ((const float*)pa->in[8])
#define ffn1_wi ((const float*)pa->in[9])
#define ffn1_wo ((const float*)pa->in[10])
#define ffn2_wi ((const float*)pa->in[11])
#define ffn2_wo ((const float*)pa->in[12])
#define attn_w_in ((const float*)pa->in[13])
#define attn_w_o ((const float*)pa->in[14])
#define pool_w ((const float*)pa->in[15])
#define pool_scale ((const float*)pa->in[16])
#define W_WI ((bf16*)(ws + WS_WI))
#define W_WO ((bf16*)(ws + WS_WO))
#define W_IN ((bf16*)(ws + WS_WIN))
#define W_OA ((bf16*)(ws + WS_WOA))
#define W_POOL ((bf16*)(ws + WS_WPOOL))
#define ROPE ((f32x2*)(ws + WS_ROPE))
#define XB ((bf16*)(ws + WS_XB))
#define XA ((float*)(ws + WS_XA))
#define PRE ((float*)(ws + WS_PRE))
#define GB ((bf16*)(ws + WS_G))
#define QB ((bf16*)(ws + WS_QB))
#define OB ((bf16*)(ws + WS_OB))
#define KB ((bf16*)(ws + WS_KB))
#define VB ((bf16*)(ws + WS_VB))
#define QIB ((bf16*)(ws + WS_QIB))
#define KIB ((bf16*)(ws + WS_KIB))
#define WIF ((float*)(ws + WS_WIF))
#define MASK ((unsigned*)(ws + WS_MASK))
#define LIST ((unsigned short*)(ws + WS_LIST))
#define DB ((bf16*)(ws + WS_DB))
#define XS ((float*)(ws + WS_S + S_XS))
#define PRES ((float*)(ws + WS_S + S_PRES))
#define XSB ((bf16*)(ws + WS_S + S_XSB))
#define GS ((bf16*)(ws + WS_S + S_GS))
#define QS ((float*)(ws + WS_S + S_QS))
#define QIS ((float*)(ws + WS_S + S_QIS))
#define WIS ((float*)(ws + WS_S + S_WIS))
#define OS ((bf16*)(ws + WS_S + S_OS))
#define DS ((bf16*)(ws + WS_S + S_DS))
#define SC ((float*)(ws + WS_S + S_SC))
    for (int u = tid; u < 64; u += NTHREADS) MISC[u] = 0u;
    __syncthreads();
    const int lo = pa->ph_lo, hi = pa->ph_hi;
    if (hi - lo > 1) (void)xcd_barrier_post((unsigned*)(ws + WS_CTL) + CW_BAR, MISC + 8, tid);
    int ph = 0;
#define LAUNDER_V(x) asm volatile("" : "+v"(x))
#define LAUNDER_S(x) asm volatile("" : "+s"(x))
#ifndef SITEMASK
#define SITEMASK 0xFFFFFFFFu
#endif
#define PH_ON(k) (((SITEMASK >> (k)) & 1u) && ph >= lo && ph < hi && RELAUNDER())
#define PH_END do { if (ph >= lo && ph + 1 < hi) { RELAUNDER(); XcdBarrier bar_; bar_.bar = (unsigned*)(ws + WS_CTL) + CW_BAR; bar_.x = xb_xcc_id(); bar_.st = (volatile LAS unsigned*)(lds + MISC_OFF) + 8; xcd_barrier(bar_, tid); } ++ph; } while (0)
    LAS float* redS = (LAS float*)(lds + RING_OFF);

    if (PH_ON(0)) {
        LAS float* scr = (LAS float*)(lds + RING_OFF + wave * 16384);
        constexpr int I_WI = 16 * 176, I_WO = 44 * 32, I_IN = 16 * 72, I_OA = 16 * 32, I_PL = 4 * 8;
        constexpr int NIT = 4 * I_WI + 4 * I_WO + I_IN + I_OA + 4 * I_PL;
        for (int it = gw; it < NIT; it += NGW) {
            int r = it;
            if (r < 4 * I_WI) { const int mi = r / I_WI; r -= mi * I_WI; const int kb = r / 176, nb = r % 176; const int n0 = nb * 32, pn = n0 >> 8, i = n0 & 255;
                const int c0 = (i < 128) ? (128 * pn + i) : (FF + 128 * pn + (i - 128));
                tr_item(((mi & 1) ? ffn2_wi : ffn1_wi) + (size_t)(mi >> 1) * D * NWI, NWI, kb * 64, c0, 32, (bf16*)((unsigned char*)W_WI + (size_t)mi * WI_STRIDE), D, n0, scr, lane); continue; }
            r -= 4 * I_WI;
            if (r < 4 * I_WO) { const int mi = r / I_WO; r -= mi * I_WO; const int kb = r / 32, nb = r % 32;
                tr_item(((mi & 1) ? ffn2_wo : ffn1_wo) + (size_t)(mi >> 1) * FF * D, D, kb * 64, nb * 32, 32, (bf16*)((unsigned char*)W_WO + (size_t)mi * WO_STRIDE), FF, nb * 32, scr, lane); continue; }
            r -= 4 * I_WO;
            if (r < I_IN) { const int kb = r / 72, nb = r % 72; const int ncv = NPROJ - nb * 32;
                tr_item(attn_w_in, NPROJ, kb * 64, (ncv > 0) ? nb * 32 : 0, ncv, W_IN, D, nb * 32, scr, lane); continue; }
            r -= I_IN;
            if (r < I_OA) { const int kb = r / 32, nb = r % 32; tr_item(attn_w_o, D, kb * 64, nb * 32, 32, W_OA, D, nb * 32, scr, lane); continue; }
            r -= I_OA;
            { const int g = r / I_PL; r -= g * I_PL; const int kb = r / 8, nb = r % 8; tr_item(pool_w + (size_t)g * 65536, 256, kb * 64, nb * 32, 32, W_POOL, 256, g * 256 + nb * 32, scr, lane); }
        }
        for (size_t i = (size_t)wg * NTHREADS + tid; i < (size_t)(M + SBT) * D / 8; i += (size_t)G * NTHREADS) {
            const float* src = (i < (size_t)M * D / 8) ? x_prompt + i * 8 : x_sample + (i - (size_t)M * D / 8) * 8;
            bf16* dst = (i < (size_t)M * D / 8) ? XB + i * 8 : XSB + (i - (size_t)M * D / 8) * 8;
            const f32x4 a = *(const f32x4*)src, c = *(const f32x4*)(src + 4);
            v4u o; o.x = pk2(a.x, a.y); o.y = pk2(a.z, a.w); o.z = pk2(c.x, c.y); o.w = pk2(c.z, c.w); *(v4u*)dst = o;
        }
        for (int i = wg * NTHREADS + tid; i < 4097 * 8; i += G * NTHREADS) {
            const int p = i >> 3, f = i & 7; const float pos = (p < 4096) ? (float)p : (float)PAST;
            const float freq = (float)pow(500000.0, -(double)f / 8.0);
            const float ang = pos * freq;
            f32x2 cs; cs.x = (float)cos((double)ang); cs.y = (float)sin((double)ang); ROPE[i] = cs;
        }
    }
    PH_END;

    for (int f = 0; f < 4; ++f) {
        const int layer = f >> 1, which = f & 1;
        const bf16* Wi = (const bf16*)((const unsigned char*)W_WI + (size_t)(layer * 2 + which) * WI_STRIDE);
        const bf16* Wo = (const bf16*)((const unsigned char*)W_WO + (size_t)(layer * 2 + which) * WO_STRIDE);
        const float* Xres = (f == 0) ? x_prompt : XA;
        const float* XSres = (f == 0) ? x_sample : XS;
        const int lni = which ? 2 : 0;
        if (PH_ON(1)) {
            { SDescG1 dsc{GS}; sgemm32<2>(XSB, D, Wi, D, D, 88, wg, G, redS, tid, dsc); }
            pg8::Gemm g{XB, Wi, D, D, D, 0}; pg8::StaticOrder S; S.init(M, NWI, G, wg);
            pg8::EpiSwiglu E{GB};
            pg8::gemm_phase<pg8::EpiSwiglu, pg8::StaticOrder, true, true>(lds + RING_OFF, g, S, E, tid);
        }
        PH_END;
        if (PH_ON(2)) {
            { SDescResid dsc{XSres, PRES, 0.5f, nullptr, 0}; sgemm32<1>(GS, FF, Wo, FF, FF, 32, wg, G, redS, tid, dsc); }
            pg8::Gemm g{GB, Wo, FF, FF, FF, 0}; pg8::StaticOrder S; S.init(M, D, G, wg);
            pg8::EpiResid<false> E{Xres, PRE, 0.5f, nullptr};
            pg8::gemm_phase<pg8::EpiResid<false>, pg8::StaticOrder, true, true>(lds + RING_OFF, g, S, E, tid);
        }
        PH_END;
        if (PH_ON(3)) {
            const float* gg = ln_g + (layer * 3 + lni) * D; const float* bb = ln_b + (layer * 3 + lni) * D;
            const bool last = (f == 3);
            for (int m = gw; m < M + SBT; m += NGW) {
                if (m < M) {
                    float* extra = nullptr;
                    if (f == 2 && (m & (SEQ - 1)) >= SEQ - 15) extra = out + O_PP + ((size_t)(m >> 12) * 15 + ((m & (SEQ - 1)) - (SEQ - 15))) * D;
                    ln_row(PRE + (size_t)m * D, gg, bb, last ? out + O_YP + (size_t)m * D : XA + (size_t)m * D, last ? nullptr : XB + (size_t)m * D, extra, lane);
                } else {
                    const int sr = m - M;
                    float* extra = (f == 2) ? out + O_PS + ((size_t)sr * 15 + 14) * D : nullptr;
                    ln_row(PRES + (size_t)sr * D, gg, bb, last ? out + O_YS + (size_t)sr * D : XS + (size_t)sr * D, last ? nullptr : XSB + (size_t)sr * D, extra, lane);
                }
            }
        }
        PH_END;
        if (f == 0) {
            if (PH_ON(4)) {
                { SDescProj dsc{QS, QIS, WIS, out + O_KS, out + O_VS, out + O_KIS, ROPE + 4096 * 8}; sgemm32<1>(XSB, D, W_IN, D, D, 67, wg, G, redS, tid, dsc); }
                pg8::Gemm g{XB, W_IN, D, D, D, 0}; pg8::StaticOrder S; S.init(M, NPROJP, G, wg);
                pg8::EpiProj E{ws, out};
                pg8::gemm_phase<pg8::EpiProj, pg8::StaticOrder, true, true>(lds + RING_OFF, g, S, E, tid);
            }
            PH_END;
            if (PH_ON(5)) {
                sample_scores_phase(QIS, WIS, cache_kidx, out + O_KIS, page_table, SC, lds + RING_OFF, wg, G, tid);
                __syncthreads();
                index_select_phase(QIB, KIB, WIF, MASK, LIST, (LAS float*)(lds + RING_OFF), wg, G, tid);
            }
            PH_END;
            if (PH_ON(6)) {
                if (wg < SBT) sample_select_attend(wg, SC, QS, cache_k, cache_v, out + O_KS, out + O_VS, page_table, OS, lds + RING_OFF, tid);
                __syncthreads();
                attn_gather_phase(QB, out + O_KP, out + O_VP, LIST, OB, lds + RING_OFF, wg, G, tid);
            }
            PH_END;
            if (PH_ON(7)) {
                { SDescResid dsc{XS, PRES, 1.0f, nullptr, 0}; sgemm32<1>(OS, D, W_OA, D, D, 32, wg, G, redS, tid, dsc); }
                pg8::Gemm g{OB, W_OA, D, D, D, 0}; pg8::StaticOrder S; S.init(M, D, G, wg);
                pg8::EpiResid<false> E{XA, PRE, 1.0f, nullptr};
                pg8::gemm_phase<pg8::EpiResid<false>, pg8::StaticOrder, true, true>(lds + RING_OFF, g, S, E, tid);
            }
            PH_END;
            if (PH_ON(8)) {
                const float* gg = ln_g + 1 * D; const float* bb = ln_b + 1 * D;
                for (int m = gw; m < M + SBT; m += NGW) {
                    if (m < M) ln_row(PRE + (size_t)m * D, gg, bb, XA + (size_t)m * D, XB + (size_t)m * D, nullptr, lane);
                    else ln_row(PRES + (size_t)(m - M) * D, gg, bb, XS + (size_t)(m - M) * D, XSB + (size_t)(m - M) * D, nullptr, lane);
                }
            }
            PH_END;
        }
        if (f == 2) {
            if (PH_ON(9)) {
                for (size_t it = (size_t)wg * NTHREADS + tid; it < (size_t)M * 256; it += (size_t)G * NTHREADS) {
                    const int row = (int)(it >> 8), c4 = (int)(it & 255), col = 4 * c4, t = row & (SEQ - 1);
                    const int w = 2 << (c4 >> 6); const int cnt = (t + 1 < w) ? t + 1 : w;
                    const f32x4 xt = *(const f32x4*)(XA + (size_t)row * D + col); f32x4 sum = xt;
                    for (int r = 1; r < cnt; ++r) sum = sum + *(const f32x4*)(XA + (size_t)(row - r) * D + col);
                    const f32x4 d = sum * (1.0f / (float)cnt) - xt;
                    v2u o; o.x = pk2(d.x, d.y); o.y = pk2(d.z, d.w); *(v2u*)(DB + (size_t)row * D + col) = o;
                }
                for (int it = wg * NTHREADS + tid; it < SBT * 256; it += G * NTHREADS) {
                    const int b = it >> 8, c4 = it & 255, col = 4 * c4; const int w = 2 << (c4 >> 6);
                    const f32x4 xt = *(const f32x4*)(XS + b * D + col); f32x4 sum = xt;
                    for (int r = 1; r < w; ++r) sum = sum + *(const f32x4*)(state_pool + ((size_t)b * 15 + (15 - r)) * D + col);
                    const f32x4 d = sum * (1.0f / (float)w) - xt;
                    v2u o; o.x = pk2(d.x, d.y); o.y = pk2(d.z, d.w); *(v2u*)(DS + b * D + col) = o;
                }
                for (int it = wg * NTHREADS + tid; it < SBT * 14 * 256; it += G * NTHREADS) {
                    const int b = it / (14 * 256), rem = it % (14 * 256), r = rem >> 8, c4 = rem & 255;
                    *(f32x4*)(out + O_PS + ((size_t)b * 15 + r) * D + 4 * c4) = *(const f32x4*)(state_pool + ((size_t)b * 15 + r + 1) * D + 4 * c4);
                }
            }
            PH_END;
            if (PH_ON(10)) {
                { SDescResid dsc{XS, PRES, 1.0f, pool_scale, 1}; sgemm32<1>(DS, D, W_POOL, 256, 256, 32, wg, G, redS, tid, dsc); }
                pg8::Gemm g{DB, W_POOL, D, 256, 256, 512}; pg8::StaticOrder S; S.init(M, D, G, wg);
                pg8::EpiResid<true> E{XA, PRE, 1.0f, pool_scale};
                pg8::gemm_phase<pg8::EpiResid<true>, pg8::StaticOrder, true, true>(lds + RING_OFF, g, S, E, tid);
            }
            PH_END;
            if (PH_ON(11)) {
                const float* gg = ln_g + 4 * D; const float* bb = ln_b + 4 * D;
                for (int m = gw; m < M + SBT; m += NGW) {
                    if (m < M) ln_row(PRE + (size_t)m * D, gg, bb, XA + (size_t)m * D, XB + (size_t)m * D, nullptr, lane);
                    else ln_row(PRES + (size_t)(m - M) * D, gg, bb, XS + (size_t)(m - M) * D, XSB + (size_t)(m - M) * D, nullptr, lane);
                }
            }
            PH_END;
        }
    }
#undef PH_ON
#undef PH_END
#undef ws
#undef out
#undef MISC
}

extern "C" void kernel_launch(void* const* d_in, const int* in_sizes, int n_in, void* d_out, int out_size, void* d_ws, size_t ws_size, hipStream_t stream) {
    static int grid = 0;
    if (grid == 0) {
        if (n_in != 17 || out_size != (int)O_END || ws_size < WS_END) { fprintf(stderr, "kernel_launch: unexpected sizes n_in %d out %d ws %zu\n", n_in, out_size, ws_size); grid = -1; return; }
        int dev = 0, cus = 0, per_cu = 0;
        if (hipGetDevice(&dev) != hipSuccess || hipDeviceGetAttribute(&cus, hipDeviceAttributeMultiprocessorCount, dev) != hipSuccess) { grid = -1; return; }
        if (hipFuncSetAttribute((const void*)fwd, hipFuncAttributeMaxDynamicSharedMemorySize, LDS_BYTES) != hipSuccess) { fprintf(stderr, "kernel_launch: hipFuncSetAttribute failed\n"); grid = -1; return; }
        if (hipOccupancyMaxActiveBlocksPerMultiprocessor(&per_cu, (const void*)fwd, NTHREADS, LDS_BYTES) != hipSuccess || per_cu < 1)
            fprintf(stderr, "kernel_launch: note: occupancy query reports %d workgroups per CU\n", per_cu);
        (void)hipGetLastError();
        grid = cus;
    }
    if (grid < 0) return;
    (void)hipMemsetAsync((char*)d_ws + WS_CTL, 0, CTL_ZERO_BYTES, stream);
    Args a{};
    for (int i = 0; i < 17; ++i) a.in[i] = d_in[i];
    a.out = (float*)d_out; a.ws = (unsigned char*)d_ws;
#ifndef MK_ONE_LAUNCH
#define MK_ONE_LAUNCH 1
#endif
    if (MK_ONE_LAUNCH) {
        a.ph_lo = 0; a.ph_hi = N_PHASES;
        hipLaunchKernelGGL(fwd, dim3(grid), dim3(NTHREADS), LDS_BYTES, stream, a);
    } else {
        for (int p = 0; p < N_PHASES; ++p) { a.ph_lo = p; a.ph_hi = p + 1; hipLaunchKernelGGL(fwd, dim3(grid), dim3(NTHREADS), LDS_BYTES, stream, a); }
    }
}
```

```cpp
#include <hip/hip_runtime.h>
#include <cstdio>
#include <cstdint>
#include <cmath>
namespace pg8 {
#define PG8_LAS __attribute__((address_space(3)))
typedef unsigned short bf16_t;
typedef short bf16x8 __attribute__((ext_vector_type(8)));
typedef float f32x4 __attribute__((ext_vector_type(4)));
typedef unsigned u32x4 __attribute__((ext_vector_type(4)));
constexpr int BM = 256, BK = 64, HALF = 128, HTB = HALF * BK * 2  , STAGE_BYTES = 8 * HTB, NXCD = 8, WGM = 8;

__host__ __device__ __forceinline__ int lds_byte(int r, int c) { const int st = (r >> 4) * 2 + (c >> 5), rr = r & 15, cc = c & 31, ob = rr * 64 + cc * 2; return st * 1024 + (ob ^ (((ob >> 9) & 1) << 5)); }
__host__ __device__ __forceinline__ void stage_rc(int b, int& R, int& C) { const int st = b / 1024, sb = b % 1024, swz = sb ^ (((sb >> 9) & 1) << 5); R = (st >> 1) * 16 + swz / 64; C = (st & 1) * 32 + (swz % 64) / 2; }
__host__ __device__ __forceinline__ int perm32(int rho) { const int n = rho >> 4, i = rho & 15; return 8 * (i >> 2) + 4 * n + (i & 3); }

struct Unit { int pm, pn; };
struct Gemm { const bf16_t* A; const bf16_t* Bt; int lda, ldb, K, a_pn_step; };

struct StaticOrder {
    int nM, nN, nwg, G, c;
    __host__ __device__ void init(int M, int N, int G_, int c_) { nM = M / BM; nN = N / BM; nwg = nM * nN; G = G_; c = c_; }
    __host__ __device__ bool next(int i, Unit& u) const {
        const long L = (long)i * G + c; if (L >= nwg) return false;
        int wgid = (int)L; { const int q = nwg / NXCD, r = nwg % NXCD, xcd = wgid % NXCD, off = wgid / NXCD; wgid = (xcd < r ? xcd * (q + 1) : r * (q + 1) + (xcd - r) * q) + off; }
        const int nig = WGM * nN, gid = wgid / nig, fm = gid * WGM, gsz = (nM - fm) < WGM ? (nM - fm) : WGM;
        u.pm = fm + ((wgid % nig) % gsz); u.pn = (wgid % nig) / gsz; return true;
    }
    __device__ __forceinline__ void a_ready(const Unit&) const {}
    __device__ __forceinline__ void done(const Unit&) const {}
};
__device__ __forceinline__ unsigned cvt_pk_bf16(float lo, float hi) { unsigned r; asm volatile("v_cvt_pk_bf16_f32 %0, %1, %2" : "=v"(r) : "v"(lo), "v"(hi)); return r; }
template <class Epi, class Sched, bool ALIGN_EPI = false, bool SP2 = false>
__device__ __forceinline__ void gemm_phase(PG8_LAS unsigned char* lds, const Gemm g, const Sched& S, const Epi& E, int tid_in) {
    int tid_l = tid_in; asm volatile("" : "+v"(tid_l));
    const int tid = tid_l, wid = __builtin_amdgcn_readfirstlane(tid >> 6), lane = tid & 63, wr = wid >> 2, wc = wid & 3, fr = lane & 15, fq = lane >> 4;
    const int K = g.K, nt = K / BK;
    unsigned voffA[2], voffB[2];
#pragma unroll
    for (int i = 0; i < 2; ++i) { int R, C; stage_rc(tid * 16 + i * 8192, R, C); const int Rb = Epi::PERM ? ((R & ~31) + perm32(R & 31)) : R;
        voffA[i] = (unsigned)(R * g.lda + C) * 2u; voffB[i] = (unsigned)(Rb * g.ldb + C) * 2u; }
    const size_t kstep = (size_t)(BK * 2);
    const size_t hstepA = (size_t)HALF * g.lda * 2, hstepB = (size_t)HALF * g.ldb * 2;
    const size_t tstepA = 2 * hstepA, tstepB = 2 * hstepB;
    const unsigned ldsw = (unsigned)wid * 1024u;
    const int aoff = lds_byte(wr * 64 + fr, fq * 8), boff = lds_byte(wc * 32 + fr, fq * 8);
#define PG8_SA(b, h) (((b) * 2 + (h)) * HTB)
#define PG8_SB(b, h) ((4 + (b) * 2 + (h)) * HTB)
#define PG8_STAGE(bufoff, gbase, voff) do { _Pragma("unroll") for (int _i = 0; _i < 2; ++_i) \
        __builtin_amdgcn_global_load_lds((const unsigned*)((const char*)(gbase) + (voff)[_i]), (PG8_LAS unsigned*)(lds + (bufoff) + ldsw + _i * 8192), 16, 0, 0); } while (0)
#define PG8_LDA(dst, b, h) do { _Pragma("unroll") for (int m = 0; m < 4; ++m) _Pragma("unroll") for (int k = 0; k < 2; ++k) dst[m][k] = *(const PG8_LAS bf16x8*)(lds + PG8_SA(b, h) + aoff + m * 2048 + k * 1024); } while (0)
#define PG8_LDB(dst, b, h) do { _Pragma("unroll") for (int n = 0; n < 2; ++n) _Pragma("unroll") for (int k = 0; k < 2; ++k) dst[n][k] = *(const PG8_LAS bf16x8*)(lds + PG8_SB(b, h) + boff + n * 2048 + k * 1024); } while (0)
#define PG8_MMA(ai, bj, At, Bt) do { __builtin_amdgcn_s_setprio(1); _Pragma("unroll") for (int m = 0; m < 4; ++m) _Pragma("unroll") for (int n = 0; n < 2; ++n) _Pragma("unroll") for (int k = 0; k < 2; ++k) \
        acc[ai][bj][m][n] = __builtin_amdgcn_mfma_f32_16x16x32_bf16(Bt[n][k], At[m][k], acc[ai][bj][m][n], 0, 0, 0); __builtin_amdgcn_s_setprio(0); } while (0)
#define PG8_WAIT_V(n) asm volatile("s_waitcnt vmcnt(" #n ")" ::: "memory")
#define PG8_WAIT_L(n) asm volatile("s_waitcnt lgkmcnt(" #n ")" ::: "memory")
#define PG8_BAR __builtin_amdgcn_s_barrier()
#define PG8_SCHED __builtin_amdgcn_sched_barrier(0)
    Unit cur, nxt; int ui = 0;
    if (!S.next(0, cur)) return;
    f32x4 acc[2][2][4][2];
#pragma unroll
    for (int a = 0; a < 2; ++a)
#pragma unroll
        for (int b = 0; b < 2; ++b)
#pragma unroll
            for (int m = 0; m < 4; ++m)
#pragma unroll
                for (int n = 0; n < 2; ++n) acc[a][b][m][n] = (f32x4){0.f, 0.f, 0.f, 0.f};
    bf16x8 At[4][2], B0[2][2], B1[2][2];
    const char* cA = (const char*)g.A + (size_t)cur.pm * tstepA + (size_t)cur.pn * g.a_pn_step; const char* cB = (const char*)g.Bt + (size_t)cur.pn * tstepB;
    S.a_ready(cur);
    if constexpr (SP2) {
        PG8_STAGE(PG8_SB(0, 0), cB, voffB); PG8_STAGE(PG8_SB(0, 1), cB + hstepB, voffB); PG8_STAGE(PG8_SA(0, 0), cA, voffA); PG8_STAGE(PG8_SA(0, 1), cA + hstepA, voffA);
        if (wr == 1) PG8_BAR;
        PG8_WAIT_V(2); PG8_BAR;
        PG8_STAGE(PG8_SB(1, 0), cB + kstep, voffB); PG8_STAGE(PG8_SA(1, 0), cA + kstep, voffA); PG8_STAGE(PG8_SB(1, 1), cB + hstepB + kstep, voffB);
        PG8_WAIT_V(6); PG8_BAR;
    } else {
        PG8_STAGE(PG8_SB(0, 0), cB, voffB); PG8_STAGE(PG8_SA(0, 0), cA, voffA); PG8_STAGE(PG8_SB(0, 1), cB + hstepB, voffB); PG8_STAGE(PG8_SA(0, 1), cA + hstepA, voffA);
        if (wr == 1) PG8_BAR;
        PG8_WAIT_V(4); PG8_BAR;
        PG8_STAGE(PG8_SB(1, 0), cB + kstep, voffB); PG8_STAGE(PG8_SA(1, 0), cA + kstep, voffA); PG8_STAGE(PG8_SB(1, 1), cB + hstepB + kstep, voffB);
        PG8_WAIT_V(6); PG8_BAR;
    }
    for (;;) {
        const bool has_next = S.next(ui + 1, nxt);
        const char* nA = has_next ? (const char*)g.A + (size_t)nxt.pm * tstepA + (size_t)nxt.pn * g.a_pn_step : cA; const char* nB = has_next ? (const char*)g.Bt + (size_t)nxt.pn * tstepB : cB;
        for (int t = 0; t < nt; t += 2) {
            const bool last = (t == nt - 2);
            const char* a1 = cA + (size_t)(t + 1) * kstep;
            const char* a2 = last ? nA : cA + (size_t)(t + 2) * kstep; const char* b2 = last ? nB : cB + (size_t)(t + 2) * kstep;
            const char* a3 = a2 + kstep; const char* b3 = b2 + kstep;
            if (last && has_next) S.a_ready(nxt);
            if constexpr (SP2) {
            PG8_LDB(B0, 0, 0); PG8_LDB(B1, 0, 1); PG8_SCHED; PG8_LDA(At, 0, 0); PG8_STAGE(PG8_SA(1, 1), a1 + hstepA, voffA);
            PG8_WAIT_V(8); PG8_WAIT_L(0); PG8_BAR; PG8_MMA(0, 0, At, B0); PG8_MMA(0, 1, At, B1); PG8_BAR; PG8_SCHED;
            PG8_LDA(At, 0, 1); PG8_STAGE(PG8_SB(0, 0), b2, voffB); PG8_STAGE(PG8_SB(0, 1), b2 + hstepB, voffB); PG8_STAGE(PG8_SA(0, 0), a2, voffA);
            PG8_WAIT_V(8); PG8_WAIT_L(0); PG8_BAR; PG8_MMA(1, 0, At, B0); PG8_MMA(1, 1, At, B1); PG8_BAR; PG8_SCHED;
            PG8_LDB(B0, 1, 0); PG8_LDB(B1, 1, 1); PG8_SCHED; PG8_LDA(At, 1, 0); PG8_STAGE(PG8_SA(0, 1), a2 + hstepA, voffA);
            PG8_WAIT_V(8); PG8_WAIT_L(0); PG8_BAR; PG8_MMA(0, 0, At, B0); PG8_MMA(0, 1, At, B1); PG8_BAR; PG8_SCHED;
            PG8_LDA(At, 1, 1); PG8_STAGE(PG8_SB(1, 0), b3, voffB); PG8_STAGE(PG8_SB(1, 1), b3 + hstepB, voffB); PG8_STAGE(PG8_SA(1, 0), a3, voffA);
            PG8_WAIT_V(8); PG8_WAIT_L(0); PG8_BAR; PG8_MMA(1, 0, At, B0); PG8_MMA(1, 1, At, B1); PG8_BAR; PG8_SCHED;
            } else {
            PG8_LDB(B0, 0, 0); PG8_SCHED; PG8_LDA(At, 0, 0); PG8_STAGE(PG8_SA(1, 1), a1 + hstepA, voffA);
            PG8_WAIT_L(8); PG8_BAR; PG8_WAIT_L(0); PG8_MMA(0, 0, At, B0); PG8_BAR; PG8_SCHED;
            PG8_LDB(B1, 0, 1); PG8_STAGE(PG8_SB(0, 0), b2, voffB);
            PG8_BAR; PG8_WAIT_L(0); PG8_MMA(0, 1, At, B1); PG8_BAR;
            PG8_LDA(At, 0, 1); PG8_STAGE(PG8_SA(0, 0), a2, voffA);
            PG8_BAR; PG8_WAIT_L(0); PG8_MMA(1, 0, At, B0); PG8_BAR; PG8_SCHED;
            PG8_STAGE(PG8_SB(0, 1), b2 + hstepB, voffB);
            PG8_WAIT_V(6); PG8_BAR; PG8_MMA(1, 1, At, B1); PG8_BAR;
            PG8_LDB(B0, 1, 0); PG8_SCHED; PG8_LDA(At, 1, 0); PG8_STAGE(PG8_SA(0, 1), a2 + hstepA, voffA);
            PG8_WAIT_L(8); PG8_BAR; PG8_WAIT_L(0); PG8_MMA(0, 0, At, B0); PG8_BAR; PG8_SCHED;
            PG8_LDB(B1, 1, 1); PG8_STAGE(PG8_SB(1, 0), b3, voffB);
            PG8_BAR; PG8_WAIT_L(0); PG8_MMA(0, 1, At, B1); PG8_BAR;
            PG8_LDA(At, 1, 1); PG8_STAGE(PG8_SA(1, 0), a3, voffA);
            PG8_BAR; PG8_WAIT_L(0); PG8_MMA(1, 0, At, B0); PG8_BAR; PG8_SCHED;
            PG8_STAGE(PG8_SB(1, 1), b3 + hstepB, voffB);
            PG8_WAIT_V(6); PG8_BAR; PG8_MMA(1, 1, At, B1); PG8_BAR;
            }
        }
        if constexpr (ALIGN_EPI) { if (wr == 0) PG8_BAR; }
        if constexpr (!Epi::AFTER_DRAIN) { int l2_; asm volatile("v_mbcnt_lo_u32_b32 %0, -1, 0\n\tv_mbcnt_hi_u32_b32 %0, -1, %0" : "=v"(l2_)); E(acc, cur, wr, wc, l2_ & 15, l2_ >> 4); S.done(cur); }
        if (!has_next) break;
#pragma unroll
        for (int a = 0; a < 2; ++a)
#pragma unroll
            for (int b = 0; b < 2; ++b)
#pragma unroll
                for (int m = 0; m < 4; ++m)
#pragma unroll
                    for (int n = 0; n < 2; ++n) acc[a][b][m][n] = (f32x4){0.f, 0.f, 0.f, 0.f};
        cur = nxt; cA = nA; cB = nB; ++ui;
        if constexpr (ALIGN_EPI) { if (wr == 1) PG8_BAR; }
    }
    PG8_WAIT_V(0);
    if constexpr (!ALIGN_EPI) { if (wr == 0) PG8_BAR; }
    PG8_BAR;
    if constexpr (Epi::AFTER_DRAIN) { E.fused(acc, cur, wr, wc, fr, fq, lds, wid, lane); S.done(cur); }
#undef PG8_SA
#undef PG8_SB
#undef PG8_STAGE
#undef PG8_LDA
#undef PG8_LDB
#undef PG8_MMA
#undef PG8_WAIT_V
#undef PG8_WAIT_L
#undef PG8_BAR
#undef PG8_SCHED
}
}

constexpr int D = 1024, BATCH = 8, SEQ = 4096, M = BATCH * SEQ, SBT = 32;
constexpr int FF = 2816, NWI = 2 * FF;
constexpr int NKV = 4, KVW = 256;
constexpr int NPROJ = 2120, NPROJP = 2304;
constexpr int PAST = 16384, PAGE = 128, NPAGES = 128;
constexpr int NKEYS_S = PAST + 1, SCLD = 16448;
constexpr int TOPK = 256;
constexpr float LN_EPS = 1e-5f;
constexpr float ALPHA = 1.4142135623730951f;
constexpr float QSCALE = 0.125f * 1.4426950408889634f;
constexpr float WSCALE = 0.125f * 0.35355339059327373f;

constexpr size_t O_YP = 0, O_YS = 33554432, O_KP = 33587200, O_VP = 41975808, O_KIP = 50364416, O_PP = 52461568,
                 O_KS = 52584448, O_VS = 52592640, O_KIS = 52600832, O_PS = 52602880, O_END = 53094400;

constexpr size_t MiB = 1u << 20;
constexpr size_t WS_CTL = 0, CTL_ZERO_BYTES = 1 * MiB;
constexpr size_t WS_WI = 2 * MiB;
constexpr size_t WI_STRIDE = 11 * MiB;
constexpr size_t WS_WO = 46 * MiB;
constexpr size_t WO_STRIDE = (size_t)D * FF * 2;
constexpr size_t WS_WIN = 68 * MiB;
constexpr size_t WS_WOA = 73 * MiB;
constexpr size_t WS_WPOOL = 75 * MiB;
constexpr size_t WS_ROPE = 76 * MiB;
constexpr size_t WS_XB = 80 * MiB;
constexpr size_t WS_XA = 144 * MiB;
constexpr size_t WS_PRE = 272 * MiB;
constexpr size_t WS_G = 400 * MiB;
constexpr size_t WS_QB = 576 * MiB;
constexpr size_t WS_OB = 640 * MiB;
constexpr size_t WS_KB = 704 * MiB;
constexpr size_t WS_VB = 720 * MiB;
constexpr size_t WS_QIB = 736 * MiB;
constexpr size_t WS_KIB = 768 * MiB;
constexpr size_t WS_WIF = 772 * MiB;
constexpr size_t WS_MASK = 776 * MiB;
constexpr size_t WS_LIST = 792 * MiB;
constexpr size_t WS_DB = 808 * MiB;
constexpr size_t WS_S = 880 * MiB;
constexpr size_t S_XS = 0, S_PRES = 131072, S_XSB = 262144, S_GS = 327680, S_QS = 524288, S_QIS = 655360, S_WIS = 720896,
                 S_OS = 786432, S_DS = 851968, S_SC = 1048576;
constexpr size_t WS_END = 884 * MiB;

constexpr int CW_BAR = 4096;

constexpr int RING_OFF = 0, RING_BYTES = 131072;
constexpr int MISC_OFF = RING_BYTES;
constexpr int LDS_BYTES = 147456;
constexpr int NWAVES = 8, NTHREADS = 512;

#define GAS __attribute__((address_space(1)))
#define LAS __attribute__((address_space(3)))
typedef unsigned short bf16;
typedef unsigned v4u __attribute__((ext_vector_type(4)));
typedef unsigned v2u __attribute__((ext_vector_type(2)));
typedef float f32x4 __attribute__((ext_vector_type(4)));
typedef float f32x2 __attribute__((ext_vector_type(2)));
typedef float f32x16 __attribute__((ext_vector_type(16)));
typedef short bf16x8 __attribute__((ext_vector_type(8)));
#define LDS_WAIT() asm volatile("s_waitcnt lgkmcnt(0)" ::: "memory")
#define VM_WAIT() asm volatile("s_waitcnt vmcnt(0)" ::: "memory")
__device__ __forceinline__ unsigned f2bf(float f) { unsigned u = __builtin_bit_cast(unsigned, f); return (u + 0x7fffu + ((u >> 16) & 1u)) >> 16; }
__device__ __forceinline__ unsigned pk2(float lo, float hi) { return f2bf(lo) | (f2bf(hi) << 16); }
__device__ __forceinline__ float bf2f(unsigned short b) { return __builtin_bit_cast(float, (unsigned)b << 16); }
__device__ __forceinline__ float wave_sum(float v) {
#pragma unroll
    for (int o = 1; o < 64; o <<= 1) v += __shfl_xor(v, o);
    return v;
}
__device__ __forceinline__ float wave_max(float v) {
#pragma unroll
    for (int o = 1; o < 64; o <<= 1) v = fmaxf(v, __shfl_xor(v, o));
    return v;
}
__device__ __forceinline__ float wave_min(float v) {
#pragma unroll
    for (int o = 1; o < 64; o <<= 1) v = fminf(v, __shfl_xor(v, o));
    return v;
}
__device__ __forceinline__ float silu_f(float x) { return x * __builtin_amdgcn_rcpf(1.0f + __builtin_amdgcn_exp2f(-1.4426950408889634f * x)); }
__device__ __forceinline__ int mbcnt64(unsigned long long m) { return (int)__builtin_amdgcn_mbcnt_hi((unsigned)(m >> 32), __builtin_amdgcn_mbcnt_lo((unsigned)m, 0u)); }

namespace pg8 {
struct EpiSwiglu {
    static constexpr bool PERM = true, AFTER_DRAIN = false;
    bf16_t* G;
    __device__ __forceinline__ void operator()(const f32x4 (&acc)[2][2][4][2], const Unit& u, int wr, int wc, int fr, int fq) const {
        const int row0 = u.pm * BM + wr * 64 + fr; const int col0 = u.pn * HALF + wc * 32 + 8 * fq;
#pragma unroll
        for (int ai = 0; ai < 2; ++ai)
#pragma unroll
            for (int m = 0; m < 4; ++m) {
                bf16_t* rowp = G + (size_t)(row0 + ai * HALF + m * 16) * FF + col0;
                const f32x4 g0 = acc[ai][0][m][0], g1 = acc[ai][0][m][1], u0 = acc[ai][1][m][0], u1 = acc[ai][1][m][1];
                u32x4 w;
                w.x = cvt_pk_bf16(silu_f(g0[0]) * u0[0], silu_f(g0[1]) * u0[1]); w.y = cvt_pk_bf16(silu_f(g0[2]) * u0[2], silu_f(g0[3]) * u0[3]);
                w.z = cvt_pk_bf16(silu_f(g1[0]) * u1[0], silu_f(g1[1]) * u1[1]); w.w = cvt_pk_bf16(silu_f(g1[2]) * u1[2], silu_f(g1[3]) * u1[3]);
                *(u32x4*)rowp = w;
            }
    }
};
template <bool HAS_CS> struct EpiResid {
    static constexpr bool PERM = false, AFTER_DRAIN = false;
    const float* X; float* P; float s; const float* cs;
    __device__ __forceinline__ void operator()(const f32x4 (&acc)[2][2][4][2], const Unit& u, int wr, int wc, int fr, int fq) const {
        const int row0 = u.pm * BM + wr * 64 + fr; const int col0 = u.pn * BM + wc * 32 + 4 * fq;
        f32x4 sc[2][2];
        if (HAS_CS) {
#pragma unroll
            for (int bj = 0; bj < 2; ++bj)
#pragma unroll
                for (int n = 0; n < 2; ++n) sc[bj][n] = *(const f32x4*)(cs + col0 + bj * HALF + n * 16) * s;
        }
#pragma unroll
        for (int ai = 0; ai < 2; ++ai)
#pragma unroll
            for (int m = 0; m < 4; ++m) {
                const size_t off = (size_t)(row0 + ai * HALF + m * 16) * D + col0;
                const float* xp = X + off; float* pp = P + off;
#pragma unroll
                for (int bj = 0; bj < 2; ++bj)
#pragma unroll
                    for (int n = 0; n < 2; ++n) {
                        const f32x4 x = *(const f32x4*)(xp + bj * HALF + n * 16);
                        if (HAS_CS) *(f32x4*)(pp + bj * HALF + n * 16) = x * ALPHA + acc[ai][bj][m][n] * sc[bj][n];
                        else *(f32x4*)(pp + bj * HALF + n * 16) = x * ALPHA + acc[ai][bj][m][n] * s;
                    }
                asm volatile("" ::: "memory");
            }
    }
};
struct EpiProj {
    static constexpr bool PERM = false, AFTER_DRAIN = false;
    unsigned char* wsb; float* outb;
    __device__ __forceinline__ void operator()(const f32x4 (&acc)[2][2][4][2], const Unit& u, int wr, int wc, int fr, int fq) const {
        const int pn = u.pn;
        const int row0 = u.pm * BM + wr * 64 + fr;
        const bool rot_tile = (pn != 5) && ((wc & 1) == 0) && (pn < 8 || wc == 0);
        const f32x2* rope = (const f32x2*)(wsb + WS_ROPE);
        const float sg = (fq < 2) ? -1.f : 1.f;
        size_t bf_off, f_off = 0; int ldb_, ldf_ = 0, colmax = 256; float scl = 1.f; bool hasf = false;
        if (pn < 4)       { bf_off = WS_QB + (size_t)pn * BM * 2; ldb_ = D; scl = QSCALE; }
        else if (pn == 4) { bf_off = WS_KB; ldb_ = KVW; f_off = O_KP; ldf_ = KVW; hasf = true; }
        else if (pn == 5) { bf_off = WS_VB; ldb_ = KVW; f_off = O_VP; ldf_ = KVW; hasf = true; }
        else if (pn < 8)  { bf_off = WS_QIB + (size_t)(pn - 6) * BM * 2; ldb_ = 512; }
        else              { bf_off = WS_KIB; ldb_ = 64; f_off = O_KIP; ldf_ = 64; hasf = true; colmax = 64; }
        bf16_t* bfb = (bf16_t*)(wsb + bf_off); float* fb = outb + f_off;
#pragma unroll
        for (int ai = 0; ai < 2; ++ai)
#pragma unroll
            for (int m = 0; m < 4; ++m) {
                const int row = row0 + ai * HALF + m * 16; const int pos = row & (SEQ - 1);
#pragma unroll
                for (int bj = 0; bj < 2; ++bj)
#pragma unroll
                    for (int n = 0; n < 2; ++n) {
                        f32x4 v = acc[ai][bj][m][n];
                        const int cit = bj * HALF + wc * 32 + n * 16 + 4 * fq;
                        if (n == 0 && rot_tile && (pn < 8 || bj == 0)) {
                            const f32x2* rp = rope + pos * 8 + 4 * (fq & 1);
#pragma unroll
                            for (int j = 0; j < 4; ++j) {
                                const auto rr = __builtin_amdgcn_permlane32_swap(__float_as_uint(v[j]), __float_as_uint(v[j]), false, false);
                                const float p = __uint_as_float((fq < 2) ? rr[1] : rr[0]);
                                const f32x2 cs = rp[j];
                                v[j] = v[j] * cs.x + sg * p * cs.y;
                            }
                        }
                        if (cit < colmax) {
                            if (hasf) *(f32x4*)(fb + (size_t)row * ldf_ + cit) = v;
                            v = v * scl; v2u w; w.x = cvt_pk_bf16(v[0], v[1]); w.y = cvt_pk_bf16(v[2], v[3]);
                            *(v2u*)(bfb + (size_t)row * ldb_ + cit) = w;
                        } else if (cit < 72) {
                            *(f32x4*)((float*)(wsb + WS_WIF) + (size_t)row * 8 + (cit - 64)) = v;
                        }
                    }
                asm volatile("" ::: "memory");
            }
    }
};
}

#define XB_TMO      128
#define XB_XCNT(j)  (256  + 64 * (j))
#define XB_XSUB(j)  (1280 + 64 * (j))
#define XB_XGEN(j)  (2304 + 64 * (j))
#define XB_TOP      3328
#define XB_TOPGEN   3392
#define XCD_BAR_WORDS 3456
#define XB_SPIN_CAP (1u << 18)
__device__ __forceinline__ unsigned xb_ld(unsigned* p)              { return __hip_atomic_load(p, __ATOMIC_RELAXED, __HIP_MEMORY_SCOPE_AGENT); }
__device__ __forceinline__ unsigned xb_add(unsigned* p, unsigned v) { return __hip_atomic_fetch_add(p, v, __ATOMIC_RELAXED, __HIP_MEMORY_SCOPE_AGENT); }
__device__ __forceinline__ unsigned xb_xcc_id() { return (unsigned)__builtin_amdgcn_s_getreg((3 << 11) | 20) & 0xFu; }
#define XB_SPIN(cond, bar) do { unsigned _sp = 0; while (cond) { __builtin_amdgcn_s_sleep(1); \
    if ((++_sp & 255u) == 0u) { if (xb_ld(&(bar)[XB_TMO])) break; if (_sp > XB_SPIN_CAP) { atomicAdd(&(bar)[XB_TMO], 1u); break; } } } } while (0)
struct XcdBarrier { unsigned* bar; unsigned x; volatile LAS unsigned* st; };
__device__ __forceinline__ XcdBarrier xcd_barrier_post(unsigned* bar, volatile LAS unsigned* st, int tid) {
    XcdBarrier b; b.bar = bar; b.x = xb_xcc_id(); b.st = st;
    if (tid == 0) (void)xb_add(&bar[XB_XCNT(b.x)], 1u);
    return b;
}
__device__ __forceinline__ void xcd_barrier_complete(unsigned* bar, unsigned x, unsigned& nloc, unsigned& nx) {
    const unsigned G = gridDim.x * gridDim.y * gridDim.z;
    unsigned sum, cnt, mine, sp = 0u;
    for (;;) {
        sum = 0u; cnt = 0u; mine = 0u;
#pragma unroll
        for (unsigned j = 0; j < 16; ++j) { const unsigned c = xb_ld(&bar[XB_XCNT(j)]); sum += c; cnt += (c > 0u) ? 1u : 0u; mine = (j == x) ? c : mine; }
        if (sum == G) break;
        __builtin_amdgcn_s_sleep(1);
        if ((++sp & 255u) == 0u) { if (xb_ld(&bar[XB_TMO])) break; if (sp > XB_SPIN_CAP) { atomicAdd(&bar[XB_TMO], 1u); break; } }
    }
    nloc = mine > 0u ? mine : 1u; nx = cnt > 0u ? cnt : 1u;
}
__device__ __forceinline__ void xcd_barrier(const XcdBarrier& b, int tid) {
    asm volatile("s_waitcnt vmcnt(0)" ::: "memory");
    __syncthreads();
    if (tid == 0) {
        unsigned* bar = b.bar;
        __builtin_amdgcn_s_waitcnt(0);
        unsigned nloc = b.st[0], nx = b.st[1];
        if (nloc == 0u) { xcd_barrier_complete(bar, b.x, nloc, nx); b.st[0] = nloc; b.st[1] = nx; }
        const unsigned old = xb_add(&bar[XB_XSUB(b.x)], 1u);
        const unsigned gen = old / nloc;
        if (old + 1u == (gen + 1u) * nloc) {
            __builtin_amdgcn_fence(__ATOMIC_RELEASE, "agent");
            asm volatile("s_waitcnt vmcnt(0)" ::: "memory");
            const unsigned og = xb_add(&bar[XB_TOP], 1u);
            const unsigned tg = og / nx;
            if (og + 1u == (tg + 1u) * nx) xb_add(&bar[XB_TOPGEN], 1u);
            else XB_SPIN(xb_ld(&bar[XB_TOPGEN]) == tg, bar);
            __builtin_amdgcn_fence(__ATOMIC_ACQUIRE, "agent");
            xb_add(&bar[XB_XGEN(b.x)], 1u);
            asm volatile("s_waitcnt vmcnt(0)" ::: "memory");
        } else {
            XB_SPIN(xb_ld(&bar[XB_XGEN(b.x)]) == gen, bar);
            __builtin_amdgcn_fence(__ATOMIC_ACQUIRE, "agent");
            asm volatile("s_waitcnt vmcnt(0)" ::: "memory");
        }
    }
    __syncthreads();
}

__device__ __forceinline__ void tr_item(const float* W, int ldw, int k0, int c0, int ncv, bf16* WT, int ldt, int r0, LAS float* scr, int lane) {
#pragma unroll 8
    for (int i = 0; i < 32; ++i) { const int kk = 2 * i + (lane >> 5), c = lane & 31; scr[kk * 33 + c] = (c < ncv) ? W[(size_t)(k0 + kk) * ldw + c0 + c] : 0.f; }
    LDS_WAIT(); asm volatile("" ::: "memory");
    const int c8 = lane & 7;
#pragma unroll
    for (int j = 0; j < 4; ++j) { const int n = (lane >> 3) + 8 * j; const LAS float* s = scr + (8 * c8) * 33 + n;
        v4u o; o.x = pk2(s[0 * 33], s[1 * 33]); o.y = pk2(s[2 * 33], s[3 * 33]); o.z = pk2(s[4 * 33], s[5 * 33]); o.w = pk2(s[6 * 33], s[7 * 33]);
        *(GAS v4u*)(WT + (size_t)(r0 + n) * ldt + k0 + 8 * c8) = o; }
    LDS_WAIT(); asm volatile("" ::: "memory");
}

__device__ __forceinline__ void ln_row(const float* prow, const float* g, const float* b, float* xf, bf16* xb, float* extra, int lane) {
    const GAS f32x4* xr = (const GAS f32x4*)prow + lane;
    f32x4 v[4]; float s = 0.f;
#pragma unroll
    for (int j = 0; j < 4; ++j) { v[j] = xr[64 * j]; s += (v[j].x + v[j].y) + (v[j].z + v[j].w); }
    const float mean = wave_sum(s) * (1.f / D); float s2 = 0.f;
#pragma unroll
    for (int j = 0; j < 4; ++j) { v[j] = v[j] - mean; s2 += (v[j].x * v[j].x + v[j].y * v[j].y) + (v[j].z * v[j].z + v[j].w * v[j].w); }
    const float rstd = 1.f / sqrtf(wave_sum(s2) * (1.f / D) + LN_EPS);
#pragma unroll
    for (int j = 0; j < 4; ++j) {
        const f32x4 gg = *((const GAS f32x4*)g + lane + 64 * j), bb = *((const GAS f32x4*)b + lane + 64 * j);
        const f32x4 y = v[j] * rstd * gg + bb;
        if (xf) *((GAS f32x4*)xf + lane + 64 * j) = y;
        if (extra) *((GAS f32x4*)extra + lane + 64 * j) = y;
        if (xb) { v2u w; w.x = pk2(y.x, y.y); w.y = pk2(y.z, y.w); *((GAS v2u*)xb + lane + 64 * j) = w; }
    }
}

template <int NT, class Desc>
__device__ __forceinline__ void sgemm32(const bf16* Xb, int lda, const bf16* Bt, int ldb, int K, int nitems, int wg, int nwg, LAS float* red, int tid, const Desc& dsc) {
    asm volatile("" : "+v"(tid));
    const int lane = tid & 63, wid = tid >> 6, r = lane & 31, h = lane >> 5;
    const int kper = K >> 3;
    LAS float* T = red + 8 * NT * 1024;
    for (int it = wg; it < nitems; it += nwg) {
        f32x16 acc[NT];
#pragma unroll
        for (int nt = 0; nt < NT; ++nt) acc[nt] = (f32x16){};
        const bf16* ap = Xb + (size_t)r * lda + dsc.aoff(it) + wid * kper + h * 8;
        const bf16* bp[NT];
#pragma unroll
        for (int nt = 0; nt < NT; ++nt) bp[nt] = Bt + (size_t)(dsc.ct(it, nt) * 32 + r) * ldb + wid * kper + h * 8;
        for (int k = 0; k < kper; k += 16) {
            const bf16x8 a = *(const bf16x8*)(ap + k);
#pragma unroll
            for (int nt = 0; nt < NT; ++nt) { const bf16x8 b = *(const bf16x8*)(bp[nt] + k); acc[nt] = __builtin_amdgcn_mfma_f32_32x32x16_bf16(a, b, acc[nt], 0, 0, 0); }
        }
#pragma unroll
        for (int nt = 0; nt < NT; ++nt)
#pragma unroll
            for (int rr = 0; rr < 16; ++rr) red[(wid * NT + nt) * 1024 + rr * 64 + lane] = acc[nt][rr];
        __syncthreads();
        for (int e = tid; e < NT * 1024; e += NTHREADS) {
            const int nt = e >> 10, x = e & 1023; float s = 0.f;
#pragma unroll
            for (int w = 0; w < 8; ++w) s += red[(w * NT + nt) * 1024 + x];
            const int rr = x >> 6, l = x & 63, j = l & 31, i = (rr & 3) + 8 * (rr >> 2) + 4 * (l >> 5);
            T[nt * 1056 + i * 33 + j] = s;
        }
        __syncthreads();
        dsc.epi(it, T, tid);
        __syncthreads();
    }
}
struct SDescG1 {
    bf16* GS;
    __device__ __forceinline__ int aoff(int) const { return 0; }
    __device__ __forceinline__ int ct(int it, int nt) const { return 8 * (it >> 2) + (it & 3) + 4 * nt; }
    __device__ __forceinline__ void epi(int it, const LAS float* T, int tid) const {
        for (int e = tid; e < 1024; e += NTHREADS) { const int i = e >> 5, j = e & 31; const float g = T[i * 33 + j], u = T[1056 + i * 33 + j];
            GS[i * FF + 128 * (it >> 2) + 32 * (it & 3) + j] = (bf16)f2bf(silu_f(g) * u); }
    }
};
struct SDescResid {
    const float* X; float* P; float s; const float* cs; int agroup;
    __device__ __forceinline__ int aoff(int it) const { return agroup ? 256 * (it >> 3) : 0; }
    __device__ __forceinline__ int ct(int it, int) const { return it; }
    __device__ __forceinline__ void epi(int it, const LAS float* T, int tid) const {
        for (int e = tid; e < 1024; e += NTHREADS) { const int i = e >> 5, j = e & 31, col = it * 32 + j; float a = T[i * 33 + j] * s; if (cs) a *= cs[col];
            P[i * D + col] = ALPHA * X[i * D + col] + a; }
    }
};
struct SDescProj {
    float *QS, *QIS, *WIS, *outK, *outV, *outKI; const f32x2* rope;
    __device__ __forceinline__ int aoff(int) const { return 0; }
    __device__ __forceinline__ int ct(int it, int) const { return it; }
    __device__ __forceinline__ void epi(int it, const LAS float* T, int tid) const {
        for (int e = tid; e < 1024; e += NTHREADS) {
            const int i = e >> 5, j = e & 31, col = it * 32 + j;
            if (col >= NPROJ) continue;
            float v = T[i * 33 + j];
            const bool rot_region = (col < 1280) || (col >= 1536 && col < 2112);
            if (rot_region && ((it & 1) == 0) && j < 16) {
                const int f = j & 7; const float x1 = T[i * 33 + f], x2 = T[i * 33 + f + 8]; const f32x2 cs = rope[f];
                v = (j < 8) ? (x1 * cs.x - x2 * cs.y) : (x2 * cs.x + x1 * cs.y);
            }
            if (col < 1024) QS[i * D + col] = v * QSCALE;
            else if (col < 1280) outK[i * KVW + col - 1024] = v;
            else if (col < 1536) outV[i * KVW + col - 1280] = v;
            else if (col < 2048) QIS[i * 512 + col - 1536] = v;
            else if (col < 2112) outKI[i * 64 + col - 2048] = v;
            else WIS[i * 8 + col - 2112] = v;
        }
    }
};

#define IDX_CNT(OUT, PRED) do { int c_ = 0; _Pragma("unroll") for (int i_ = 0; i_ < 64; ++i_) if (i_ < nreg) c_ += __builtin_popcountll(__ballot(v[i_] PRED)); OUT = c_; } while (0)
__device__ __forceinline__ void index_select_phase(const bf16* QIb, const bf16* KIb, const float* WIf, unsigned* MASK, unsigned short* LIST,
                                                   LAS float* S, int wg, int nwg, int tid) {
    const int wid = __builtin_amdgcn_readfirstlane(tid >> 6);
    const int ngroups = M / 8;
    for (int rd = 0; rd * nwg < ngroups; ++rd) {
        { int l_ = tid; asm volatile("" : "+v"(l_)); tid = l_; }
        const int lane = tid & 63, r = lane & 31, hh = lane >> 5;
        const int o = rd * nwg + ((rd & 1) ? (nwg - 1 - wg) : wg);
        if (o < ngroups) {
            const int qg = o >> 3, b = o & 7, t0 = qg * 8, rb = b * SEQ + t0;
            const int nkt = (t0 + 8 + 31) >> 5;
            bf16x8 A[2][4]; float W[2][16];
#pragma unroll
            for (int mt = 0; mt < 2; ++mt) {
#pragma unroll
                for (int d0 = 0; d0 < 4; ++d0) A[mt][d0] = *(const bf16x8*)(QIb + (size_t)(rb + 4 * mt + (r >> 3)) * 512 + (r & 7) * 64 + d0 * 16 + hh * 8);
#pragma unroll
                for (int rr = 0; rr < 16; ++rr) W[mt][rr] = WIf[(size_t)(rb + 4 * mt + (rr >> 2)) * 8 + (rr & 3) + 4 * hh] * WSCALE;
            }
            for (int kt = wid; kt < nkt; kt += 8) {
                bf16x8 Bf[4];
#pragma unroll
                for (int d0 = 0; d0 < 4; ++d0) Bf[d0] = *(const bf16x8*)(KIb + (size_t)(b * SEQ + kt * 32 + r) * 64 + d0 * 16 + hh * 8);
#pragma unroll
                for (int mt = 0; mt < 2; ++mt) {
                    f32x16 acc = (f32x16){};
#pragma unroll
                    for (int d0 = 0; d0 < 4; ++d0) acc = __builtin_amdgcn_mfma_f32_32x32x16_bf16(A[mt][d0], Bf[d0], acc, 0, 0, 0);
                    float sc[4];
#pragma unroll
                    for (int qq = 0; qq < 4; ++qq) {
                        float a = 0.f;
#pragma unroll
                        for (int e = 0; e < 4; ++e) a += fmaxf(acc[4 * qq + e], 0.f) * W[mt][4 * qq + e];
                        sc[qq] = a + __shfl_xor(a, 32);
                    }
                    const float v0 = hh ? sc[2] : sc[0], v1 = hh ? sc[3] : sc[1];
                    S[(4 * mt + 2 * hh) * 4096 + kt * 32 + r] = v0;
                    S[(4 * mt + 2 * hh + 1) * 4096 + kt * 32 + r] = v1;
                }
            }
        }
        __syncthreads();
        if (o < ngroups) {
            int lane_s = lane; asm volatile("" : "+v"(lane_s));
            const int qg = o >> 3, b = o & 7, t = qg * 8 + wid;
            const size_t grow = (size_t)b * SEQ + t;
            const int nreg = (t >> 6) + 1;
            float v[64];
#pragma unroll
            for (int i = 0; i < 64; ++i) { const int key = i * 64 + lane_s; v[i] = -INFINITY; if (i < nreg) { const float x = S[wid * 4096 + key] + 0.0f; v[i] = (key <= t) ? x : -INFINITY; } }
            const bool all = (t + 1 <= TOPK);
            float T = -INFINITY; int need = 0;
            if (!all) {
                float mn = INFINITY, mx = -INFINITY;
#pragma unroll
                for (int i = 0; i < 64; ++i) { mx = fmaxf(mx, v[i]); mn = fminf(mn, (v[i] == -INFINITY) ? INFINITY : v[i]); }
                float lo = wave_min(mn), hi = wave_max(mx);
                int c; IDX_CNT(c, >= hi);
                if (c >= TOPK) T = hi;
                else {
                    T = lo;
                    for (int itn = 0; itn < 400; ++itn) {
                        const float mid = lo + (hi - lo) * 0.5f;
                        if (!(mid > lo) || !(mid < hi)) { T = lo; break; }
                        IDX_CNT(c, >= mid);
                        if (c == TOPK) { T = mid; break; }
                        if (c > TOPK) lo = mid; else hi = mid;
                        T = lo;
                    }
                }
                int cgt; IDX_CNT(cgt, > T);
                need = TOPK - cgt;
            }
            unsigned mlo = 0u, mhi = 0u; int base = 0;
#pragma unroll
            for (int i = 0; i < 64; ++i) {
                if (i < nreg) {
                    const int key = i * 64 + lane_s;
                    bool gt = all ? (key <= t) : (v[i] > T);
                    bool eq = all ? false : (v[i] == T);
                    unsigned long long meq = __ballot(eq); int k = __builtin_popcountll(meq);
                    if (k > need) { eq = eq && (mbcnt64(meq) < need); meq = __ballot(eq); k = need; }
                    need -= k;
                    const bool sel = gt || eq;
                    const unsigned long long m = __ballot(sel);
                    { const unsigned m0_ = (unsigned)m, m1_ = (unsigned)(m >> 32); asm volatile("v_writelane_b32 %0, %1, %2" : "+v"(mlo) : "s"(m0_), "n"(i)); asm volatile("v_writelane_b32 %0, %1, %2" : "+v"(mhi) : "s"(m1_), "n"(i)); }
                    if (sel) LIST[grow * 256 + base + mbcnt64(m)] = (unsigned short)key;
                    base += __builtin_popcountll(m);
                }
            }
            v2u mw; mw.x = mlo; mw.y = mhi;
            *((v2u*)(MASK + grow * 128) + lane_s) = mw;
        }
        __syncthreads();
    }
}

template <class KR, class VR>
__device__ __forceinline__ void gather_attend(const LAS float* qf, const LAS int* keys, LAS float* pl, int cnt, const KR& kr, const VR& vr, bf16* orow  , int lane) {
    float s[4][4];
#pragma unroll
    for (int c = 0; c < 4; ++c) {
        const int slot = lane + 64 * c; const bool valid = slot < cnt;
        const int key = keys[valid ? slot : 0];
        const float* kp = kr(key);
        float a[4] = {0.f, 0.f, 0.f, 0.f};
#pragma unroll 4
        for (int d4 = 0; d4 < 16; ++d4) {
            const f32x4 kv = *(const f32x4*)(kp + 4 * d4);
#pragma unroll
            for (int g = 0; g < 4; ++g) { const f32x4 qv = *(const LAS f32x4*)(qf + g * 64 + 4 * d4); a[g] += (kv.x * qv.x + kv.y * qv.y) + (kv.z * qv.z + kv.w * qv.w); }
        }
#pragma unroll
        for (int g = 0; g < 4; ++g) s[c][g] = valid ? a[g] : -INFINITY;
    }
    float linv[4];
#pragma unroll
    for (int g = 0; g < 4; ++g) {
        const float mx = wave_max(fmaxf(fmaxf(s[0][g], s[1][g]), fmaxf(s[2][g], s[3][g])));
        float sum = 0.f;
#pragma unroll
        for (int c = 0; c < 4; ++c) { const float p = __builtin_amdgcn_exp2f(s[c][g] - mx); sum += p; pl[g * 256 + lane + 64 * c] = p; }
        linv[g] = 1.0f / wave_sum(sum);
    }
    LDS_WAIT(); asm volatile("" ::: "memory");
    float o[4] = {0.f, 0.f, 0.f, 0.f};
    for (int slot = 0; slot < cnt; ++slot) {
        const int key = keys[slot];
        const float vv = vr(key)[lane];
#pragma unroll
        for (int g = 0; g < 4; ++g) o[g] += pl[g * 256 + slot] * vv;
    }
#pragma unroll
    for (int g = 0; g < 4; ++g) orow[g * 64 + lane] = (bf16)f2bf(o[g] * linv[g]);
    LDS_WAIT(); asm volatile("" ::: "memory");
}
struct RowPlain { const float* base; __device__ __forceinline__ const float* operator()(int key) const { return base + (size_t)key * KVW; } };
struct RowPaged { const float* cache; const float* newrow; const int* pt; int j;
    __device__ __forceinline__ const float* operator()(int key) const {
        if (key >= PAST) return newrow;
        const int phys = pt[key >> 7];
        return cache + ((size_t)(phys * PAGE + (key & (PAGE - 1))) * NKV + j) * 64;
    } };

__device__ __forceinline__ void attn_gather_phase(const bf16* Qb, const float* outK, const float* outV, const unsigned short* LIST, bf16* Ob, LAS unsigned char* lds, int wg, int nwg, int tid) {
    asm volatile("" : "+v"(tid));
    const int lane = tid & 63, wid = tid >> 6;
    LAS float* qf = (LAS float*)(lds + wid * 8192); LAS int* keys = (LAS int*)(lds + wid * 8192 + 1024); LAS float* pl = (LAS float*)(lds + wid * 8192 + 2048);
    const int j = wid & 3;
    for (int pr = wg; pr < M / 2; pr += nwg) {
        const int row = pr * 2 + (wid >> 2); const int b = row >> 12, t = row & (SEQ - 1);
        const int cnt = (t + 1 < TOPK) ? t + 1 : TOPK;
#pragma unroll
        for (int g = 0; g < 4; ++g) qf[g * 64 + lane] = bf2f(Qb[(size_t)row * D + (4 * j + g) * 64 + lane]);
#pragma unroll
        for (int c = 0; c < 4; ++c) keys[lane + 64 * c] = (lane + 64 * c < cnt) ? (int)LIST[(size_t)row * 256 + lane + 64 * c] : 0;
        LDS_WAIT(); asm volatile("" ::: "memory");
        RowPlain kr{outK + (size_t)b * SEQ * KVW + j * 64}, vr{outV + (size_t)b * SEQ * KVW + j * 64};
        gather_attend(qf, keys, pl, cnt, kr, vr, Ob + (size_t)row * D + 4 * j * 64, lane);
    }
}

__device__ __forceinline__ void sample_scores_phase(const float* QIS, const float* WIS, const float* cki, const float* kinew, const int* ptab, float* SC, LAS unsigned char* lds, int wg, int nwg, int tid) {
    asm volatile("" : "+v"(tid));
    const int lane = tid & 63, wid = tid >> 6;
    LAS float* qs = (LAS float*)(lds + wid * 4096);
    for (int it = wg * NWAVES + wid; it < SBT * NPAGES; it += nwg * NWAVES) {
        const int b = it >> 7, pg = it & 127;
#pragma unroll
        for (int i = 0; i < 8; ++i) qs[i * 64 + lane] = QIS[b * 512 + i * 64 + lane];
        if (lane < 8) qs[512 + lane] = WIS[b * 8 + lane] * WSCALE;
        LDS_WAIT(); asm volatile("" ::: "memory");
        const int phys = ptab[b * NPAGES + pg];
#pragma unroll
        for (int kk = 0; kk < 2; ++kk) {
            const int key = lane + 64 * kk;
            const float* kp = cki + ((size_t)phys * PAGE + key) * 64;
            float dot[8] = {0.f, 0.f, 0.f, 0.f, 0.f, 0.f, 0.f, 0.f};
#pragma unroll 4
            for (int d4 = 0; d4 < 16; ++d4) {
                const f32x4 kv = *(const f32x4*)(kp + 4 * d4);
#pragma unroll
                for (int h = 0; h < 8; ++h) { const f32x4 qv = *(const LAS f32x4*)(qs + h * 64 + 4 * d4); dot[h] += (kv.x * qv.x + kv.y * qv.y) + (kv.z * qv.z + kv.w * qv.w); }
            }
            float sc = 0.f;
#pragma unroll
            for (int h = 0; h < 8; ++h) sc += fmaxf(dot[h], 0.f) * qs[512 + h];
            SC[(size_t)b * SCLD + pg * PAGE + key] = sc;
        }
        LDS_WAIT(); asm volatile("" ::: "memory");
    }
    if (wg == nwg - 1 && tid < SBT) {
        const int b = tid; float sc = 0.f;
        for (int h = 0; h < 8; ++h) { float dsum = 0.f; for (int d = 0; d < 64; ++d) dsum += QIS[b * 512 + h * 64 + d] * kinew[b * 64 + d]; sc += fmaxf(dsum, 0.f) * WIS[b * 8 + h] * WSCALE; }
        SC[(size_t)b * SCLD + PAST] = sc;
    }
}

#define SS_CNT(OUT, PRED) do { int c_ = 0; _Pragma("unroll") for (int i_ = 0; i_ < 33; ++i_) c_ += __builtin_popcountll(__ballot(v[i_] PRED)); \
        if (lane == 0) cw[par * 8 + wid] = c_; __syncthreads(); int t_ = 0; _Pragma("unroll") for (int w_ = 0; w_ < 8; ++w_) t_ += cw[par * 8 + w_]; par ^= 1; OUT = t_; } while (0)
__device__ __forceinline__ void sample_select_attend(int b, const float* SC, const float* QS, const float* ck, const float* cv, const float* knew, const float* vnew, const int* ptab,
                                                     bf16* OS, LAS unsigned char* lds, int tid) {
    asm volatile("" : "+v"(tid));
    const int lane = tid & 63, wid = tid >> 6;
    LAS int* cw = (LAS int*)(lds);
    LAS float* cwf = (LAS float*)(lds);
    LAS int* keysL = (LAS int*)(lds + 1024);
    float v[33];
#pragma unroll
    for (int i = 0; i < 33; ++i) { const int key = i * NTHREADS + tid; v[i] = (key < NKEYS_S) ? SC[(size_t)b * SCLD + key] + 0.0f : -INFINITY; }
    float mn = INFINITY, mx = -INFINITY;
#pragma unroll
    for (int i = 0; i < 33; ++i) { mx = fmaxf(mx, v[i]); mn = fminf(mn, (v[i] == -INFINITY) ? INFINITY : v[i]); }
    mn = wave_min(mn); mx = wave_max(mx);
    if (lane == 0) { cwf[16 + wid] = mn; cwf[24 + wid] = mx; }
    if (tid == 0) cw[32] = 0;
    __syncthreads();
    float lo = cwf[16], hi = cwf[24];
#pragma unroll
    for (int w = 1; w < 8; ++w) { lo = fminf(lo, cwf[16 + w]); hi = fmaxf(hi, cwf[24 + w]); }
    int par = 0; int c; float T;
    SS_CNT(c, >= hi);
    if (c >= TOPK) T = hi;
    else {
        T = lo;
        for (int itn = 0; itn < 400; ++itn) {
            const float mid = lo + (hi - lo) * 0.5f;
            if (!(mid > lo) || !(mid < hi)) { T = lo; break; }
            SS_CNT(c, >= mid);
            if (c == TOPK) { T = mid; break; }
            if (c > TOPK) lo = mid; else hi = mid;
            T = lo;
        }
    }
    int cgt; SS_CNT(cgt, > T);
    int need = TOPK - cgt;
    int ceq; SS_CNT(ceq, == T);
#pragma unroll
    for (int i = 0; i < 33; ++i) {
        const bool sel = v[i] > T; const unsigned long long m = __ballot(sel);
        if (m) { int bs = 0; if (lane == 0) bs = atomicAdd((int*)&cw[32], __builtin_popcountll(m)); bs = __builtin_amdgcn_readfirstlane(bs);
            if (sel) keysL[bs + mbcnt64(m)] = i * NTHREADS + tid; }
    }
    if (ceq <= need) {
#pragma unroll
        for (int i = 0; i < 33; ++i) {
            const bool sel = v[i] == T; const unsigned long long m = __ballot(sel);
            if (m) { int bs = 0; if (lane == 0) bs = atomicAdd((int*)&cw[32], __builtin_popcountll(m)); bs = __builtin_amdgcn_readfirstlane(bs);
                if (sel) keysL[bs + mbcnt64(m)] = i * NTHREADS + tid; }
        }
    } else {
        int taken = 0;
#pragma unroll
        for (int i = 0; i < 33; ++i) {
            const bool eq = v[i] == T; const unsigned long long m = __ballot(eq);
            if (lane == 0) cw[40 + wid] = __builtin_popcountll(m);
            __syncthreads();
            int before = taken, tot = 0;
#pragma unroll
            for (int w = 0; w < 8; ++w) { const int kw = cw[40 + w]; if (w < wid) before += kw; tot += kw; }
            const int rank = before + mbcnt64(m);
            if (eq && rank < need) keysL[cgt + rank] = i * NTHREADS + tid;
            taken += tot;
            __syncthreads();
        }
    }
    __syncthreads();
    if (wid < NKV) {
        const int j = wid;
        LAS float* qf = (LAS float*)(lds + 4096 + wid * 8192); LAS float* pl = (LAS float*)(lds + 4096 + wid * 8192 + 1024);
#pragma unroll
        for (int g = 0; g < 4; ++g) qf[g * 64 + lane] = QS[b * D + (4 * j + g) * 64 + lane];
        LDS_WAIT(); asm volatile("" ::: "memory");
        RowPaged kr{ck, knew + b * KVW + j * 64, ptab + b * NPAGES, j}, vr{cv, vnew + b * KVW + j * 64, ptab + b * NPAGES, j};
        gather_attend(qf, keysL, pl, TOPK, kr, vr, OS + b * D + 4 * j * 64, lane);
    }
    __syncthreads();
}

namespace att {
using bf16=unsigned short;
using bf16x8=__attribute__((ext_vector_type(8)))short;
using s16x4=__attribute__((ext_vector_type(4)))short;
using f32x16=__attribute__((ext_vector_type(16)))float;
using u32x4=__attribute__((ext_vector_type(4)))unsigned;
constexpr int SEQ=4096,D=64,DM=1024,KVP=256;
constexpr int NW=8,QBLK=32,QB=QBLK*NW,KVBLK=64,QPU=64,NQB=SEQ/QPU;
__device__ __forceinline__ int crow(int r,int hi){return (r&3)+8*(r>>2)+4*hi;}
#define SBAR() __builtin_amdgcn_sched_barrier(0)
__device__ __forceinline__ void imask(f32x16&p0,f32x16&p1,unsigned wl,unsigned wh){
  #pragma unroll
  for(int r=0;r<16;++r){ const int c=(r&3)+8*(r>>2);
    const int m0=((int)(wl<<(31-c)))>>31, m1=((int)(wh<<(31-c)))>>31;
    p0[r]=__uint_as_float(((unsigned)m0&__float_as_uint(p0[r]))|(~(unsigned)m0&0xff800000u));
    p1[r]=__uint_as_float(((unsigned)m1&__float_as_uint(p1[r]))|(~(unsigned)m1&0xff800000u)); }
}

constexpr int NSLOT=3, SLOTB=8192;
constexpr int LDS_K=0, LDS_V=NSLOT*SLOTB, LDS_WS=2*NSLOT*SLOTB, LDS_OST=LDS_WS+NW*64*4, LDS_MR=LDS_OST+NW*4096, LDS_BYTES=LDS_MR+NW*NSLOT*256;
__device__ __forceinline__ void glds16(const void*gsrc,unsigned lds_dst){unsigned keep;
  asm volatile("s_mov_b32 %0, m0\n\ts_mov_b32 m0, %2\n\ts_nop 0\n\tglobal_load_lds_dwordx4 %1, off\n\ts_mov_b32 m0, %0":"=&s"(keep):"v"(gsrc),"s"(lds_dst):"memory");}
__device__ __forceinline__ void glds4(const void*gsrc,unsigned lds_dst){unsigned keep;
  asm volatile("s_mov_b32 %0, m0\n\ts_mov_b32 m0, %2\n\ts_nop 0\n\tglobal_load_lds_dword %1, off\n\ts_mov_b32 m0, %0":"=&s"(keep):"v"(gsrc),"s"(lds_dst):"memory");}
__device__ __forceinline__ float max3f(float a,float b,float c){float r;asm("v_max3_f32 %0, %1, %2, %3":"=v"(r):"v"(a),"v"(b),"v"(c));return r;}
__device__ __forceinline__ float max2f(float a,float b){float r;asm("v_max_f32_e32 %0, %1, %2":"=v"(r):"v"(a),"v"(b));return r;}
__device__ __forceinline__ float fadd_s(float a,float b){float r;asm("v_add_f32_e32 %0, %1, %2":"=v"(r):"v"(a),"v"(b));return r;}
__device__ __forceinline__ float fsub_s(float a,float b){float r;asm("v_sub_f32_e32 %0, %1, %2":"=v"(r):"v"(a),"v"(b));return r;}
typedef float f32x2_t __attribute__((ext_vector_type(2))); typedef __bf16 bf16x2_t __attribute__((ext_vector_type(2)));
__device__ __forceinline__ unsigned cvtpk_s(float lo,float hi){f32x2_t v={lo,hi};bf16x2_t b=__builtin_convertvector(v,bf16x2_t);return __builtin_bit_cast(unsigned,b);}
#define WAIT_BAR(N) asm volatile("s_waitcnt vmcnt(" #N ") lgkmcnt(0)\n\ts_barrier":::"memory")

__device__ __forceinline__ void qkt(f32x16&p0,f32x16&p1,const char*Kslot,const bf16x8*qr,const f32x16&negm,int r32,int hi){
  const char*kb=Kslot+hi*1024+r32*16;
  #pragma unroll
  for(int d0=0;d0<4;++d0){
    const bf16x8 b0=*reinterpret_cast<const bf16x8*>(kb+d0*2048);
    const bf16x8 b1=*reinterpret_cast<const bf16x8*>(kb+d0*2048+512);
    if(d0==0){p0=__builtin_amdgcn_mfma_f32_32x32x16_bf16(b0,qr[0],negm,0,0,0);p1=__builtin_amdgcn_mfma_f32_32x32x16_bf16(b1,qr[0],negm,0,0,0);}
    else{p0=__builtin_amdgcn_mfma_f32_32x32x16_bf16(b0,qr[d0],p0,0,0,0);p1=__builtin_amdgcn_mfma_f32_32x32x16_bf16(b1,qr[d0],p1,0,0,0);}}
}
typedef __attribute__((address_space(3))) const char* lds_cptr;
typedef short v4i16_t __attribute__((ext_vector_type(4)));
__device__ __forceinline__ void kload8(bf16x8*kf,lds_cptr kp){
  kf[0]=*(const __attribute__((address_space(3))) bf16x8*)(kp);      kf[1]=*(const __attribute__((address_space(3))) bf16x8*)(kp+512);
  kf[2]=*(const __attribute__((address_space(3))) bf16x8*)(kp+2048); kf[3]=*(const __attribute__((address_space(3))) bf16x8*)(kp+2560);
  kf[4]=*(const __attribute__((address_space(3))) bf16x8*)(kp+4096); kf[5]=*(const __attribute__((address_space(3))) bf16x8*)(kp+4608);
  kf[6]=*(const __attribute__((address_space(3))) bf16x8*)(kp+6144); kf[7]=*(const __attribute__((address_space(3))) bf16x8*)(kp+6656);
}
__device__ __forceinline__ void kload2(bf16x8*kf,lds_cptr kp,int j){ kf[2*j]=*(const __attribute__((address_space(3))) bf16x8*)(kp+j*2048); kf[2*j+1]=*(const __attribute__((address_space(3))) bf16x8*)(kp+j*2048+512); }
__device__ __forceinline__ s16x4 vtr(lds_cptr p){ return __builtin_bit_cast(s16x4,__builtin_amdgcn_ds_read_tr16_b64_v4i16((__attribute__((address_space(3))) v4i16_t*)p)); }
__device__ __forceinline__ float rowmax(const f32x16&p0,const f32x16&p1){
  float a=max3f(p0[0],p0[1],p1[0]),b=max3f(p0[2],p0[3],p1[1]);a=max3f(a,p1[2],p1[3]);
  #pragma unroll
  for(int r=4;r<16;r+=4){a=max3f(a,p0[r],p0[r+1]);b=max3f(b,p0[r+2],p0[r+3]);a=max3f(a,p1[r],p1[r+1]);b=max3f(b,p1[r+2],p1[r+3]);}
  const float m=max2f(a,b);
  auto rr=__builtin_amdgcn_permlane32_swap(__float_as_uint(m),__float_as_uint(m),false,false);
  return max2f(__uint_as_float(rr[0]),__uint_as_float(rr[1]));
}
__device__ __forceinline__ void pv(f32x16*o,int vb,bf16x8 pa0,bf16x8 pa1,bf16x8 pa2,bf16x8 pa3){
  #pragma unroll
  for(int d0=0;d0<2;++d0){s16x4 lo[4],hi[4];
    #pragma unroll
    for(int ks=0;ks<4;++ks){
      asm volatile("ds_read_b64_tr_b16 %0,%1 offset:%c2":"=&v"(lo[ks]):"v"(vb),"i"(d0*4096+ks*1024):"memory");
      asm volatile("ds_read_b64_tr_b16 %0,%1 offset:%c2":"=&v"(hi[ks]):"v"(vb),"i"(d0*4096+ks*1024+512):"memory");}
    asm volatile("s_waitcnt lgkmcnt(0)":::"memory");SBAR();
    #define PK(k) (bf16x8){lo[k][0],lo[k][1],lo[k][2],lo[k][3],hi[k][0],hi[k][1],hi[k][2],hi[k][3]}
    o[d0]=__builtin_amdgcn_mfma_f32_32x32x16_bf16(pa0,PK(0),o[d0],0,0,0);
    o[d0]=__builtin_amdgcn_mfma_f32_32x32x16_bf16(pa1,PK(1),o[d0],0,0,0);
    o[d0]=__builtin_amdgcn_mfma_f32_32x32x16_bf16(pa2,PK(2),o[d0],0,0,0);
    o[d0]=__builtin_amdgcn_mfma_f32_32x32x16_bf16(pa3,PK(3),o[d0],0,0,0);
    #undef PK
  }
}

__device__ __forceinline__ unsigned short f2bf_s(float x){ return (unsigned short)(cvtpk_s(x,x)&0xffffu); }
#ifndef ATTN_STORE16
#define ATTN_STORE16(p,v) (*(u32x4*)(p)=(v))
#endif
template<int THRL> __device__ __forceinline__ void attn_unit(int b,int j,int qb,const bf16*Q,const bf16*__restrict__ K,const bf16*__restrict__ V,const unsigned*__restrict__ MASKW,bf16*O,char*shm,int tid){
  const int lane=tid&63,r32=lane&31,hi=lane>>5; const int wid=__builtin_amdgcn_readfirstlane(tid>>6);
  const long rowbase=(long)b*SEQ; const int q0=qb*QPU;
  const bf16*Qw=Q+(rowbase+q0+wid*8)*DM+(4*j)*D;
  const bf16*Kh=K+rowbase*KVP+j*D,*Vh=V+rowbase*KVP+j*D;
  const unsigned lds0=(unsigned)(uintptr_t)shm;
  float*wsf=(float*)(shm+LDS_WS)+wid*64;
  const bf16*ksrc=Kh+(long)lane*KVP+wid*8;
  const bf16*vsrc=Vh+(long)(16*(wid&3)+(lane>>2))*KVP+(wid>>2)*32+(lane&3)*8;
  const unsigned*msrc=MASKW+(rowbase+q0+wid*8+((lane&15)>>1))*128+(lane&1);
  const unsigned kdst=lds0+LDS_K+wid*1024, vdst=lds0+LDS_V+wid*1024, mdst=lds0+LDS_MR+wid*(NSLOT*256);
  const int NT0=qb+1; int NT=(NT0+1)&~1; if(NT<4)NT=4;
  const int TL=NT-1;
  #define CL(t) (((t)<TL)?(t):TL)
  #define DMA_K(t,slot) glds16(ksrc+(long)CL(t)*KVBLK*KVP,(unsigned)__builtin_amdgcn_readfirstlane(kdst+(slot)))
  #define DMA_V(t,slot) glds16(vsrc+(long)CL(t)*KVBLK*KVP,(unsigned)__builtin_amdgcn_readfirstlane(vdst+(slot)))
  #define DMA_M(t,mslot) glds4(msrc+2*CL(t),(unsigned)__builtin_amdgcn_readfirstlane(mdst+(mslot)))
  const int vb0=(int)(lds0+LDS_V)+((lane>>4)&1)*32+(lane&3)*8+(4*hi+((lane&15)>>2))*64;
  const char*Kbase=shm+LDS_K; bf16x8 kf[8];
  const lds_cptr shm3=(lds_cptr)shm; const lds_cptr kp0=shm3+LDS_K+hi*1024+r32*16; const lds_cptr vp0=shm3+LDS_V+((lane>>4)&1)*32+(lane&3)*8+(4*hi+((lane&15)>>2))*64;
  const lds_cptr mp0=shm3+LDS_MR+wid*(NSLOT*256)+(r32>>2)*8;
  const unsigned sh4=4u*(unsigned)hi;
  DMA_K(0,0);DMA_M(0,0);DMA_V(0,0);DMA_K(1,SLOTB);DMA_M(1,256);
  bf16x8 qr[4];
  #pragma unroll
  for(int d0=0;d0<4;++d0)qr[d0]=*reinterpret_cast<const bf16x8*>(&Qw[(long)(r32>>2)*DM+(r32&3)*D+d0*16+hi*8]);
  float mhat=0.f,l_reg=0.f; float z_=0.f; asm volatile("":"+v"(z_));
  f32x16 o[2],negm;
  #pragma unroll
  for(int r=0;r<16;++r){o[0][r]=z_;o[1][r]=z_;negm[r]=z_;}
  typedef unsigned u32x2_t __attribute__((ext_vector_type(2)));
  #define CMASK(P0,P1,ms) do{ const u32x2_t mw_=*(const __attribute__((address_space(3))) u32x2_t*)(mp0+(ms)); imask(P0,P1,mw_[0]>>sh4,mw_[1]>>sh4); }while(0)
  bool resc=false;
  #define START(P0,P1) do{ const float rm=rowmax(P0,P1); resc=false; \
    { const float dl=__builtin_fmaxf(rm,-1024.f); mhat=fadd_s(mhat,dl); \
      _Pragma("unroll") for(int r=0;r<16;++r){P0[r]=fsub_s(P0[r],dl);P1[r]=fsub_s(P1[r],dl);} \
      _Pragma("unroll") for(int r=0;r<16;++r)negm[r]=-mhat; asm volatile("":"+v"(negm)); } \
    _Pragma("unroll") for(int r=0;r<16;++r)P0[r]=__builtin_amdgcn_exp2f(P0[r]); }while(0)
  #define RESC() do{ if(resc){ asm volatile("s_waitcnt lgkmcnt(0)":::"memory"); \
      _Pragma("unroll") for(int d_=0;d_<2;++d_) _Pragma("unroll") for(int r=0;r<16;++r)o[d_][r]*=wsf[crow(r,hi)]; } }while(0)
  f32x16 pA0,pA1,pB0,pB1;
  int sl_prev=0,sl_cur=0,sl_next=SLOTB;
  int ms_cur=0,ms_next=256,ms_nn=512;
  #define ROT() do{sl_prev=sl_cur;sl_cur=sl_next;sl_next=(sl_next==(NSLOT-1)*SLOTB)?0:sl_next+SLOTB; const int m_=ms_cur; ms_cur=ms_next; ms_next=ms_nn; ms_nn=m_;}while(0)
  DMA_K(2,2*SLOTB);
  WAIT_BAR(4);
  qkt(pA0,pA1,Kbase,qr,negm,r32,hi);asm volatile("s_nop 15\n\ts_nop 7":"+v"(pA0),"+v"(pA1));CMASK(pA0,pA1,ms_cur);
  START(pA0,pA1);
  _Pragma("unroll") for(int r=0;r<16;++r)pA1[r]=__builtin_amdgcn_exp2f(pA1[r]);
  WAIT_BAR(0);
  DMA_K(3,0);DMA_V(1,SLOTB);DMA_M(2,512);
  ROT();
  kload8(kf,kp0+sl_cur);
  WAIT_BAR(3);
  s16x4 vlo[8],vhi[8]; u32x4 pw0,pw1,pw2,pw3;
  #define PKW(P,B) cvtpk_s(P[B],P[B+1])
  #define PAF(k) __builtin_bit_cast(bf16x8,pw##k)
  #define VFR(i) (bf16x8){vlo[i][0],vlo[i][1],vlo[i][2],vlo[i][3],vhi[i][0],vhi[i][1],vhi[i][2],vhi[i][3]}
  #define PIN(x) asm volatile("":"+v"(x))
  #define MX3(a,b,c) __builtin_fmaxf(__builtin_fmaxf((a),(b)),(c))
  #define GAPA(MF,A0,A1,A2,A3,W0,W1,PW) do{ MF; sacc+=A0; sacc+=A1; sacc+=A2; sacc+=A3; PIN(sacc); W0; W1; PIN(PW); SBAR(); }while(0)
  #define EX(v) __builtin_amdgcn_exp2f(v)
  #define GAPB(MF,X,B) do{ MF; X[B]=EX(X[B]); X[B+1]=EX(X[B+1]); X[B+2]=EX(X[B+2]); X[B+3]=EX(X[B+3]); PIN(X); SBAR(); }while(0)
  #define VRD(i) do{ vlo[i]=vtr(vp_+(((i)>>2)*4096+((i)&3)*1024)); vhi[i]=vtr(vp_+(((i)>>2)*4096+((i)&3)*1024+512)); }while(0)
  #define KRD(jj) do{ kload2(kf,kp0+sl_next,jj); SBAR(); }while(0)
  #define STEP(C0,C1,P0,P1,t) do{ SBAR(); \
    const lds_cptr vp_=vp0+sl_prev; \
    VRD(0); SBAR(); float sacc=(P0[0]+P0[1]); \
    GAPA(C0=__builtin_amdgcn_mfma_f32_32x32x16_bf16(kf[0],qr[0],negm,0,0,0), P0[2],P0[3],P0[4],P0[5],     pw0[0]=PKW(P0,0), pw0[1]=PKW(P0,2), pw0); \
    VRD(4); SBAR(); GAPA(C1=__builtin_amdgcn_mfma_f32_32x32x16_bf16(kf[1],qr[0],negm,0,0,0), P0[6],P0[7],P0[8],P0[9],     pw0[2]=PKW(P0,4), pw0[3]=PKW(P0,6), pw0); \
    VRD(1); SBAR(); GAPA(C0=__builtin_amdgcn_mfma_f32_32x32x16_bf16(kf[2],qr[1],C0,0,0,0),   P0[10],P0[11],P0[12],P0[13], pw1[0]=PKW(P0,8), pw1[1]=PKW(P0,10), pw1); \
    VRD(5); SBAR(); GAPA(C1=__builtin_amdgcn_mfma_f32_32x32x16_bf16(kf[3],qr[1],C1,0,0,0),   P0[14],P0[15],P1[0],P1[1],   pw1[2]=PKW(P0,12),pw1[3]=PKW(P0,14), pw1); \
    VRD(2); SBAR(); GAPA(C0=__builtin_amdgcn_mfma_f32_32x32x16_bf16(kf[4],qr[2],C0,0,0,0),   P1[2],P1[3],P1[4],P1[5],     pw2[0]=PKW(P1,0), pw2[1]=PKW(P1,2), pw2); \
    VRD(6); SBAR(); GAPA(C1=__builtin_amdgcn_mfma_f32_32x32x16_bf16(kf[5],qr[2],C1,0,0,0),   P1[6],P1[7],P1[8],P1[9],     pw2[2]=PKW(P1,4), pw2[3]=PKW(P1,6), pw2); \
    VRD(3); SBAR(); GAPA(C0=__builtin_amdgcn_mfma_f32_32x32x16_bf16(kf[6],qr[3],C0,0,0,0),   P1[10],P1[11],P1[12],P1[13], pw3[0]=PKW(P1,8), pw3[1]=PKW(P1,10), pw3); \
    VRD(7); SBAR(); GAPA(C1=__builtin_amdgcn_mfma_f32_32x32x16_bf16(kf[7],qr[3],C1,0,0,0),   P1[14],P1[15],0.f,0.f,       pw3[2]=PKW(P1,12),pw3[3]=PKW(P1,14), pw3); \
    l_reg+=sacc; \
    DMA_K((t)+3,sl_cur); DMA_V((t)+1,sl_next); DMA_M((t)+2,ms_nn); \
    CMASK(C0,C1,ms_cur); \
    { float a=MX3(C0[0],C0[1],C1[0]),b_=MX3(C0[2],C0[3],C1[1]); a=MX3(a,C1[2],C1[3]); \
      _Pragma("unroll") for(int r=4;r<16;r+=4){a=MX3(a,C0[r],C0[r+1]);b_=MX3(b_,C0[r+2],C0[r+3]);a=MX3(a,C1[r],C1[r+1]);b_=MX3(b_,C1[r+2],C1[r+3]);} \
      float rm=__builtin_fmaxf(a,b_); { auto rr=__builtin_amdgcn_permlane32_swap(__float_as_uint(rm),__float_as_uint(rm),false,false); rm=__builtin_fmaxf(__uint_as_float(rr[0]),__uint_as_float(rr[1])); } \
      resc=false; \
      if(__builtin_expect(__any(rm>(float)THRL),0)){ const float dl=__builtin_fmaxf(rm,0.f); mhat+=dl; \
        _Pragma("unroll") for(int r=0;r<16;++r){C0[r]-=dl;C1[r]-=dl;} \
        _Pragma("unroll") for(int r=0;r<16;++r)negm[r]=-mhat; asm volatile("":"+v"(negm)); \
        const float f=__builtin_amdgcn_exp2f(-dl); l_reg*=f; if(hi==0)wsf[r32]=f; resc=true; } } \
    SBAR(); \
    GAPB(o[0]=__builtin_amdgcn_mfma_f32_32x32x16_bf16(PAF(0),VFR(0),o[0],0,0,0), C0,0); \
    GAPB(o[1]=__builtin_amdgcn_mfma_f32_32x32x16_bf16(PAF(0),VFR(4),o[1],0,0,0), C0,4); \
    KRD(0); GAPB(o[0]=__builtin_amdgcn_mfma_f32_32x32x16_bf16(PAF(1),VFR(1),o[0],0,0,0), C0,8); \
    KRD(1); GAPB(o[1]=__builtin_amdgcn_mfma_f32_32x32x16_bf16(PAF(1),VFR(5),o[1],0,0,0), C0,12); \
    KRD(2); GAPB(o[0]=__builtin_amdgcn_mfma_f32_32x32x16_bf16(PAF(2),VFR(2),o[0],0,0,0), C1,0); \
    KRD(3); GAPB(o[1]=__builtin_amdgcn_mfma_f32_32x32x16_bf16(PAF(2),VFR(6),o[1],0,0,0), C1,4); \
    GAPB(o[0]=__builtin_amdgcn_mfma_f32_32x32x16_bf16(PAF(3),VFR(3),o[0],0,0,0), C1,8); \
    GAPB(o[1]=__builtin_amdgcn_mfma_f32_32x32x16_bf16(PAF(3),VFR(7),o[1],0,0,0), C1,12); \
    }while(0)
  int t=1;
  for(;t+1<NT;t+=2){
    STEP(pB0,pB1,pA0,pA1,t);     WAIT_BAR(3); RESC(); ROT();
    STEP(pA0,pA1,pB0,pB1,t+1);   WAIT_BAR(3); RESC(); ROT();
  }
  STEP(pB0,pB1,pA0,pA1,NT-1); WAIT_BAR(0); RESC();
  { float sacc=pB0[0]+pB0[1]; _Pragma("unroll") for(int r=2;r<16;++r)sacc+=pB0[r]; _Pragma("unroll") for(int r=0;r<16;++r)sacc+=pB1[r]; l_reg+=sacc;
    pw0=(u32x4){PKW(pB0,0),PKW(pB0,2),PKW(pB0,4),PKW(pB0,6)};pw1=(u32x4){PKW(pB0,8),PKW(pB0,10),PKW(pB0,12),PKW(pB0,14)};pw2=(u32x4){PKW(pB1,0),PKW(pB1,2),PKW(pB1,4),PKW(pB1,6)};pw3=(u32x4){PKW(pB1,8),PKW(pB1,10),PKW(pB1,12),PKW(pB1,14)};
    SBAR(); pv(o,vb0+sl_cur,PAF(0),PAF(1),PAF(2),PAF(3)); }
  #undef PKW
  #undef PAF
  #undef VFR
  #undef PIN
  #undef MX3
  #undef GAPA
  #undef GAPB
  #undef EX
  #undef VRD
  #undef KRD
  #undef STEP
  {auto rr=__builtin_amdgcn_permlane32_swap(__float_as_uint(l_reg),__float_as_uint(l_reg),false,false);l_reg=__uint_as_float(rr[0])+__uint_as_float(rr[1]);}
  if(hi==0)wsf[32+r32]=l_reg;asm volatile("s_waitcnt lgkmcnt(0)":::"memory");
  float rli[16];
  #pragma unroll
  for(int r=0;r<16;++r)rli[r]=__builtin_amdgcn_rcpf(wsf[32+crow(r,hi)]);
  bf16*Ow=O+(rowbase+q0+wid*8)*DM+(4*j)*D;
  { bf16*stg=(bf16*)(shm+LDS_OST)+wid*2048;
    #pragma unroll
    for(int r=0;r<16;++r){const int orow=crow(r,hi);
      #pragma unroll
      for(int d0=0;d0<2;++d0)stg[orow*64+d0*32+r32]=(bf16)f2bf_s(o[d0][r]*rli[r]);}
    asm volatile("s_waitcnt lgkmcnt(0)":::"memory");
    #pragma unroll
    for(int i=0;i<4;++i){const int row=i*8+(lane>>3),ch=lane&7; const u32x4 v=*(const u32x4*)(stg+row*64+ch*8); ATTN_STORE16(Ow+(long)(row>>2)*DM+(row&3)*D+ch*8,v);} }
  asm volatile("s_waitcnt vmcnt(0) lgkmcnt(0)\n\ts_barrier":::"memory");
  #undef DMA_K
  #undef DMA_V
  #undef DMA_M
  #undef CL
  #undef CMASK
  #undef START
  #undef RESC
  #undef ROT
}
__device__ __forceinline__ void attn_phase_masked(char*lds,const bf16*Q,const bf16*K,const bf16*V,const unsigned*MASKW,bf16*O,int grid,int block,int tid){
  if(grid==256){
    const int vcu=(block&7)*32+(block>>3); const int bh=vcu>>3, s=vcu&7;
    for(int i=0;i<8;++i){ const int p=s+8*(i>>1); const int qb=(i&1)?(63-p):p; attn_unit<8>(bh>>2,bh&3,qb,Q,K,V,MASKW,O,lds,tid); }
  } else {
    for(int u=block;u<2048;u+=grid){ const int bh=u>>6, x=u&63; const int qb=(x&1)?(63-(x>>1)):(x>>1); attn_unit<8>(bh>>2,bh&3,qb,Q,K,V,MASKW,O,lds,tid); }
  }
}
#undef SBAR
#undef WAIT_BAR
}

#define RELAUNDER() (({ asm volatile("" : "+s"(pa)); G = G0; wg = wg0; asm volatile("" : "+s"(G), "+s"(wg)); gw = wg * NWAVES + wave; NGW = G * NWAVES; asm volatile("v_mbcnt_lo_u32_b32 %0, -1, 0\n\tv_mbcnt_hi_u32_b32 %0, -1, %0" : "=v"(lane)); tid = wave * 64 + lane; }), true)
struct Args { const void* in[17]; float* out; unsigned char* ws; int ph_lo, ph_hi; };
constexpr int N_PHASES = 21;

__global__ void __launch_bounds__(NTHREADS, 2) fwd(Args args) {
    extern __shared__ __attribute__((aligned(16))) unsigned char lds_raw[];
    LAS unsigned char* lds = (LAS unsigned char*)lds_raw;
#define MISC ((volatile LAS unsigned*)(lds + MISC_OFF))
    int wave = __builtin_amdgcn_readfirstlane((int)threadIdx.x >> 6); asm volatile("" : "+s"(wave));
    int lane, tid; asm volatile("v_mbcnt_lo_u32_b32 %0, -1, 0\n\tv_mbcnt_hi_u32_b32 %0, -1, %0" : "=v"(lane)); tid = wave * 64 + lane;
    const int G0 = gridDim.x, wg0 = blockIdx.x;
    int G = G0, wg = wg0, gw = wg * NWAVES + wave, NGW = G * NWAVES;
    typedef __attribute__((address_space(4))) const Args* kargs_t;
    kargs_t pa = (kargs_t)__builtin_amdgcn_kernarg_segment_ptr();
#define ws (pa->ws)
#define out (pa->out)
#define x_prompt ((const float*)pa->in[0])
#define x_sample ((const float*)pa->in[1])
#define cache_k ((const float*)pa->in[2])
#define cache_v ((const float*)pa->in[3])
#define cache_kidx ((const float*)pa->in[4])
#define state_pool ((const float*)pa->in[5])
#define page_table ((const int*)pa->in[6])
#define ln_g ((const float*)pa->in[7])
#define ln_b ((const float*)pa->in[8])
#define ffn1_wi ((const float*)pa->in[9])
#define ffn1_wo ((const float*)pa->in[10])
#define ffn2_wi ((const float*)pa->in[11])
#define ffn2_wo ((const float*)pa->in[12])
#define attn_w_in ((const float*)pa->in[13])
#define attn_w_o ((const float*)pa->in[14])
#define pool_w ((const float*)pa->in[15])
#define pool_scale ((const float*)pa->in[16])
#define W_WI ((bf16*)(ws + WS_WI))
#define W_WO ((bf16*)(ws + WS_WO))
#define W_IN ((bf16*)(ws + WS_WIN))
#define W_OA ((bf16*)(ws + WS_WOA))
#define W_POOL ((bf16*)(ws + WS_WPOOL))
#define ROPE ((f32x2*)(ws + WS_ROPE))
#define XB ((bf16*)(ws + WS_XB))
#define XA ((float*)(ws + WS_XA))
#define PRE ((float*)(ws + WS_PRE))
#define GB ((bf16*)(ws + WS_G))
#define QB ((bf16*)(ws + WS_QB))
#define OB ((bf16*)(ws + WS_OB))
#define KB ((bf16*)(ws + WS_KB))
#define VB ((bf16*)(ws + WS_VB))
#define QIB ((bf16*)(ws + WS_QIB))
#define KIB ((bf16*)(ws + WS_KIB))
#define WIF ((float*)(ws + WS_WIF))
#define MASK ((unsigned*)(ws + WS_MASK))
#define LIST ((unsigned short*)(ws + WS_LIST))
#define DB ((bf16*)(ws + WS_DB))
#define XS ((float*)(ws + WS_S + S_XS))
#define PRES ((float*)(ws + WS_S + S_PRES))
#define XSB ((bf16*)(ws + WS_S + S_XSB))
#define GS ((bf16*)(ws + WS_S + S_GS))
#define QS ((float*)(ws + WS_S + S_QS))
#define QIS ((float*)(ws + WS_S + S_QIS))
#define WIS ((float*)(ws + WS_S + S_WIS))
#define OS ((bf16*)(ws + WS_S + S_OS))
#define DS ((bf16*)(ws + WS_S + S_DS))
#define SC ((float*)(ws + WS_S + S_SC))
    for (int u = tid; u < 64; u += NTHREADS) MISC[u] = 0u;
    __syncthreads();
    const int lo = pa->ph_lo, hi = pa->ph_hi;
    if (hi - lo > 1) (void)xcd_barrier_post((unsigned*)(ws + WS_CTL) + CW_BAR, MISC + 8, tid);
    int ph = 0;
#define LAUNDER_V(x) asm volatile("" : "+v"(x))
#define LAUNDER_S(x) asm volatile("" : "+s"(x))
#ifndef SITEMASK
#define SITEMASK 0xFFFFFFFFu
#endif
#define PH_ON(k) (RELAUNDER() && ((SITEMASK >> (k)) & 1u) && ph >= lo && ph < hi)
#define PH_END do { if (ph >= lo && ph + 1 < hi) { RELAUNDER(); XcdBarrier bar_; bar_.bar = (unsigned*)(ws + WS_CTL) + CW_BAR; bar_.x = xb_xcc_id(); bar_.st = (volatile LAS unsigned*)(lds + MISC_OFF) + 8; xcd_barrier(bar_, tid); } ++ph; } while (0)
    LAS float* redS = (LAS float*)(lds + RING_OFF);

    if (PH_ON(0)) {
        LAS float* scr = (LAS float*)(lds + RING_OFF + wave * 16384);
        constexpr int I_WI = 16 * 176, I_WO = 44 * 32, I_IN = 16 * 72, I_OA = 16 * 32, I_PL = 4 * 8;
        constexpr int NIT = 4 * I_WI + 4 * I_WO + I_IN + I_OA + 4 * I_PL;
        for (int it = gw; it < NIT; it += NGW) {
            int r = it;
            if (r < 4 * I_WI) { const int mi = r / I_WI; r -= mi * I_WI; const int kb = r / 176, nb = r % 176; const int n0 = nb * 32, pn = n0 >> 8, i = n0 & 255;
                const int c0 = (i < 128) ? (128 * pn + i) : (FF + 128 * pn + (i - 128));
                tr_item(((mi & 1) ? ffn2_wi : ffn1_wi) + (size_t)(mi >> 1) * D * NWI, NWI, kb * 64, c0, 32, (bf16*)((unsigned char*)W_WI + (size_t)mi * WI_STRIDE), D, n0, scr, lane); continue; }
            r -= 4 * I_WI;
            if (r < 4 * I_WO) { const int mi = r / I_WO; r -= mi * I_WO; const int kb = r / 32, nb = r % 32;
                tr_item(((mi & 1) ? ffn2_wo : ffn1_wo) + (size_t)(mi >> 1) * FF * D, D, kb * 64, nb * 32, 32, (bf16*)((unsigned char*)W_WO + (size_t)mi * WO_STRIDE), FF, nb * 32, scr, lane); continue; }
            r -= 4 * I_WO;
            if (r < I_IN) { const int kb = r / 72, nb = r % 72; const int ncv = NPROJ - nb * 32;
                tr_item(attn_w_in, NPROJ, kb * 64, (ncv > 0) ? nb * 32 : 0, ncv, W_IN, D, nb * 32, scr, lane); continue; }
            r -= I_IN;
            if (r < I_OA) { const int kb = r / 32, nb = r % 32; tr_item(attn_w_o, D, kb * 64, nb * 32, 32, W_OA, D, nb * 32, scr, lane); continue; }
            r -= I_OA;
            { const int g = r / I_PL; r -= g * I_PL; const int kb = r / 8, nb = r % 8; tr_item(pool_w + (size_t)g * 65536, 256, kb * 64, nb * 32, 32, W_POOL, 256, g * 256 + nb * 32, scr, lane); }
        }
        for (size_t i = (size_t)wg * NTHREADS + tid; i < (size_t)(M + SBT) * D / 8; i += (size_t)G * NTHREADS) {
            const float* src = (i < (size_t)M * D / 8) ? x_prompt + i * 8 : x_sample + (i - (size_t)M * D / 8) * 8;
            bf16* dst = (i < (size_t)M * D / 8) ? XB + i * 8 : XSB + (i - (size_t)M * D / 8) * 8;
            const f32x4 a = *(const f32x4*)src, c = *(const f32x4*)(src + 4);
            v4u o; o.x = pk2(a.x, a.y); o.y = pk2(a.z, a.w); o.z = pk2(c.x, c.y); o.w = pk2(c.z, c.w); *(v4u*)dst = o;
        }
        for (int i = wg * NTHREADS + tid; i < 4097 * 8; i += G * NTHREADS) {
            const int p = i >> 3, f = i & 7; const float pos = (p < 4096) ? (float)p : (float)PAST;
            const float freq = (float)pow(500000.0, -(double)f / 8.0);
            const float ang = pos * freq;
            f32x2 cs; cs.x = (float)cos((double)ang); cs.y = (float)sin((double)ang); ROPE[i] = cs;
        }
    }
    PH_END;

    for (int f = 0; f < 4; ++f) {
        const int layer = f >> 1, which = f & 1;
        const bf16* Wi = (const bf16*)((const unsigned char*)W_WI + (size_t)(layer * 2 + which) * WI_STRIDE);
        const bf16* Wo = (const bf16*)((const unsigned char*)W_WO + (size_t)(layer * 2 + which) * WO_STRIDE);
        const float* Xres = (f == 0) ? x_prompt : XA;
        const float* XSres = (f == 0) ? x_sample : XS;
        const int lni = which ? 2 : 0;
        if (PH_ON(1)) {
            { SDescG1 dsc{GS}; sgemm32<2>(XSB, D, Wi, D, D, 88, wg, G, redS, tid, dsc); }
            pg8::Gemm g{XB, Wi, D, D, D, 0}; pg8::StaticOrder S; S.init(M, NWI, G, wg);
            pg8::EpiSwiglu E{GB};
            pg8::gemm_phase<pg8::EpiSwiglu, pg8::StaticOrder, true, true>(lds + RING_OFF, g, S, E, tid);
        }
        PH_END;
        if (PH_ON(2)) {
            { SDescResid dsc{XSres, PRES, 0.5f, nullptr, 0}; sgemm32<1>(GS, FF, Wo, FF, FF, 32, wg, G, redS, tid, dsc); }
            pg8::Gemm g{GB, Wo, FF, FF, FF, 0}; pg8::StaticOrder S; S.init(M, D, G, wg);
            pg8::EpiResid<false> E{Xres, PRE, 0.5f, nullptr};
            pg8::gemm_phase<pg8::EpiResid<false>, pg8::StaticOrder, true, true>(lds + RING_OFF, g, S, E, tid);
        }
        PH_END;
        if (PH_ON(3)) {
            const float* gg = ln_g + (layer * 3 + lni) * D; const float* bb = ln_b + (layer * 3 + lni) * D;
            const bool last = (f == 3);
            for (int m = gw; m < M + SBT; m += NGW) {
                if (m < M) {
                    float* extra = nullptr;
                    if (f == 2 && (m & (SEQ - 1)) >= SEQ - 15) extra = out + O_PP + ((size_t)(m >> 12) * 15 + ((m & (SEQ - 1)) - (SEQ - 15))) * D;
                    ln_row(PRE + (size_t)m * D, gg, bb, last ? out + O_YP + (size_t)m * D : XA + (size_t)m * D, last ? nullptr : XB + (size_t)m * D, extra, lane);
                } else {
                    const int sr = m - M;
                    float* extra = (f == 2) ? out + O_PS + ((size_t)sr * 15 + 14) * D : nullptr;
                    ln_row(PRES + (size_t)sr * D, gg, bb, last ? out + O_YS + (size_t)sr * D : XS + (size_t)sr * D, last ? nullptr : XSB + (size_t)sr * D, extra, lane);
                }
            }
        }
        PH_END;
        if (f == 0) {
            if (PH_ON(4)) {
                { SDescProj dsc{QS, QIS, WIS, out + O_KS, out + O_VS, out + O_KIS, ROPE + 4096 * 8}; sgemm32<1>(XSB, D, W_IN, D, D, 67, wg, G, redS, tid, dsc); }
                pg8::Gemm g{XB, W_IN, D, D, D, 0}; pg8::StaticOrder S; S.init(M, NPROJP, G, wg);
                pg8::EpiProj E{ws, out};
                pg8::gemm_phase<pg8::EpiProj, pg8::StaticOrder, true, true>(lds + RING_OFF, g, S, E, tid);
            }
            PH_END;
            if (PH_ON(5)) {
                sample_scores_phase(QIS, WIS, cache_kidx, out + O_KIS, page_table, SC, lds + RING_OFF, wg, G, tid);
                __syncthreads();
                index_select_phase(QIB, KIB, WIF, MASK, LIST, (LAS float*)(lds + RING_OFF), wg, G, tid);
            }
            PH_END;
            if (PH_ON(6)) {
                if (wg < SBT) sample_select_attend(wg, SC, QS, cache_k, cache_v, out + O_KS, out + O_VS, page_table, OS, lds + RING_OFF, tid);
                __syncthreads();
                att::attn_phase_masked((char*)lds_raw + RING_OFF, QB, KB, VB, MASK, OB, G, wg, tid);
            }
            PH_END;
            if (PH_ON(7)) {
                { SDescResid dsc{XS, PRES, 1.0f, nullptr, 0}; sgemm32<1>(OS, D, W_OA, D, D, 32, wg, G, redS, tid, dsc); }
                pg8::Gemm g{OB, W_OA, D, D, D, 0}; pg8::StaticOrder S; S.init(M, D, G, wg);
                pg8::EpiResid<false> E{XA, PRE, 1.0f, nullptr};
                pg8::gemm_phase<pg8::EpiResid<false>, pg8::StaticOrder, true, true>(lds + RING_OFF, g, S, E, tid);
            }
            PH_END;
            if (PH_ON(8)) {
                const float* gg = ln_g + 1 * D; const float* bb = ln_b + 1 * D;
                for (int m = gw; m < M + SBT; m += NGW) {
                    if (m < M) ln_row(PRE + (size_t)m * D, gg, bb, XA + (size_t)m * D, XB + (size_t)m * D, nullptr, lane);
                    else ln_row(PRES + (size_t)(m - M) * D, gg, bb, XS + (size_t)(m - M) * D, XSB + (size_t)(m - M) * D, nullptr, lane);
                }
            }
            PH_END;
        }
        if (f == 2) {
            if (PH_ON(9)) {
                for (size_t it = (size_t)wg * NTHREADS + tid; it < (size_t)M * 256; it += (size_t)G * NTHREADS) {
                    const int row = (int)(it >> 8), c4 = (int)(it & 255), col = 4 * c4, t = row & (SEQ - 1);
                    const int w = 2 << (c4 >> 6); const int cnt = (t + 1 < w) ? t + 1 : w;
                    const f32x4 xt = *(const f32x4*)(XA + (size_t)row * D + col); f32x4 sum = xt;
                    for (int r = 1; r < cnt; ++r) sum = sum + *(const f32x4*)(XA + (size_t)(row - r) * D + col);
                    const f32x4 d = sum * (1.0f / (float)cnt) - xt;
                    v2u o; o.x = pk2(d.x, d.y); o.y = pk2(d.z, d.w); *(v2u*)(DB + (size_t)row * D + col) = o;
                }
                for (int it = wg * NTHREADS + tid; it < SBT * 256; it += G * NTHREADS) {
                    const int b = it >> 8, c4 = it & 255, col = 4 * c4; const int w = 2 << (c4 >> 6);
                    const f32x4 xt = *(const f32x4*)(XS + b * D + col); f32x4 sum = xt;
                    for (int r = 1; r < w; ++r) sum = sum + *(const f32x4*)(state_pool + ((size_t)b * 15 + (15 - r)) * D + col);
                    const f32x4 d = sum * (1.0f / (float)w) - xt;
                    v2u o; o.x = pk2(d.x, d.y); o.y = pk2(d.z, d.w); *(v2u*)(DS + b * D + col) = o;
                }
                for (int it = wg * NTHREADS + tid; it < SBT * 14 * 256; it += G * NTHREADS) {
                    const int b = it / (14 * 256), rem = it % (14 * 256), r = rem >> 8, c4 = rem & 255;
                    *(f32x4*)(out + O_PS + ((size_t)b * 15 + r) * D + 4 * c4) = *(const f32x4*)(state_pool + ((size_t)b * 15 + r + 1) * D + 4 * c4);
                }
            }
            PH_END;
            if (PH_ON(10)) {
                { SDescResid dsc{XS, PRES, 1.0f, pool_scale, 1}; sgemm32<1>(DS, D, W_POOL, 256, 256, 32, wg, G, redS, tid, dsc); }
                pg8::Gemm g{DB, W_POOL, D, 256, 256, 512}; pg8::StaticOrder S; S.init(M, D, G, wg);
                pg8::EpiResid<true> E{XA, PRE, 1.0f, pool_scale};
                pg8::gemm_phase<pg8::EpiResid<true>, pg8::StaticOrder, true, true>(lds + RING_OFF, g, S, E, tid);
            }
            PH_END;
            if (PH_ON(11)) {
                const float* gg = ln_g + 4 * D; const float* bb = ln_b + 4 * D;
                for (int m = gw; m < M + SBT; m += NGW) {
                    if (m < M) ln_row(PRE + (size_t)m * D, gg, bb, XA + (size_t)m * D, XB + (size_t)m * D, nullptr, lane);
                    else ln_row(PRES + (size_t)(m - M) * D, gg, bb, XS + (size_t)(m - M) * D, XSB + (size_t)(m - M) * D, nullptr, lane);
                }
            }
            PH_END;
        }
    }
#undef PH_ON
#undef PH_END
#undef ws
#undef out
#undef MISC
}

extern "C" void kernel_launch(void* const* d_in, const int* in_sizes, int n_in, void* d_out, int out_size, void* d_ws, size_t ws_size, hipStream_t stream) {
    static int grid = 0;
    if (grid == 0) {
        if (n_in != 17 || out_size != (int)O_END || ws_size < WS_END) { fprintf(stderr, "kernel_launch: unexpected sizes n_in %d out %d ws %zu\n", n_in, out_size, ws_size); grid = -1; return; }
        int dev = 0, cus = 0, per_cu = 0;
        if (hipGetDevice(&dev) != hipSuccess || hipDeviceGetAttribute(&cus, hipDeviceAttributeMultiprocessorCount, dev) != hipSuccess) { grid = -1; return; }
        if (hipFuncSetAttribute((const void*)fwd, hipFuncAttributeMaxDynamicSharedMemorySize, LDS_BYTES) != hipSuccess) { fprintf(stderr, "kernel_launch: hipFuncSetAttribute failed\n"); grid = -1; return; }
        if (hipOccupancyMaxActiveBlocksPerMultiprocessor(&per_cu, (const void*)fwd, NTHREADS, LDS_BYTES) != hipSuccess || per_cu < 1)
            fprintf(stderr, "kernel_launch: note: occupancy query reports %d workgroups per CU\n", per_cu);
        (void)hipGetLastError();
        grid = cus;
    }
    if (grid < 0) return;
    (void)hipMemsetAsync((char*)d_ws + WS_CTL, 0, CTL_ZERO_BYTES, stream);
    Args a{};
    for (int i = 0; i < 17; ++i) a.in[i] = d_in[i];
    a.out = (float*)d_out; a.ws = (unsigned char*)d_ws;
#ifndef MK_ONE_LAUNCH
#define MK_ONE_LAUNCH 1
#endif
    if (MK_ONE_LAUNCH) {
        a.ph_lo = 0; a.ph_hi = N_PHASES;
        hipLaunchKernelGGL(fwd, dim3(grid), dim3(NTHREADS), LDS_BYTES, stream, a);
    } else {
        for (int p = 0; p < N_PHASES; ++p) { a.ph_lo = p; a.ph_hi = p + 1; hipLaunchKernelGGL(fwd, dim3(grid), dim3(NTHREADS), LDS_BYTES, stream, a); }
    }
}
```

```cpp
#include <hip/hip_runtime.h>
#include <cstdio>
#include <cstdint>
#include <cmath>
namespace pg8 {
#define PG8_LAS __attribute__((address_space(3)))
typedef unsigned short bf16_t;
typedef short bf16x8 __attribute__((ext_vector_type(8)));
typedef float f32x4 __attribute__((ext_vector_type(4)));
typedef unsigned u32x4 __attribute__((ext_vector_type(4)));
constexpr int BM = 256, BK = 64, HALF = 128, HTB = HALF * BK * 2  , STAGE_BYTES = 8 * HTB, NXCD = 8, WGM = 8;

__host__ __device__ __forceinline__ int lds_byte(int r, int c) { const int st = (r >> 4) * 2 + (c >> 5), rr = r & 15, cc = c & 31, ob = rr * 64 + cc * 2; return st * 1024 + (ob ^ (((ob >> 9) & 1) << 5)); }
__host__ __device__ __forceinline__ void stage_rc(int b, int& R, int& C) { const int st = b / 1024, sb = b % 1024, swz = sb ^ (((sb >> 9) & 1) << 5); R = (st >> 1) * 16 + swz / 64; C = (st & 1) * 32 + (swz % 64) / 2; }
__host__ __device__ __forceinline__ int perm32(int rho) { const int n = rho >> 4, i = rho & 15; return 8 * (i >> 2) + 4 * n + (i & 3); }

struct Unit { int pm, pn; };
struct Gemm { const bf16_t* A; const bf16_t* Bt; int lda, ldb, K, a_pn_step; };

struct StaticOrder {
    int nM, nN, nwg, G, c;
    __host__ __device__ void init(int M, int N, int G_, int c_) { nM = M / BM; nN = N / BM; nwg = nM * nN; G = G_; c = c_; }
    __host__ __device__ bool next(int i, Unit& u) const {
        const long L = (long)i * G + c; if (L >= nwg) return false;
        int wgid = (int)L; { const int q = nwg / NXCD, r = nwg % NXCD, xcd = wgid % NXCD, off = wgid / NXCD; wgid = (xcd < r ? xcd * (q + 1) : r * (q + 1) + (xcd - r) * q) + off; }
        const int nig = WGM * nN, gid = wgid / nig, fm = gid * WGM, gsz = (nM - fm) < WGM ? (nM - fm) : WGM;
        u.pm = fm + ((wgid % nig) % gsz); u.pn = (wgid % nig) / gsz; return true;
    }
    __device__ __forceinline__ void a_ready(const Unit&) const {}
    __device__ __forceinline__ void done(const Unit&) const {}
};
__device__ __forceinline__ unsigned cvt_pk_bf16(float lo, float hi) { unsigned r; asm volatile("v_cvt_pk_bf16_f32 %0, %1, %2" : "=v"(r) : "v"(lo), "v"(hi)); return r; }
template <class Epi, class Sched, bool ALIGN_EPI = false, bool SP2 = false>
__device__ __forceinline__ void gemm_phase(PG8_LAS unsigned char* lds, const Gemm g, const Sched& S, const Epi& E, int tid_in) {
    int tid_l = tid_in; asm volatile("" : "+v"(tid_l));
    const int tid = tid_l, wid = __builtin_amdgcn_readfirstlane(tid >> 6), lane = tid & 63, wr = wid >> 2, wc = wid & 3, fr = lane & 15, fq = lane >> 4;
    const int K = g.K, nt = K / BK;
    unsigned voffA[2], voffB[2];
#pragma unroll
    for (int i = 0; i < 2; ++i) { int R, C; stage_rc(tid * 16 + i * 8192, R, C); const int Rb = Epi::PERM ? ((R & ~31) + perm32(R & 31)) : R;
        voffA[i] = (unsigned)(R * g.lda + C) * 2u; voffB[i] = (unsigned)(Rb * g.ldb + C) * 2u; }
    const size_t kstep = (size_t)(BK * 2);
    const size_t hstepA = (size_t)HALF * g.lda * 2, hstepB = (size_t)HALF * g.ldb * 2;
    const size_t tstepA = 2 * hstepA, tstepB = 2 * hstepB;
    const unsigned ldsw = (unsigned)wid * 1024u;
    const int aoff = lds_byte(wr * 64 + fr, fq * 8), boff = lds_byte(wc * 32 + fr, fq * 8);
#define PG8_SA(b, h) (((b) * 2 + (h)) * HTB)
#define PG8_SB(b, h) ((4 + (b) * 2 + (h)) * HTB)
#define PG8_STAGE(bufoff, gbase, voff) do { _Pragma("unroll") for (int _i = 0; _i < 2; ++_i) \
        __builtin_amdgcn_global_load_lds((const unsigned*)((const char*)(gbase) + (voff)[_i]), (PG8_LAS unsigned*)(lds + (bufoff) + ldsw + _i * 8192), 16, 0, 0); } while (0)
#define PG8_LDA(dst, b, h) do { _Pragma("unroll") for (int m = 0; m < 4; ++m) _Pragma("unroll") for (int k = 0; k < 2; ++k) dst[m][k] = *(const PG8_LAS bf16x8*)(lds + PG8_SA(b, h) + aoff + m * 2048 + k * 1024); } while (0)
#define PG8_LDB(dst, b, h) do { _Pragma("unroll") for (int n = 0; n < 2; ++n) _Pragma("unroll") for (int k = 0; k < 2; ++k) dst[n][k] = *(const PG8_LAS bf16x8*)(lds + PG8_SB(b, h) + boff + n * 2048 + k * 1024); } while (0)
#define PG8_MMA(ai, bj, At, Bt) do { __builtin_amdgcn_s_setprio(1); _Pragma("unroll") for (int m = 0; m < 4; ++m) _Pragma("unroll") for (int n = 0; n < 2; ++n) _Pragma("unroll") for (int k = 0; k < 2; ++k) \
        acc[ai][bj][m][n] = __builtin_amdgcn_mfma_f32_16x16x32_bf16(Bt[n][k], At[m][k], acc[ai][bj][m][n], 0, 0, 0); __builtin_amdgcn_s_setprio(0); } while (0)
#define PG8_WAIT_V(n) asm volatile("s_waitcnt vmcnt(" #n ")" ::: "memory")
#define PG8_WAIT_L(n) asm volatile("s_waitcnt lgkmcnt(" #n ")" ::: "memory")
#define PG8_BAR __builtin_amdgcn_s_barrier()
#define PG8_SCHED __builtin_amdgcn_sched_barrier(0)
    Unit cur, nxt; int ui = 0;
    if (!S.next(0, cur)) return;
    f32x4 acc[2][2][4][2];
#pragma unroll
    for (int a = 0; a < 2; ++a)
#pragma unroll
        for (int b = 0; b < 2; ++b)
#pragma unroll
            for (int m = 0; m < 4; ++m)
#pragma unroll
                for (int n = 0; n < 2; ++n) acc[a][b][m][n] = (f32x4){0.f, 0.f, 0.f, 0.f};
    bf16x8 At[4][2], B0[2][2], B1[2][2];
    const char* cA = (const char*)g.A + (size_t)cur.pm * tstepA + (size_t)cur.pn * g.a_pn_step; const char* cB = (const char*)g.Bt + (size_t)cur.pn * tstepB;
    S.a_ready(cur);
    if constexpr (SP2) {
        PG8_STAGE(PG8_SB(0, 0), cB, voffB); PG8_STAGE(PG8_SB(0, 1), cB + hstepB, voffB); PG8_STAGE(PG8_SA(0, 0), cA, voffA); PG8_STAGE(PG8_SA(0, 1), cA + hstepA, voffA);
        if (wr == 1) PG8_BAR;
        PG8_WAIT_V(2); PG8_BAR;
        PG8_STAGE(PG8_SB(1, 0), cB + kstep, voffB); PG8_STAGE(PG8_SA(1, 0), cA + kstep, voffA); PG8_STAGE(PG8_SB(1, 1), cB + hstepB + kstep, voffB);
        PG8_WAIT_V(6); PG8_BAR;
    } else {
        PG8_STAGE(PG8_SB(0, 0), cB, voffB); PG8_STAGE(PG8_SA(0, 0), cA, voffA); PG8_STAGE(PG8_SB(0, 1), cB + hstepB, voffB); PG8_STAGE(PG8_SA(0, 1), cA + hstepA, voffA);
        if (wr == 1) PG8_BAR;
        PG8_WAIT_V(4); PG8_BAR;
        PG8_STAGE(PG8_SB(1, 0), cB + kstep, voffB); PG8_STAGE(PG8_SA(1, 0), cA + kstep, voffA); PG8_STAGE(PG8_SB(1, 1), cB + hstepB + kstep, voffB);
        PG8_WAIT_V(6); PG8_BAR;
    }
    for (;;) {
        const bool has_next = S.next(ui + 1, nxt);
        const char* nA = has_next ? (const char*)g.A + (size_t)nxt.pm * tstepA + (size_t)nxt.pn * g.a_pn_step : cA; const char* nB = has_next ? (const char*)g.Bt + (size_t)nxt.pn * tstepB : cB;
        for (int t = 0; t < nt; t += 2) {
            const bool last = (t == nt - 2);
            const char* a1 = cA + (size_t)(t + 1) * kstep;
            const char* a2 = last ? nA : cA + (size_t)(t + 2) * kstep; const char* b2 = last ? nB : cB + (size_t)(t + 2) * kstep;
            const char* a3 = a2 + kstep; const char* b3 = b2 + kstep;
            if (last && has_next) S.a_ready(nxt);
            if constexpr (SP2) {
            PG8_LDB(B0, 0, 0); PG8_LDB(B1, 0, 1); PG8_SCHED; PG8_LDA(At, 0, 0); PG8_STAGE(PG8_SA(1, 1), a1 + hstepA, voffA);
            PG8_WAIT_V(8); PG8_WAIT_L(0); PG8_BAR; PG8_MMA(0, 0, At, B0); PG8_MMA(0, 1, At, B1); PG8_BAR; PG8_SCHED;
            PG8_LDA(At, 0, 1); PG8_STAGE(PG8_SB(0, 0), b2, voffB); PG8_STAGE(PG8_SB(0, 1), b2 + hstepB, voffB); PG8_STAGE(PG8_SA(0, 0), a2, voffA);
            PG8_WAIT_V(8); PG8_WAIT_L(0); PG8_BAR; PG8_MMA(1, 0, At, B0); PG8_MMA(1, 1, At, B1); PG8_BAR; PG8_SCHED;
            PG8_LDB(B0, 1, 0); PG8_LDB(B1, 1, 1); PG8_SCHED; PG8_LDA(At, 1, 0); PG8_STAGE(PG8_SA(0, 1), a2 + hstepA, voffA);
            PG8_WAIT_V(8); PG8_WAIT_L(0); PG8_BAR; PG8_MMA(0, 0, At, B0); PG8_MMA(0, 1, At, B1); PG8_BAR; PG8_SCHED;
            PG8_LDA(At, 1, 1); PG8_STAGE(PG8_SB(1, 0), b3, voffB); PG8_STAGE(PG8_SB(1, 1), b3 + hstepB, voffB); PG8_STAGE(PG8_SA(1, 0), a3, voffA);
            PG8_WAIT_V(8); PG8_WAIT_L(0); PG8_BAR; PG8_MMA(1, 0, At, B0); PG8_MMA(1, 1, At, B1); PG8_BAR; PG8_SCHED;
            } else {
            PG8_LDB(B0, 0, 0); PG8_SCHED; PG8_LDA(At, 0, 0); PG8_STAGE(PG8_SA(1, 1), a1 + hstepA, voffA);
            PG8_WAIT_L(8); PG8_BAR; PG8_WAIT_L(0); PG8_MMA(0, 0, At, B0); PG8_BAR; PG8_SCHED;
            PG8_LDB(B1, 0, 1); PG8_STAGE(PG8_SB(0, 0), b2, voffB);
            PG8_BAR; PG8_WAIT_L(0); PG8_MMA(0, 1, At, B1); PG8_BAR;
            PG8_LDA(At, 0, 1); PG8_STAGE(PG8_SA(0, 0), a2, voffA);
            PG8_BAR; PG8_WAIT_L(0); PG8_MMA(1, 0, At, B0); PG8_BAR; PG8_SCHED;
            PG8_STAGE(PG8_SB(0, 1), b2 + hstepB, voffB);
            PG8_WAIT_V(6); PG8_BAR; PG8_MMA(1, 1, At, B1); PG8_BAR;
            PG8_LDB(B0, 1, 0); PG8_SCHED; PG8_LDA(At, 1, 0); PG8_STAGE(PG8_SA(0, 1), a2 + hstepA, voffA);
            PG8_WAIT_L(8); PG8_BAR; PG8_WAIT_L(0); PG8_MMA(0, 0, At, B0); PG8_BAR; PG8_SCHED;
            PG8_LDB(B1, 1, 1); PG8_STAGE(PG8_SB(1, 0), b3, voffB);
            PG8_BAR; PG8_WAIT_L(0); PG8_MMA(0, 1, At, B1); PG8_BAR;
            PG8_LDA(At, 1, 1); PG8_STAGE(PG8_SA(1, 0), a3, voffA);
            PG8_BAR; PG8_WAIT_L(0); PG8_MMA(1, 0, At, B0); PG8_BAR; PG8_SCHED;
            PG8_STAGE(PG8_SB(1, 1), b3 + hstepB, voffB);
            PG8_WAIT_V(6); PG8_BAR; PG8_MMA(1, 1, At, B1); PG8_BAR;
            }
        }
        if constexpr (ALIGN_EPI) { if (wr == 0) PG8_BAR; }
        if constexpr (!Epi::AFTER_DRAIN) { int l2_; asm volatile("v_mbcnt_lo_u32_b32 %0, -1, 0\n\tv_mbcnt_hi_u32_b32 %0, -1, %0" : "=v"(l2_)); E(acc, cur, wr, wc, l2_ & 15, l2_ >> 4); S.done(cur); }
        if (!has_next) break;
#pragma unroll
        for (int a = 0; a < 2; ++a)
#pragma unroll
            for (int b = 0; b < 2; ++b)
#pragma unroll
                for (int m = 0; m < 4; ++m)
#pragma unroll
                    for (int n = 0; n < 2; ++n) acc[a][b][m][n] = (f32x4){0.f, 0.f, 0.f, 0.f};
        cur = nxt; cA = nA; cB = nB; ++ui;
        if constexpr (ALIGN_EPI) { if (wr == 1) PG8_BAR; }
    }
    PG8_WAIT_V(0);
    if constexpr (!ALIGN_EPI) { if (wr == 0) PG8_BAR; }
    PG8_BAR;
    if constexpr (Epi::AFTER_DRAIN) { E.fused(acc, cur, wr, wc, fr, fq, lds, wid, lane); S.done(cur); }
#undef PG8_SA
#undef PG8_SB
#undef PG8_STAGE
#undef PG8_LDA
#undef PG8_LDB
#undef PG8_MMA
#undef PG8_WAIT_V
#undef PG8_WAIT_L
#undef PG8_BAR
#undef PG8_SCHED
}
}

constexpr int D = 1024, BATCH = 8, SEQ = 4096, M = BATCH * SEQ, SBT = 32;
constexpr int FF = 2816, NWI = 2 * FF;
constexpr int NKV = 4, KVW = 256;
constexpr int NPROJ = 2120, NPROJP = 2304;
constexpr int PAST = 16384, PAGE = 128, NPAGES = 128;
constexpr int NKEYS_S = PAST + 1, SCLD = 16448;
constexpr int TOPK = 256;
constexpr float LN_EPS = 1e-5f;
constexpr float ALPHA = 1.4142135623730951f;
constexpr float QSCALE = 0.125f * 1.4426950408889634f;
constexpr float WSCALE = 0.125f * 0.35355339059327373f;

constexpr size_t O_YP = 0, O_YS = 33554432, O_KP = 33587200, O_VP = 41975808, O_KIP = 50364416, O_PP = 52461568,
                 O_KS = 52584448, O_VS = 52592640, O_KIS = 52600832, O_PS = 52602880, O_END = 53094400;

constexpr size_t MiB = 1u << 20;
constexpr size_t WS_CTL = 0, CTL_ZERO_BYTES = 1 * MiB;
constexpr size_t WS_WI = 2 * MiB;
constexpr size_t WI_STRIDE = 11 * MiB;
constexpr size_t WS_WO = 46 * MiB;
constexpr size_t WO_STRIDE = (size_t)D * FF * 2;
constexpr size_t WS_WIN = 68 * MiB;
constexpr size_t WS_WOA = 73 * MiB;
constexpr size_t WS_WPOOL = 75 * MiB;
constexpr size_t WS_ROPE = 76 * MiB;
constexpr size_t WS_XB = 80 * MiB;
constexpr size_t WS_XA = 144 * MiB;
constexpr size_t WS_PRE = 272 * MiB;
constexpr size_t WS_G = 400 * MiB;
constexpr size_t WS_QB = 576 * MiB;
constexpr size_t WS_OB = 640 * MiB;
constexpr size_t WS_KB = 704 * MiB;
constexpr size_t WS_VB = 720 * MiB;
constexpr size_t WS_QIB = 736 * MiB;
constexpr size_t WS_KIB = 768 * MiB;
constexpr size_t WS_WIF = 772 * MiB;
constexpr size_t WS_MASK = 776 * MiB;
constexpr size_t WS_LIST = 792 * MiB;
constexpr size_t WS_DB = 808 * MiB;
constexpr size_t WS_S = 880 * MiB;
constexpr size_t S_XS = 0, S_PRES = 131072, S_XSB = 262144, S_GS = 327680, S_QS = 524288, S_QIS = 655360, S_WIS = 720896,
                 S_OS = 786432, S_DS = 851968, S_SC = 1048576;
constexpr size_t WS_END = 884 * MiB;

constexpr int CW_BAR = 4096;

constexpr int RING_OFF = 0, RING_BYTES = 131072;
constexpr int MISC_OFF = RING_BYTES;
constexpr int LDS_BYTES = 147456;
constexpr int NWAVES = 8, NTHREADS = 512;

#define GAS __attribute__((address_space(1)))
#define LAS __attribute__((address_space(3)))
typedef unsigned short bf16;
typedef unsigned v4u __attribute__((ext_vector_type(4)));
typedef unsigned v2u __attribute__((ext_vector_type(2)));
typedef float f32x4 __attribute__((ext_vector_type(4)));
typedef float f32x2 __attribute__((ext_vector_type(2)));
typedef float f32x16 __attribute__((ext_vector_type(16)));
typedef short bf16x8 __attribute__((ext_vector_type(8)));
#define LDS_WAIT() asm volatile("s_waitcnt lgkmcnt(0)" ::: "memory")
#define VM_WAIT() asm volatile("s_waitcnt vmcnt(0)" ::: "memory")
__device__ __forceinline__ unsigned f2bf(float f) { unsigned u = __builtin_bit_cast(unsigned, f); return (u + 0x7fffu + ((u >> 16) & 1u)) >> 16; }
__device__ __forceinline__ unsigned pk2(float lo, float hi) { return f2bf(lo) | (f2bf(hi) << 16); }
__device__ __forceinline__ float bf2f(unsigned short b) { return __builtin_bit_cast(float, (unsigned)b << 16); }
#define DPP_ROR(v, n) __uint_as_float((unsigned)__builtin_amdgcn_update_dpp(0, (int)__float_as_uint(v), 0x120 + (n), 0xf, 0xf, false))
#define RDL(v, l) __uint_as_float((unsigned)__builtin_amdgcn_readlane((int)__float_as_uint(v), (l)))
__device__ __forceinline__ float wave_sum(float v) {
    v += DPP_ROR(v, 1); v += DPP_ROR(v, 2); v += DPP_ROR(v, 4); v += DPP_ROR(v, 8);
    return (RDL(v, 0) + RDL(v, 16)) + (RDL(v, 32) + RDL(v, 48));
}
__device__ __forceinline__ float wave_max(float v) {
    v = fmaxf(v, DPP_ROR(v, 1)); v = fmaxf(v, DPP_ROR(v, 2)); v = fmaxf(v, DPP_ROR(v, 4)); v = fmaxf(v, DPP_ROR(v, 8));
    return fmaxf(fmaxf(RDL(v, 0), RDL(v, 16)), fmaxf(RDL(v, 32), RDL(v, 48)));
}
__device__ __forceinline__ float wave_min(float v) {
    v = fminf(v, DPP_ROR(v, 1)); v = fminf(v, DPP_ROR(v, 2)); v = fminf(v, DPP_ROR(v, 4)); v = fminf(v, DPP_ROR(v, 8));
    return fminf(fminf(RDL(v, 0), RDL(v, 16)), fminf(RDL(v, 32), RDL(v, 48)));
}
__device__ __forceinline__ float silu_f(float x) { return x * __builtin_amdgcn_rcpf(1.0f + __builtin_amdgcn_exp2f(-1.4426950408889634f * x)); }
__device__ __forceinline__ int mbcnt64(unsigned long long m) { return (int)__builtin_amdgcn_mbcnt_hi((unsigned)(m >> 32), __builtin_amdgcn_mbcnt_lo((unsigned)m, 0u)); }

namespace pg8 {
struct EpiSwiglu {
    static constexpr bool PERM = true, AFTER_DRAIN = false;
    bf16_t* G;
    __device__ __forceinline__ void operator()(const f32x4 (&acc)[2][2][4][2], const Unit& u, int wr, int wc, int fr, int fq) const {
        const int row0 = u.pm * BM + wr * 64 + fr; const int col0 = u.pn * HALF + wc * 32 + 8 * fq;
#pragma unroll
        for (int ai = 0; ai < 2; ++ai)
#pragma unroll
            for (int m = 0; m < 4; ++m) {
                bf16_t* rowp = G + (size_t)(row0 + ai * HALF + m * 16) * FF + col0;
                const f32x4 g0 = acc[ai][0][m][0], g1 = acc[ai][0][m][1], u0 = acc[ai][1][m][0], u1 = acc[ai][1][m][1];
                u32x4 w;
                w.x = cvt_pk_bf16(silu_f(g0[0]) * u0[0], silu_f(g0[1]) * u0[1]); w.y = cvt_pk_bf16(silu_f(g0[2]) * u0[2], silu_f(g0[3]) * u0[3]);
                w.z = cvt_pk_bf16(silu_f(g1[0]) * u1[0], silu_f(g1[1]) * u1[1]); w.w = cvt_pk_bf16(silu_f(g1[2]) * u1[2], silu_f(g1[3]) * u1[3]);
                *(u32x4*)rowp = w;
            }
    }
};
template <bool HAS_CS> struct EpiResid {
    static constexpr bool PERM = false, AFTER_DRAIN = false;
    const float* X; float* P; float s; const float* cs;
    __device__ __forceinline__ void operator()(const f32x4 (&acc)[2][2][4][2], const Unit& u, int wr, int wc, int fr, int fq) const {
        const int row0 = u.pm * BM + wr * 64 + fr; const int col0 = u.pn * BM + wc * 32 + 4 * fq;
        f32x4 sc[2][2];
        if (HAS_CS) {
#pragma unroll
            for (int bj = 0; bj < 2; ++bj)
#pragma unroll
                for (int n = 0; n < 2; ++n) sc[bj][n] = *(const f32x4*)(cs + col0 + bj * HALF + n * 16) * s;
        }
#pragma unroll
        for (int ai = 0; ai < 2; ++ai)
#pragma unroll
            for (int m = 0; m < 4; ++m) {
                const size_t off = (size_t)(row0 + ai * HALF + m * 16) * D + col0;
                const float* xp = X + off; float* pp = P + off;
#pragma unroll
                for (int bj = 0; bj < 2; ++bj)
#pragma unroll
                    for (int n = 0; n < 2; ++n) {
                        const f32x4 x = *(const f32x4*)(xp + bj * HALF + n * 16);
                        if (HAS_CS) *(f32x4*)(pp + bj * HALF + n * 16) = x * ALPHA + acc[ai][bj][m][n] * sc[bj][n];
                        else *(f32x4*)(pp + bj * HALF + n * 16) = x * ALPHA + acc[ai][bj][m][n] * s;
                    }
                asm volatile("" ::: "memory");
            }
    }
};
struct EpiProj {
    static constexpr bool PERM = false, AFTER_DRAIN = false;
    unsigned char* wsb; float* outb;
    __device__ __forceinline__ void operator()(const f32x4 (&acc)[2][2][4][2], const Unit& u, int wr, int wc, int fr, int fq) const {
        const int pn = u.pn;
        const int row0 = u.pm * BM + wr * 64 + fr;
        const bool rot_tile = (pn != 5) && ((wc & 1) == 0) && (pn < 8 || wc == 0);
        const f32x2* rope = (const f32x2*)(wsb + WS_ROPE);
        const float sg = (fq < 2) ? -1.f : 1.f;
        size_t bf_off, f_off = 0; int ldb_, ldf_ = 0, colmax = 256; float scl = 1.f; bool hasf = false;
        if (pn < 4)       { bf_off = WS_QB + (size_t)pn * BM * 2; ldb_ = D; scl = QSCALE; }
        else if (pn == 4) { bf_off = WS_KB; ldb_ = KVW; f_off = O_KP; ldf_ = KVW; hasf = true; }
        else if (pn == 5) { bf_off = WS_VB; ldb_ = KVW; f_off = O_VP; ldf_ = KVW; hasf = true; }
        else if (pn < 8)  { bf_off = WS_QIB + (size_t)(pn - 6) * BM * 2; ldb_ = 512; }
        else              { bf_off = WS_KIB; ldb_ = 64; f_off = O_KIP; ldf_ = 64; hasf = true; colmax = 64; }
        bf16_t* bfb = (bf16_t*)(wsb + bf_off); float* fb = outb + f_off;
#pragma unroll
        for (int ai = 0; ai < 2; ++ai)
#pragma unroll
            for (int m = 0; m < 4; ++m) {
                const int row = row0 + ai * HALF + m * 16; const int pos = row & (SEQ - 1);
#pragma unroll
                for (int bj = 0; bj < 2; ++bj)
#pragma unroll
                    for (int n = 0; n < 2; ++n) {
                        f32x4 v = acc[ai][bj][m][n];
                        const int cit = bj * HALF + wc * 32 + n * 16 + 4 * fq;
                        if (n == 0 && rot_tile && (pn < 8 || bj == 0)) {
                            const f32x2* rp = rope + pos * 8 + 4 * (fq & 1);
#pragma unroll
                            for (int j = 0; j < 4; ++j) {
                                const auto rr = __builtin_amdgcn_permlane32_swap(__float_as_uint(v[j]), __float_as_uint(v[j]), false, false);
                                const float p = __uint_as_float((fq < 2) ? rr[1] : rr[0]);
                                const f32x2 cs = rp[j];
                                v[j] = v[j] * cs.x + sg * p * cs.y;
                            }
                        }
                        if (cit < colmax) {
                            if (hasf) *(f32x4*)(fb + (size_t)row * ldf_ + cit) = v;
                            v = v * scl; v2u w; w.x = cvt_pk_bf16(v[0], v[1]); w.y = cvt_pk_bf16(v[2], v[3]);
                            *(v2u*)(bfb + (size_t)row * ldb_ + cit) = w;
                        } else if (cit < 72) {
                            *(f32x4*)((float*)(wsb + WS_WIF) + (size_t)row * 8 + (cit - 64)) = v;
                        }
                    }
                asm volatile("" ::: "memory");
            }
    }
};
}

#define XB_TMO      128
#define XB_XCNT(j)  (256  + 64 * (j))
#define XB_XSUB(j)  (1280 + 64 * (j))
#define XB_XGEN(j)  (2304 + 64 * (j))
#define XB_TOP      3328
#define XB_TOPGEN   3392
#define XCD_BAR_WORDS 3456
#define XB_SPIN_CAP (1u << 18)
__device__ __forceinline__ unsigned xb_ld(unsigned* p)              { return __hip_atomic_load(p, __ATOMIC_RELAXED, __HIP_MEMORY_SCOPE_AGENT); }
__device__ __forceinline__ unsigned xb_add(unsigned* p, unsigned v) { return __hip_atomic_fetch_add(p, v, __ATOMIC_RELAXED, __HIP_MEMORY_SCOPE_AGENT); }
__device__ __forceinline__ unsigned xb_xcc_id() { return (unsigned)__builtin_amdgcn_s_getreg((3 << 11) | 20) & 0xFu; }
#define XB_SPIN(cond, bar) do { unsigned _sp = 0; while (cond) { __builtin_amdgcn_s_sleep(1); \
    if ((++_sp & 255u) == 0u) { if (xb_ld(&(bar)[XB_TMO])) break; if (_sp > XB_SPIN_CAP) { atomicAdd(&(bar)[XB_TMO], 1u); break; } } } } while (0)
struct XcdBarrier { unsigned* bar; unsigned x; volatile LAS unsigned* st; };
__device__ __forceinline__ XcdBarrier xcd_barrier_post(unsigned* bar, volatile LAS unsigned* st, int tid) {
    XcdBarrier b; b.bar = bar; b.x = xb_xcc_id(); b.st = st;
    if (tid == 0) (void)xb_add(&bar[XB_XCNT(b.x)], 1u);
    return b;
}
__device__ __forceinline__ void xcd_barrier_complete(unsigned* bar, unsigned x, unsigned& nloc, unsigned& nx) {
    const unsigned G = gridDim.x * gridDim.y * gridDim.z;
    unsigned sum, cnt, mine, sp = 0u;
    for (;;) {
        sum = 0u; cnt = 0u; mine = 0u;
#pragma unroll
        for (unsigned j = 0; j < 16; ++j) { const unsigned c = xb_ld(&bar[XB_XCNT(j)]); sum += c; cnt += (c > 0u) ? 1u : 0u; mine = (j == x) ? c : mine; }
        if (sum == G) break;
        __builtin_amdgcn_s_sleep(1);
        if ((++sp & 255u) == 0u) { if (xb_ld(&bar[XB_TMO])) break; if (sp > XB_SPIN_CAP) { atomicAdd(&bar[XB_TMO], 1u); break; } }
    }
    nloc = mine > 0u ? mine : 1u; nx = cnt > 0u ? cnt : 1u;
}
__device__ __forceinline__ void xcd_barrier(const XcdBarrier& b, int tid) {
    asm volatile("s_waitcnt vmcnt(0)" ::: "memory");
    __syncthreads();
    if (tid == 0) {
        unsigned* bar = b.bar;
        __builtin_amdgcn_s_waitcnt(0);
        unsigned nloc = b.st[0], nx = b.st[1];
        if (nloc == 0u) { xcd_barrier_complete(bar, b.x, nloc, nx); b.st[0] = nloc; b.st[1] = nx; }
        const unsigned old = xb_add(&bar[XB_XSUB(b.x)], 1u);
        const unsigned gen = old / nloc;
        if (old + 1u == (gen + 1u) * nloc) {
            __builtin_amdgcn_fence(__ATOMIC_RELEASE, "agent");
            asm volatile("s_waitcnt vmcnt(0)" ::: "memory");
            const unsigned og = xb_add(&bar[XB_TOP], 1u);
            const unsigned tg = og / nx;
            if (og + 1u == (tg + 1u) * nx) xb_add(&bar[XB_TOPGEN], 1u);
            else XB_SPIN(xb_ld(&bar[XB_TOPGEN]) == tg, bar);
            __builtin_amdgcn_fence(__ATOMIC_ACQUIRE, "agent");
            xb_add(&bar[XB_XGEN(b.x)], 1u);
            asm volatile("s_waitcnt vmcnt(0)" ::: "memory");
        } else {
            XB_SPIN(xb_ld(&bar[XB_XGEN(b.x)]) == gen, bar);
            __builtin_amdgcn_fence(__ATOMIC_ACQUIRE, "agent");
            asm volatile("s_waitcnt vmcnt(0)" ::: "memory");
        }
    }
    __syncthreads();
}

__device__ __forceinline__ void tr_item(const float* W, int ldw, int k0, int c0, int ncv, bf16* WT, int ldt, int r0, LAS float* scr, int lane) {
#pragma unroll 8
    for (int i = 0; i < 32; ++i) { const int kk = 2 * i + (lane >> 5), c = lane & 31; scr[kk * 33 + c] = (c < ncv) ? W[(size_t)(k0 + kk) * ldw + c0 + c] : 0.f; }
    LDS_WAIT(); asm volatile("" ::: "memory");
    const int c8 = lane & 7;
#pragma unroll
    for (int j = 0; j < 4; ++j) { const int n = (lane >> 3) + 8 * j; const LAS float* s = scr + (8 * c8) * 33 + n;
        v4u o; o.x = pk2(s[0 * 33], s[1 * 33]); o.y = pk2(s[2 * 33], s[3 * 33]); o.z = pk2(s[4 * 33], s[5 * 33]); o.w = pk2(s[6 * 33], s[7 * 33]);
        *(GAS v4u*)(WT + (size_t)(r0 + n) * ldt + k0 + 8 * c8) = o; }
    LDS_WAIT(); asm volatile("" ::: "memory");
}

__device__ __forceinline__ void ln_row(const float* prow, const float* g, const float* b, float* xf, bf16* xb, float* extra, int lane) {
    const GAS f32x4* xr = (const GAS f32x4*)prow + lane;
    f32x4 v[4]; float s = 0.f;
#pragma unroll
    for (int j = 0; j < 4; ++j) { v[j] = xr[64 * j]; s += (v[j].x + v[j].y) + (v[j].z + v[j].w); }
    const float mean = wave_sum(s) * (1.f / D); float s2 = 0.f;
#pragma unroll
    for (int j = 0; j < 4; ++j) { v[j] = v[j] - mean; s2 += (v[j].x * v[j].x + v[j].y * v[j].y) + (v[j].z * v[j].z + v[j].w * v[j].w); }
    const float rstd = 1.f / sqrtf(wave_sum(s2) * (1.f / D) + LN_EPS);
#pragma unroll
    for (int j = 0; j < 4; ++j) {
        const f32x4 gg = *((const GAS f32x4*)g + lane + 64 * j), bb = *((const GAS f32x4*)b + lane + 64 * j);
        const f32x4 y = v[j] * rstd * gg + bb;
        if (xf) *((GAS f32x4*)xf + lane + 64 * j) = y;
        if (extra) *((GAS f32x4*)extra + lane + 64 * j) = y;
        if (xb) { v2u w; w.x = pk2(y.x, y.y); w.y = pk2(y.z, y.w); *((GAS v2u*)xb + lane + 64 * j) = w; }
    }
}

template <int RL>
__device__ __forceinline__ void ln_phase(unsigned char* wsb, float* outb, const float* g, const float* b, bool last, bool poolcopy, int gw, int NGW, int lane) {
    const int NR_ = M + SBT;
    for (int m0 = gw; m0 < NR_; m0 += RL * NGW) {
        const float* prow[RL]; float* xf[RL]; bf16* xb[RL]; float* extra[RL];
#pragma unroll
        for (int r = 0; r < RL; ++r) {
            int m = m0 + r * NGW; if (m >= NR_) m = m0;
            extra[r] = nullptr;
            if (m < M) {
                prow[r] = (const float*)(wsb + WS_PRE) + (size_t)m * D;
                xf[r] = last ? outb + O_YP + (size_t)m * D : (float*)(wsb + WS_XA) + (size_t)m * D;
                xb[r] = last ? nullptr : (bf16*)(wsb + WS_XB) + (size_t)m * D;
                if (poolcopy && (m & (SEQ - 1)) >= SEQ - 15) extra[r] = outb + O_PP + ((size_t)(m >> 12) * 15 + ((m & (SEQ - 1)) - (SEQ - 15))) * D;
            } else {
                const int sr = m - M;
                prow[r] = (const float*)(wsb + WS_S + S_PRES) + (size_t)sr * D;
                xf[r] = last ? outb + O_YS + (size_t)sr * D : (float*)(wsb + WS_S + S_XS) + (size_t)sr * D;
                xb[r] = last ? nullptr : (bf16*)(wsb + WS_S + S_XSB) + (size_t)sr * D;
                if (poolcopy) extra[r] = outb + O_PS + ((size_t)sr * 15 + 14) * D;
            }
        }
        f32x4 v[RL][4]; float s[RL];
#pragma unroll
        for (int r = 0; r < RL; ++r) {
            const GAS f32x4* xr = (const GAS f32x4*)prow[r] + lane; s[r] = 0.f;
#pragma unroll
            for (int j = 0; j < 4; ++j) { v[r][j] = xr[64 * j]; }
        }
#pragma unroll
        for (int r = 0; r < RL; ++r)
#pragma unroll
            for (int j = 0; j < 4; ++j) s[r] += (v[r][j].x + v[r][j].y) + (v[r][j].z + v[r][j].w);
#pragma unroll
        for (int r = 0; r < RL; ++r) s[r] = wave_sum(s[r]);
        float s2[RL];
#pragma unroll
        for (int r = 0; r < RL; ++r) { const float mean = s[r] * (1.f / D); s2[r] = 0.f;
#pragma unroll
            for (int j = 0; j < 4; ++j) { v[r][j] = v[r][j] - mean; s2[r] += (v[r][j].x * v[r][j].x + v[r][j].y * v[r][j].y) + (v[r][j].z * v[r][j].z + v[r][j].w * v[r][j].w); } }
#pragma unroll
        for (int r = 0; r < RL; ++r) s2[r] = wave_sum(s2[r]);
#pragma unroll
        for (int j = 0; j < 4; ++j) {
            const f32x4 gg = *((const GAS f32x4*)g + lane + 64 * j), bb = *((const GAS f32x4*)b + lane + 64 * j);
#pragma unroll
            for (int r = 0; r < RL; ++r) {
                const float rstd = 1.f / sqrtf(s2[r] * (1.f / D) + LN_EPS);
                const f32x4 y = v[r][j] * rstd * gg + bb;
                *((GAS f32x4*)xf[r] + lane + 64 * j) = y;
                if (extra[r]) *((GAS f32x4*)extra[r] + lane + 64 * j) = y;
                if (xb[r]) { v2u w; w.x = pk2(y.x, y.y); w.y = pk2(y.z, y.w); *((GAS v2u*)xb[r] + lane + 64 * j) = w; }
            }
        }
    }
}

template <int W>
__device__ __forceinline__ void pool_seg(const float* X, bf16* Dst, int row0, int col) {
    const int t0 = row0 & (SEQ - 1);
    f32x4 ring[W]; f32x4 sum = (f32x4){0.f, 0.f, 0.f, 0.f};
#pragma unroll
    for (int k = 0; k < W; ++k) ring[k] = (f32x4){0.f, 0.f, 0.f, 0.f};
    if (t0 > 0) {
#pragma unroll
        for (int k = 1; k < W; ++k) { ring[k] = *(const f32x4*)(X + (size_t)(row0 - W + k) * D + col); sum = sum + ring[k]; }
    }
    for (int r = 0; r < 64; r += W) {
#pragma unroll
        for (int u = 0; u < W; ++u) {
            const int row = row0 + r + u; const int t = t0 + r + u;
            const f32x4 x = *(const f32x4*)(X + (size_t)row * D + col);
            sum = sum + x - ring[u];
            ring[u] = x;
            const float inv = 1.0f / (float)((t + 1 < W) ? t + 1 : W);
            const f32x4 d = sum * inv - x;
            v2u o; o.x = pk2(d.x, d.y); o.y = pk2(d.z, d.w); *(v2u*)(Dst + (size_t)row * D + col) = o;
        }
    }
}

template <int NT, class Desc>
__device__ __forceinline__ void sgemm32(const bf16* Xb, int lda, const bf16* Bt, int ldb, int K, int nitems, int wg, int nwg, LAS float* red, int tid, const Desc& dsc) {
    asm volatile("" : "+v"(tid));
    const int lane = tid & 63, wid = tid >> 6, r = lane & 31, h = lane >> 5;
    const int kper = K >> 3;
    LAS float* T = red + 8 * NT * 1024;
    for (int it = wg; it < nitems; it += nwg) {
        f32x16 acc[NT];
#pragma unroll
        for (int nt = 0; nt < NT; ++nt) acc[nt] = (f32x16){};
        const bf16* ap = Xb + (size_t)r * lda + dsc.aoff(it) + wid * kper + h * 8;
        const bf16* bp[NT];
#pragma unroll
        for (int nt = 0; nt < NT; ++nt) bp[nt] = Bt + (size_t)(dsc.ct(it, nt) * 32 + r) * ldb + wid * kper + h * 8;
        for (int k = 0; k < kper; k += 16) {
            const bf16x8 a = *(const bf16x8*)(ap + k);
#pragma unroll
            for (int nt = 0; nt < NT; ++nt) { const bf16x8 b = *(const bf16x8*)(bp[nt] + k); acc[nt] = __builtin_amdgcn_mfma_f32_32x32x16_bf16(a, b, acc[nt], 0, 0, 0); }
        }
#pragma unroll
        for (int nt = 0; nt < NT; ++nt)
#pragma unroll
            for (int rr = 0; rr < 16; ++rr) red[(wid * NT + nt) * 1024 + rr * 64 + lane] = acc[nt][rr];
        __syncthreads();
        for (int e = tid; e < NT * 1024; e += NTHREADS) {
            const int nt = e >> 10, x = e & 1023; float s = 0.f;
#pragma unroll
            for (int w = 0; w < 8; ++w) s += red[(w * NT + nt) * 1024 + x];
            const int rr = x >> 6, l = x & 63, j = l & 31, i = (rr & 3) + 8 * (rr >> 2) + 4 * (l >> 5);
            T[nt * 1056 + i * 33 + j] = s;
        }
        __syncthreads();
        dsc.epi(it, T, tid);
        __syncthreads();
    }
}
struct SDescG1 {
    bf16* GS;
    __device__ __forceinline__ int aoff(int) const { return 0; }
    __device__ __forceinline__ int ct(int it, int nt) const { return 8 * (it >> 2) + (it & 3) + 4 * nt; }
    __device__ __forceinline__ void epi(int it, const LAS float* T, int tid) const {
        for (int e = tid; e < 1024; e += NTHREADS) { const int i = e >> 5, j = e & 31; const float g = T[i * 33 + j], u = T[1056 + i * 33 + j];
            GS[i * FF + 128 * (it >> 2) + 32 * (it & 3) + j] = (bf16)f2bf(silu_f(g) * u); }
    }
};
struct SDescResid {
    const float* X; float* P; float s; const float* cs; int agroup;
    __device__ __forceinline__ int aoff(int it) const { return agroup ? 256 * (it >> 3) : 0; }
    __device__ __forceinline__ int ct(int it, int) const { return it; }
    __device__ __forceinline__ void epi(int it, const LAS float* T, int tid) const {
        for (int e = tid; e < 1024; e += NTHREADS) { const int i = e >> 5, j = e & 31, col = it * 32 + j; float a = T[i * 33 + j] * s; if (cs) a *= cs[col];
            P[i * D + col] = ALPHA * X[i * D + col] + a; }
    }
};
struct SDescProj {
    float *QS, *QIS, *WIS, *outK, *outV, *outKI; const f32x2* rope;
    __device__ __forceinline__ int aoff(int) const { return 0; }
    __device__ __forceinline__ int ct(int it, int) const { return it; }
    __device__ __forceinline__ void epi(int it, const LAS float* T, int tid) const {
        for (int e = tid; e < 1024; e += NTHREADS) {
            const int i = e >> 5, j = e & 31, col = it * 32 + j;
            if (col >= NPROJ) continue;
            float v = T[i * 33 + j];
            const bool rot_region = (col < 1280) || (col >= 1536 && col < 2112);
            if (rot_region && ((it & 1) == 0) && j < 16) {
                const int f = j & 7; const float x1 = T[i * 33 + f], x2 = T[i * 33 + f + 8]; const f32x2 cs = rope[f];
                v = (j < 8) ? (x1 * cs.x - x2 * cs.y) : (x2 * cs.x + x1 * cs.y);
            }
            if (col < 1024) QS[i * D + col] = v * QSCALE;
            else if (col < 1280) outK[i * KVW + col - 1024] = v;
            else if (col < 1536) outV[i * KVW + col - 1280] = v;
            else if (col < 2048) QIS[i * 512 + col - 1536] = v;
            else if (col < 2112) outKI[i * 64 + col - 2048] = v;
            else WIS[i * 8 + col - 2112] = v;
        }
    }
};

template <int NR>
__device__ __forceinline__ void select_row(const LAS float* Srow, int t, int lane, unsigned* maskrow) {
    float v[NR];
#pragma unroll
    for (int i = 0; i < NR; ++i) { const int key = i * 64 + lane; const float x = Srow[key] + 0.0f; v[i] = (key <= t) ? x : -INFINITY; }
#define SEL_CNT(OUT, PRED) do { int c_ = 0; _Pragma("unroll") for (int i_ = 0; i_ < NR; ++i_) c_ += __builtin_popcountll(__ballot(v[i_] PRED)); OUT = c_; } while (0)
    float T = -INFINITY; int need = 0;
    if (t + 1 > TOPK) {
        float mn = INFINITY, mx = -INFINITY;
#pragma unroll
        for (int i = 0; i < NR; ++i) { mx = fmaxf(mx, v[i]); mn = fminf(mn, (v[i] == -INFINITY) ? INFINITY : v[i]); }
        float lo = wave_min(mn), hi = wave_max(mx);
        int c; SEL_CNT(c, >= hi);
        if (c >= TOPK) T = hi;
        else {
            T = lo;
            for (int itn = 0; itn < 400; ++itn) {
                const float mid = lo + (hi - lo) * 0.5f;
                if (!(mid > lo) || !(mid < hi)) { T = lo; break; }
                SEL_CNT(c, >= mid);
                if (c == TOPK) { T = mid; break; }
                if (c > TOPK) lo = mid; else hi = mid;
                T = lo;
            }
        }
        int cgt; SEL_CNT(cgt, > T);
        need = TOPK - cgt;
    }
#undef SEL_CNT
    unsigned mlo = 0u, mhi = 0u;
#pragma unroll
    for (int i = 0; i < NR; ++i) {
        const bool gt = v[i] > T; bool eq = (v[i] == T) && (need > 0);
        unsigned long long meq = __ballot(eq); int k = __builtin_popcountll(meq);
        if (k > need) { eq = eq && (mbcnt64(meq) < need); meq = __ballot(eq); k = need; }
        need -= k;
        const unsigned long long m = __ballot(gt) | meq;
        { const unsigned m0_ = (unsigned)m, m1_ = (unsigned)(m >> 32); asm volatile("v_writelane_b32 %0, %1, %2" : "+v"(mlo) : "s"(m0_), "n"(i)); asm volatile("v_writelane_b32 %0, %1, %2" : "+v"(mhi) : "s"(m1_), "n"(i)); }
    }
    v2u mw; mw.x = mlo; mw.y = mhi;
    *((v2u*)maskrow + lane) = mw;
}
__device__ __forceinline__ void index_select_phase(const bf16* QIb, const bf16* KIb, const float* WIf, unsigned* MASK,
                                                   LAS float* S, int wg, int nwg, int tid) {
    const int wid = __builtin_amdgcn_readfirstlane(tid >> 6);
    const int ngroups = M / 8;
    for (int rd = 0; rd * nwg < ngroups; ++rd) {
        { int l_ = tid; asm volatile("" : "+v"(l_)); tid = l_; }
        const int lane = tid & 63, r = lane & 31, hh = lane >> 5;
        const int o = rd * nwg + ((rd & 1) ? (nwg - 1 - wg) : wg);
        if (o < ngroups) {
            const int qg = o >> 3, b = o & 7, t0 = qg * 8, rb = b * SEQ + t0;
            const int nkt = (t0 + 8 + 31) >> 5;
            bf16x8 A[2][4]; float W[2][16];
            const bf16* kbase = KIb + (size_t)(b * SEQ + r) * 64 + hh * 8;
            bf16x8 Bn[4];
            if (wid < nkt) {
#pragma unroll
                for (int d0 = 0; d0 < 4; ++d0) Bn[d0] = *(const bf16x8*)(kbase + (size_t)wid * 32 * 64 + d0 * 16);
            }
#pragma unroll
            for (int mt = 0; mt < 2; ++mt) {
#pragma unroll
                for (int d0 = 0; d0 < 4; ++d0) A[mt][d0] = *(const bf16x8*)(QIb + (size_t)(rb + 4 * mt + (r >> 3)) * 512 + (r & 7) * 64 + d0 * 16 + hh * 8);
#pragma unroll
                for (int rr = 0; rr < 16; ++rr) W[mt][rr] = WIf[(size_t)(rb + 4 * mt + (rr >> 2)) * 8 + (rr & 3) + 4 * hh] * WSCALE;
            }
            for (int kt = wid; kt < nkt; kt += 8) {
                bf16x8 Bf[4];
#pragma unroll
                for (int d0 = 0; d0 < 4; ++d0) Bf[d0] = Bn[d0];
                if (kt + 8 < nkt) {
#pragma unroll
                    for (int d0 = 0; d0 < 4; ++d0) Bn[d0] = *(const bf16x8*)(kbase + (size_t)(kt + 8) * 32 * 64 + d0 * 16);
                }
#pragma unroll
                for (int mt = 0; mt < 2; ++mt) {
                    f32x16 acc = (f32x16){};
#pragma unroll
                    for (int d0 = 0; d0 < 4; ++d0) acc = __builtin_amdgcn_mfma_f32_32x32x16_bf16(A[mt][d0], Bf[d0], acc, 0, 0, 0);
                    float sc[4];
#pragma unroll
                    for (int qq = 0; qq < 4; ++qq) {
                        float a = 0.f;
#pragma unroll
                        for (int e = 0; e < 4; ++e) a += fmaxf(acc[4 * qq + e], 0.f) * W[mt][4 * qq + e];
                        const auto rr2 = __builtin_amdgcn_permlane32_swap(__float_as_uint(a), __float_as_uint(a), false, false);
                        sc[qq] = __uint_as_float(rr2[0]) + __uint_as_float(rr2[1]);
                    }
                    const float v0 = hh ? sc[2] : sc[0], v1 = hh ? sc[3] : sc[1];
                    S[(4 * mt + 2 * hh) * 4096 + kt * 32 + r] = v0;
                    S[(4 * mt + 2 * hh + 1) * 4096 + kt * 32 + r] = v1;
                }
            }
        }
        __syncthreads();
        if (o < ngroups) {
            int lane_s = lane; asm volatile("" : "+v"(lane_s));
            const int qg = o >> 3, b = o & 7, t = qg * 8 + wid;
            unsigned* mrow = MASK + ((size_t)b * SEQ + t) * 128;
            const LAS float* Srow = S + wid * 4096;
            if (t < 1024) select_row<16>(Srow, t, lane_s, mrow);
            else if (t < 2048) select_row<32>(Srow, t, lane_s, mrow);
            else if (t < 3072) select_row<48>(Srow, t, lane_s, mrow);
            else select_row<64>(Srow, t, lane_s, mrow);
        }
        __syncthreads();
    }
}

template <class KR, class VR>
__device__ __forceinline__ void gather_attend(const LAS float* qf, const LAS int* keys, LAS float* pl, int cnt, const KR& kr, const VR& vr, bf16* orow  , int lane) {
    float s[4][4];
#pragma unroll
    for (int c = 0; c < 4; ++c) {
        const int slot = lane + 64 * c; const bool valid = slot < cnt;
        const int key = keys[valid ? slot : 0];
        const float* kp = kr(key);
        float a[4] = {0.f, 0.f, 0.f, 0.f};
#pragma unroll 4
        for (int d4 = 0; d4 < 16; ++d4) {
            const f32x4 kv = *(const f32x4*)(kp + 4 * d4);
#pragma unroll
            for (int g = 0; g < 4; ++g) { const f32x4 qv = *(const LAS f32x4*)(qf + g * 64 + 4 * d4); a[g] += (kv.x * qv.x + kv.y * qv.y) + (kv.z * qv.z + kv.w * qv.w); }
        }
#pragma unroll
        for (int g = 0; g < 4; ++g) s[c][g] = valid ? a[g] : -INFINITY;
    }
    float linv[4];
#pragma unroll
    for (int g = 0; g < 4; ++g) {
        const float mx = wave_max(fmaxf(fmaxf(s[0][g], s[1][g]), fmaxf(s[2][g], s[3][g])));
        float sum = 0.f;
#pragma unroll
        for (int c = 0; c < 4; ++c) { const float p = __builtin_amdgcn_exp2f(s[c][g] - mx); sum += p; pl[g * 256 + lane + 64 * c] = p; }
        linv[g] = 1.0f / wave_sum(sum);
    }
    LDS_WAIT(); asm volatile("" ::: "memory");
    float o[4] = {0.f, 0.f, 0.f, 0.f};
    for (int slot = 0; slot < cnt; ++slot) {
        const int key = keys[slot];
        const float vv = vr(key)[lane];
#pragma unroll
        for (int g = 0; g < 4; ++g) o[g] += pl[g * 256 + slot] * vv;
    }
#pragma unroll
    for (int g = 0; g < 4; ++g) orow[g * 64 + lane] = (bf16)f2bf(o[g] * linv[g]);
    LDS_WAIT(); asm volatile("" ::: "memory");
}
struct RowPlain { const float* base; __device__ __forceinline__ const float* operator()(int key) const { return base + (size_t)key * KVW; } };
struct RowPaged { const float* cache; const float* newrow; const int* pt; int j;
    __device__ __forceinline__ const float* operator()(int key) const {
        if (key >= PAST) return newrow;
        const int phys = pt[key >> 7];
        return cache + ((size_t)(phys * PAGE + (key & (PAGE - 1))) * NKV + j) * 64;
    } };

__device__ __forceinline__ void attn_gather_phase(const bf16* Qb, const float* outK, const float* outV, const unsigned short* LIST, bf16* Ob, LAS unsigned char* lds, int wg, int nwg, int tid) {
    asm volatile("" : "+v"(tid));
    const int lane = tid & 63, wid = tid >> 6;
    LAS float* qf = (LAS float*)(lds + wid * 8192); LAS int* keys = (LAS int*)(lds + wid * 8192 + 1024); LAS float* pl = (LAS float*)(lds + wid * 8192 + 2048);
    const int j = wid & 3;
    for (int pr = wg; pr < M / 2; pr += nwg) {
        const int row = pr * 2 + (wid >> 2); const int b = row >> 12, t = row & (SEQ - 1);
        const int cnt = (t + 1 < TOPK) ? t + 1 : TOPK;
#pragma unroll
        for (int g = 0; g < 4; ++g) qf[g * 64 + lane] = bf2f(Qb[(size_t)row * D + (4 * j + g) * 64 + lane]);
#pragma unroll
        for (int c = 0; c < 4; ++c) keys[lane + 64 * c] = (lane + 64 * c < cnt) ? (int)LIST[(size_t)row * 256 + lane + 64 * c] : 0;
        LDS_WAIT(); asm volatile("" ::: "memory");
        RowPlain kr{outK + (size_t)b * SEQ * KVW + j * 64}, vr{outV + (size_t)b * SEQ * KVW + j * 64};
        gather_attend(qf, keys, pl, cnt, kr, vr, Ob + (size_t)row * D + 4 * j * 64, lane);
    }
}

__device__ __forceinline__ void sample_scores_phase(const float* QIS, const float* WIS, const float* cki, const float* kinew, const int* ptab, float* SC, LAS unsigned char* lds, int wg, int nwg, int tid) {
    asm volatile("" : "+v"(tid));
    const int lane = tid & 63, wid = tid >> 6;
    LAS float* qs = (LAS float*)(lds + wid * 4096);
    for (int it = wg * NWAVES + wid; it < SBT * NPAGES; it += nwg * NWAVES) {
        const int b = it >> 7, pg = it & 127;
#pragma unroll
        for (int i = 0; i < 8; ++i) qs[i * 64 + lane] = QIS[b * 512 + i * 64 + lane];
        if (lane < 8) qs[512 + lane] = WIS[b * 8 + lane] * WSCALE;
        LDS_WAIT(); asm volatile("" ::: "memory");
        const int phys = ptab[b * NPAGES + pg];
#pragma unroll
        for (int kk = 0; kk < 2; ++kk) {
            const int key = lane + 64 * kk;
            const float* kp = cki + ((size_t)phys * PAGE + key) * 64;
            float dot[8] = {0.f, 0.f, 0.f, 0.f, 0.f, 0.f, 0.f, 0.f};
#pragma unroll 4
            for (int d4 = 0; d4 < 16; ++d4) {
                const f32x4 kv = *(const f32x4*)(kp + 4 * d4);
#pragma unroll
                for (int h = 0; h < 8; ++h) { const f32x4 qv = *(const LAS f32x4*)(qs + h * 64 + 4 * d4); dot[h] += (kv.x * qv.x + kv.y * qv.y) + (kv.z * qv.z + kv.w * qv.w); }
            }
            float sc = 0.f;
#pragma unroll
            for (int h = 0; h < 8; ++h) sc += fmaxf(dot[h], 0.f) * qs[512 + h];
            SC[(size_t)b * SCLD + pg * PAGE + key] = sc;
        }
        LDS_WAIT(); asm volatile("" ::: "memory");
    }
    if (wg == nwg - 1 && tid < SBT) {
        const int b = tid; float sc = 0.f;
        for (int h = 0; h < 8; ++h) { float dsum = 0.f; for (int d = 0; d < 64; ++d) dsum += QIS[b * 512 + h * 64 + d] * kinew[b * 64 + d]; sc += fmaxf(dsum, 0.f) * WIS[b * 8 + h] * WSCALE; }
        SC[(size_t)b * SCLD + PAST] = sc;
    }
}

#define SS_CNT(OUT, PRED) do { int c_ = 0; _Pragma("unroll") for (int i_ = 0; i_ < 33; ++i_) c_ += __builtin_popcountll(__ballot(v[i_] PRED)); \
        if (lane == 0) cw[par * 8 + wid] = c_; __syncthreads(); int t_ = 0; _Pragma("unroll") for (int w_ = 0; w_ < 8; ++w_) t_ += cw[par * 8 + w_]; par ^= 1; OUT = t_; } while (0)
__device__ __forceinline__ void sample_select_attend(int b, const float* SC, const float* QS, const float* ck, const float* cv, const float* knew, const float* vnew, const int* ptab,
                                                     bf16* OS, LAS unsigned char* lds, int tid) {
    asm volatile("" : "+v"(tid));
    const int lane = tid & 63, wid = tid >> 6;
    LAS int* cw = (LAS int*)(lds);
    LAS float* cwf = (LAS float*)(lds);
    LAS int* keysL = (LAS int*)(lds + 1024);
    float v[33];
#pragma unroll
    for (int i = 0; i < 33; ++i) { const int key = i * NTHREADS + tid; v[i] = (key < NKEYS_S) ? SC[(size_t)b * SCLD + key] + 0.0f : -INFINITY; }
    float mn = INFINITY, mx = -INFINITY;
#pragma unroll
    for (int i = 0; i < 33; ++i) { mx = fmaxf(mx, v[i]); mn = fminf(mn, (v[i] == -INFINITY) ? INFINITY : v[i]); }
    mn = wave_min(mn); mx = wave_max(mx);
    if (lane == 0) { cwf[16 + wid] = mn; cwf[24 + wid] = mx; }
    if (tid == 0) cw[32] = 0;
    __syncthreads();
    float lo = cwf[16], hi = cwf[24];
#pragma unroll
    for (int w = 1; w < 8; ++w) { lo = fminf(lo, cwf[16 + w]); hi = fmaxf(hi, cwf[24 + w]); }
    int par = 0; int c; float T;
    SS_CNT(c, >= hi);
    if (c >= TOPK) T = hi;
    else {
        T = lo;
        for (int itn = 0; itn < 400; ++itn) {
            const float mid = lo + (hi - lo) * 0.5f;
            if (!(mid > lo) || !(mid < hi)) { T = lo; break; }
            SS_CNT(c, >= mid);
            if (c == TOPK) { T = mid; break; }
            if (c > TOPK) lo = mid; else hi = mid;
            T = lo;
        }
    }
    int cgt; SS_CNT(cgt, > T);
    int need = TOPK - cgt;
    int ceq; SS_CNT(ceq, == T);
#pragma unroll
    for (int i = 0; i < 33; ++i) {
        const bool sel = v[i] > T; const unsigned long long m = __ballot(sel);
        if (m) { int bs = 0; if (lane == 0) bs = atomicAdd((int*)&cw[32], __builtin_popcountll(m)); bs = __builtin_amdgcn_readfirstlane(bs);
            if (sel) keysL[bs + mbcnt64(m)] = i * NTHREADS + tid; }
    }
    if (ceq <= need) {
#pragma unroll
        for (int i = 0; i < 33; ++i) {
            const bool sel = v[i] == T; const unsigned long long m = __ballot(sel);
            if (m) { int bs = 0; if (lane == 0) bs = atomicAdd((int*)&cw[32], __builtin_popcountll(m)); bs = __builtin_amdgcn_readfirstlane(bs);
                if (sel) keysL[bs + mbcnt64(m)] = i * NTHREADS + tid; }
        }
    } else {
        int taken = 0;
#pragma unroll
        for (int i = 0; i < 33; ++i) {
            const bool eq = v[i] == T; const unsigned long long m = __ballot(eq);
            if (lane == 0) cw[40 + wid] = __builtin_popcountll(m);
            __syncthreads();
            int before = taken, tot = 0;
#pragma unroll
            for (int w = 0; w < 8; ++w) { const int kw = cw[40 + w]; if (w < wid) before += kw; tot += kw; }
            const int rank = before + mbcnt64(m);
            if (eq && rank < need) keysL[cgt + rank] = i * NTHREADS + tid;
            taken += tot;
            __syncthreads();
        }
    }
    __syncthreads();
    LAS int* rowi = (LAS int*)(lds + 2048);
    if (tid < TOPK) { const int key = keysL[tid]; rowi[tid] = (key >= PAST) ? -1 : (ptab[b * NPAGES + (key >> 7)] * PAGE + (key & (PAGE - 1))); }
    __syncthreads();
    {
        const int j = wid & 3, half = wid >> 2;
        LAS float* qf = (LAS float*)(lds + 4096 + wid * 4096); LAS float* pl = qf + 256;
        LAS float* comb = (LAS float*)(lds + 36864) + wid * 264;
#pragma unroll
        for (int g = 0; g < 4; ++g) qf[g * 64 + lane] = QS[b * D + (4 * j + g) * 64 + lane];
        LDS_WAIT(); asm volatile("" ::: "memory");
        float s[2][4];
#pragma unroll
        for (int c2 = 0; c2 < 2; ++c2) {
            const int ri = rowi[half * 128 + lane + 64 * c2];
            const float* kp = (ri < 0) ? (knew + b * KVW + j * 64) : (ck + ((size_t)ri * NKV + j) * 64);
            float a[4] = {0.f, 0.f, 0.f, 0.f};
#pragma unroll
            for (int dq = 0; dq < 4; ++dq) {
#pragma unroll
                for (int d4 = 4 * dq; d4 < 4 * dq + 4; ++d4) {
                    const f32x4 kv = *(const f32x4*)(kp + 4 * d4);
#pragma unroll
                    for (int g = 0; g < 4; ++g) { const f32x4 qv = *(const LAS f32x4*)(qf + g * 64 + 4 * d4); a[g] += (kv.x * qv.x + kv.y * qv.y) + (kv.z * qv.z + kv.w * qv.w); }
                }
                asm volatile("" ::: "memory");
            }
#pragma unroll
            for (int g = 0; g < 4; ++g) s[c2][g] = a[g];
        }
        float mg[4], lg[4];
#pragma unroll
        for (int g = 0; g < 4; ++g) {
            mg[g] = wave_max(fmaxf(s[0][g], s[1][g]));
            const float p0 = __builtin_amdgcn_exp2f(s[0][g] - mg[g]), p1 = __builtin_amdgcn_exp2f(s[1][g] - mg[g]);
            pl[g * 128 + lane] = p0; pl[g * 128 + lane + 64] = p1;
            lg[g] = wave_sum(p0 + p1);
        }
        LDS_WAIT(); asm volatile("" ::: "memory");
        float o[4] = {0.f, 0.f, 0.f, 0.f};
        for (int s0 = 0; s0 < 128; s0 += 8) {
            float vv[8];
#pragma unroll
            for (int u = 0; u < 8; ++u) { const int ri = rowi[half * 128 + s0 + u]; const float* vp = (ri < 0) ? (vnew + b * KVW + j * 64) : (cv + ((size_t)ri * NKV + j) * 64); vv[u] = vp[lane]; }
#pragma unroll
            for (int u = 0; u < 8; ++u)
#pragma unroll
                for (int g = 0; g < 4; ++g) o[g] += pl[g * 128 + s0 + u] * vv[u];
        }
        if (lane < 4) { comb[lane] = (lane == 0) ? mg[0] : (lane == 1) ? mg[1] : (lane == 2) ? mg[2] : mg[3]; comb[4 + lane] = (lane == 0) ? lg[0] : (lane == 1) ? lg[1] : (lane == 2) ? lg[2] : lg[3]; }
#pragma unroll
        for (int g = 0; g < 4; ++g) comb[8 + g * 64 + lane] = o[g];
        __syncthreads();
        if (half == 0) {
            const LAS float* cb = comb + 4 * 264;
#pragma unroll
            for (int g = 0; g < 4; ++g) {
                const float ma = comb[g], mb = cb[g], mm = fmaxf(ma, mb); const float fa = __builtin_amdgcn_exp2f(ma - mm), fb = __builtin_amdgcn_exp2f(mb - mm);
                const float l = comb[4 + g] * fa + cb[4 + g] * fb; const float ov = comb[8 + g * 64 + lane] * fa + cb[8 + g * 64 + lane] * fb;
                OS[b * D + (4 * j + g) * 64 + lane] = (bf16)f2bf(ov / l);
            }
        }
    }
    __syncthreads();
}

namespace att {
using bf16=unsigned short;
using bf16x8=__attribute__((ext_vector_type(8)))short;
using s16x4=__attribute__((ext_vector_type(4)))short;
using f32x16=__attribute__((ext_vector_type(16)))float;
using u32x4=__attribute__((ext_vector_type(4)))unsigned;
constexpr int SEQ=4096,D=64,DM=1024,KVP=256;
constexpr int NW=8,QBLK=32,QB=QBLK*NW,KVBLK=64,QPU=64,NQB=SEQ/QPU;
__device__ __forceinline__ int crow(int r,int hi){return (r&3)+8*(r>>2)+4*hi;}
#define SBAR() __builtin_amdgcn_sched_barrier(0)
__device__ __forceinline__ void imask(f32x16&p0,f32x16&p1,unsigned wl,unsigned wh){
  #pragma unroll
  for(int r=0;r<16;++r){ const int c=(r&3)+8*(r>>2);
    const int m0=((int)(wl<<(31-c)))>>31, m1=((int)(wh<<(31-c)))>>31;
    p0[r]=__uint_as_float(((unsigned)m0&__float_as_uint(p0[r]))|(~(unsigned)m0&0xff800000u));
    p1[r]=__uint_as_float(((unsigned)m1&__float_as_uint(p1[r]))|(~(unsigned)m1&0xff800000u)); }
}

constexpr int NSLOT=3, SLOTB=8192;
constexpr int LDS_K=0, LDS_V=NSLOT*SLOTB, LDS_WS=2*NSLOT*SLOTB, LDS_OST=LDS_WS+NW*64*4, LDS_MR=LDS_OST+NW*4096, LDS_BYTES=LDS_MR+NW*NSLOT*256;
__device__ __forceinline__ void glds16(const void*gsrc,unsigned lds_dst){unsigned keep;
  asm volatile("s_mov_b32 %0, m0\n\ts_mov_b32 m0, %2\n\ts_nop 0\n\tglobal_load_lds_dwordx4 %1, off\n\ts_mov_b32 m0, %0":"=&s"(keep):"v"(gsrc),"s"(lds_dst):"memory");}
__device__ __forceinline__ void glds4(const void*gsrc,unsigned lds_dst){unsigned keep;
  asm volatile("s_mov_b32 %0, m0\n\ts_mov_b32 m0, %2\n\ts_nop 0\n\tglobal_load_lds_dword %1, off\n\ts_mov_b32 m0, %0":"=&s"(keep):"v"(gsrc),"s"(lds_dst):"memory");}
__device__ __forceinline__ float max3f(float a,float b,float c){float r;asm("v_max3_f32 %0, %1, %2, %3":"=v"(r):"v"(a),"v"(b),"v"(c));return r;}
__device__ __forceinline__ float max2f(float a,float b){float r;asm("v_max_f32_e32 %0, %1, %2":"=v"(r):"v"(a),"v"(b));return r;}
__device__ __forceinline__ float fadd_s(float a,float b){float r;asm("v_add_f32_e32 %0, %1, %2":"=v"(r):"v"(a),"v"(b));return r;}
__device__ __forceinline__ float fsub_s(float a,float b){float r;asm("v_sub_f32_e32 %0, %1, %2":"=v"(r):"v"(a),"v"(b));return r;}
typedef float f32x2_t __attribute__((ext_vector_type(2))); typedef __bf16 bf16x2_t __attribute__((ext_vector_type(2)));
__device__ __forceinline__ unsigned cvtpk_s(float lo,float hi){f32x2_t v={lo,hi};bf16x2_t b=__builtin_convertvector(v,bf16x2_t);return __builtin_bit_cast(unsigned,b);}
#define WAIT_BAR(N) asm volatile("s_waitcnt vmcnt(" #N ") lgkmcnt(0)\n\ts_barrier":::"memory")

__device__ __forceinline__ void qkt(f32x16&p0,f32x16&p1,const char*Kslot,const bf16x8*qr,const f32x16&negm,int r32,int hi){
  const char*kb=Kslot+hi*1024+r32*16;
  #pragma unroll
  for(int d0=0;d0<4;++d0){
    const bf16x8 b0=*reinterpret_cast<const bf16x8*>(kb+d0*2048);
    const bf16x8 b1=*reinterpret_cast<const bf16x8*>(kb+d0*2048+512);
    if(d0==0){p0=__builtin_amdgcn_mfma_f32_32x32x16_bf16(b0,qr[0],negm,0,0,0);p1=__builtin_amdgcn_mfma_f32_32x32x16_bf16(b1,qr[0],negm,0,0,0);}
    else{p0=__builtin_amdgcn_mfma_f32_32x32x16_bf16(b0,qr[d0],p0,0,0,0);p1=__builtin_amdgcn_mfma_f32_32x32x16_bf16(b1,qr[d0],p1,0,0,0);}}
}
typedef __attribute__((address_space(3))) const char* lds_cptr;
typedef short v4i16_t __attribute__((ext_vector_type(4)));
__device__ __forceinline__ void kload8(bf16x8*kf,lds_cptr kp){
  kf[0]=*(const __attribute__((address_space(3))) bf16x8*)(kp);      kf[1]=*(const __attribute__((address_space(3))) bf16x8*)(kp+512);
  kf[2]=*(const __attribute__((address_space(3))) bf16x8*)(kp+2048); kf[3]=*(const __attribute__((address_space(3))) bf16x8*)(kp+2560);
  kf[4]=*(const __attribute__((address_space(3))) bf16x8*)(kp+4096); kf[5]=*(const __attribute__((address_space(3))) bf16x8*)(kp+4608);
  kf[6]=*(const __attribute__((address_space(3))) bf16x8*)(kp+6144); kf[7]=*(const __attribute__((address_space(3))) bf16x8*)(kp+6656);
}
__device__ __forceinline__ void kload2(bf16x8*kf,lds_cptr kp,int j){ kf[2*j]=*(const __attribute__((address_space(3))) bf16x8*)(kp+j*2048); kf[2*j+1]=*(const __attribute__((address_space(3))) bf16x8*)(kp+j*2048+512); }
__device__ __forceinline__ s16x4 vtr(lds_cptr p){ return __builtin_bit_cast(s16x4,__builtin_amdgcn_ds_read_tr16_b64_v4i16((__attribute__((address_space(3))) v4i16_t*)p)); }
__device__ __forceinline__ float rowmax(const f32x16&p0,const f32x16&p1){
  float a=max3f(p0[0],p0[1],p1[0]),b=max3f(p0[2],p0[3],p1[1]);a=max3f(a,p1[2],p1[3]);
  #pragma unroll
  for(int r=4;r<16;r+=4){a=max3f(a,p0[r],p0[r+1]);b=max3f(b,p0[r+2],p0[r+3]);a=max3f(a,p1[r],p1[r+1]);b=max3f(b,p1[r+2],p1[r+3]);}
  const float m=max2f(a,b);
  auto rr=__builtin_amdgcn_permlane32_swap(__float_as_uint(m),__float_as_uint(m),false,false);
  return max2f(__uint_as_float(rr[0]),__uint_as_float(rr[1]));
}
__device__ __forceinline__ void pv(f32x16*o,int vb,bf16x8 pa0,bf16x8 pa1,bf16x8 pa2,bf16x8 pa3){
  #pragma unroll
  for(int d0=0;d0<2;++d0){s16x4 lo[4],hi[4];
    #pragma unroll
    for(int ks=0;ks<4;++ks){
      asm volatile("ds_read_b64_tr_b16 %0,%1 offset:%c2":"=&v"(lo[ks]):"v"(vb),"i"(d0*4096+ks*1024):"memory");
      asm volatile("ds_read_b64_tr_b16 %0,%1 offset:%c2":"=&v"(hi[ks]):"v"(vb),"i"(d0*4096+ks*1024+512):"memory");}
    asm volatile("s_waitcnt lgkmcnt(0)":::"memory");SBAR();
    #define PK(k) (bf16x8){lo[k][0],lo[k][1],lo[k][2],lo[k][3],hi[k][0],hi[k][1],hi[k][2],hi[k][3]}
    o[d0]=__builtin_amdgcn_mfma_f32_32x32x16_bf16(pa0,PK(0),o[d0],0,0,0);
    o[d0]=__builtin_amdgcn_mfma_f32_32x32x16_bf16(pa1,PK(1),o[d0],0,0,0);
    o[d0]=__builtin_amdgcn_mfma_f32_32x32x16_bf16(pa2,PK(2),o[d0],0,0,0);
    o[d0]=__builtin_amdgcn_mfma_f32_32x32x16_bf16(pa3,PK(3),o[d0],0,0,0);
    #undef PK
  }
}

__device__ __forceinline__ unsigned short f2bf_s(float x){ return (unsigned short)(cvtpk_s(x,x)&0xffffu); }
#ifndef ATTN_STORE16
#define ATTN_STORE16(p,v) (*(u32x4*)(p)=(v))
#endif
template<int THRL> __device__ __forceinline__ void attn_unit(int b,int j,int qb,const bf16*Q,const bf16*__restrict__ K,const bf16*__restrict__ V,const unsigned*__restrict__ MASKW,bf16*O,char*shm,int tid){
  const int lane=tid&63,r32=lane&31,hi=lane>>5; const int wid=__builtin_amdgcn_readfirstlane(tid>>6);
  const long rowbase=(long)b*SEQ; const int q0=qb*QPU;
  const bf16*Qw=Q+(rowbase+q0+wid*8)*DM+(4*j)*D;
  const bf16*Kh=K+rowbase*KVP+j*D,*Vh=V+rowbase*KVP+j*D;
  const unsigned lds0=(unsigned)(uintptr_t)shm;
  float*wsf=(float*)(shm+LDS_WS)+wid*64;
  const bf16*ksrc=Kh+(long)lane*KVP+wid*8;
  const bf16*vsrc=Vh+(long)(16*(wid&3)+(lane>>2))*KVP+(wid>>2)*32+(lane&3)*8;
  const unsigned*msrc=MASKW+(rowbase+q0+wid*8+((lane&15)>>1))*128+(lane&1);
  const unsigned kdst=lds0+LDS_K+wid*1024, vdst=lds0+LDS_V+wid*1024, mdst=lds0+LDS_MR+wid*(NSLOT*256);
  const int NT0=qb+1; int NT=(NT0+1)&~1; if(NT<4)NT=4;
  const int TL=NT-1;
  #define CL(t) (((t)<TL)?(t):TL)
  #define DMA_K(t,slot) glds16(ksrc+(long)CL(t)*KVBLK*KVP,(unsigned)__builtin_amdgcn_readfirstlane(kdst+(slot)))
  #define DMA_V(t,slot) glds16(vsrc+(long)CL(t)*KVBLK*KVP,(unsigned)__builtin_amdgcn_readfirstlane(vdst+(slot)))
  #define DMA_M(t,mslot) glds4(msrc+2*CL(t),(unsigned)__builtin_amdgcn_readfirstlane(mdst+(mslot)))
  const int vb0=(int)(lds0+LDS_V)+((lane>>4)&1)*32+(lane&3)*8+(4*hi+((lane&15)>>2))*64;
  const char*Kbase=shm+LDS_K; bf16x8 kf[8];
  const lds_cptr shm3=(lds_cptr)shm; const lds_cptr kp0=shm3+LDS_K+hi*1024+r32*16; const lds_cptr vp0=shm3+LDS_V+((lane>>4)&1)*32+(lane&3)*8+(4*hi+((lane&15)>>2))*64;
  const lds_cptr mp0=shm3+LDS_MR+wid*(NSLOT*256)+(r32>>2)*8;
  const unsigned sh4=4u*(unsigned)hi;
  DMA_K(0,0);DMA_M(0,0);DMA_V(0,0);DMA_K(1,SLOTB);DMA_M(1,256);
  bf16x8 qr[4];
  #pragma unroll
  for(int d0=0;d0<4;++d0)qr[d0]=*reinterpret_cast<const bf16x8*>(&Qw[(long)(r32>>2)*DM+(r32&3)*D+d0*16+hi*8]);
  float mhat=0.f,l_reg=0.f; float z_=0.f; asm volatile("":"+v"(z_));
  f32x16 o[2],negm;
  #pragma unroll
  for(int r=0;r<16;++r){o[0][r]=z_;o[1][r]=z_;negm[r]=z_;}
  typedef unsigned u32x2_t __attribute__((ext_vector_type(2)));
  #define CMASK(P0,P1,ms) do{ const u32x2_t mw_=*(const __attribute__((address_space(3))) u32x2_t*)(mp0+(ms)); imask(P0,P1,mw_[0]>>sh4,mw_[1]>>sh4); }while(0)
  bool resc=false;
  #define START(P0,P1) do{ const float rm=rowmax(P0,P1); resc=false; \
    { const float dl=__builtin_fmaxf(rm,-1024.f); mhat=fadd_s(mhat,dl); \
      _Pragma("unroll") for(int r=0;r<16;++r){P0[r]=fsub_s(P0[r],dl);P1[r]=fsub_s(P1[r],dl);} \
      _Pragma("unroll") for(int r=0;r<16;++r)negm[r]=-mhat; asm volatile("":"+v"(negm)); } \
    _Pragma("unroll") for(int r=0;r<16;++r)P0[r]=__builtin_amdgcn_exp2f(P0[r]); }while(0)
  #define RESC() do{ if(resc){ asm volatile("s_waitcnt lgkmcnt(0)":::"memory"); \
      _Pragma("unroll") for(int d_=0;d_<2;++d_) _Pragma("unroll") for(int r=0;r<16;++r)o[d_][r]*=wsf[crow(r,hi)]; } }while(0)
  f32x16 pA0,pA1,pB0,pB1;
  int sl_prev=0,sl_cur=0,sl_next=SLOTB;
  int ms_cur=0,ms_next=256,ms_nn=512;
  #define ROT() do{sl_prev=sl_cur;sl_cur=sl_next;sl_next=(sl_next==(NSLOT-1)*SLOTB)?0:sl_next+SLOTB; const int m_=ms_cur; ms_cur=ms_next; ms_next=ms_nn; ms_nn=m_;}while(0)
  DMA_K(2,2*SLOTB);
  WAIT_BAR(4);
  qkt(pA0,pA1,Kbase,qr,negm,r32,hi);asm volatile("s_nop 15\n\ts_nop 7":"+v"(pA0),"+v"(pA1));CMASK(pA0,pA1,ms_cur);
  START(pA0,pA1);
  _Pragma("unroll") for(int r=0;r<16;++r)pA1[r]=__builtin_amdgcn_exp2f(pA1[r]);
  WAIT_BAR(0);
  DMA_K(3,0);DMA_V(1,SLOTB);DMA_M(2,512);
  ROT();
  kload8(kf,kp0+sl_cur);
  WAIT_BAR(3);
  s16x4 vlo[8],vhi[8]; u32x4 pw0,pw1,pw2,pw3;
  #define PKW(P,B) cvtpk_s(P[B],P[B+1])
  #define PAF(k) __builtin_bit_cast(bf16x8,pw##k)
  #define VFR(i) (bf16x8){vlo[i][0],vlo[i][1],vlo[i][2],vlo[i][3],vhi[i][0],vhi[i][1],vhi[i][2],vhi[i][3]}
  #define PIN(x) asm volatile("":"+v"(x))
  #define MX3(a,b,c) __builtin_fmaxf(__builtin_fmaxf((a),(b)),(c))
  #define GAPA(MF,A0,A1,A2,A3,W0,W1,PW) do{ MF; sacc+=A0; sacc+=A1; sacc+=A2; sacc+=A3; PIN(sacc); W0; W1; PIN(PW); SBAR(); }while(0)
  #define EX(v) __builtin_amdgcn_exp2f(v)
  #define GAPB(MF,X,B) do{ MF; X[B]=EX(X[B]); X[B+1]=EX(X[B+1]); X[B+2]=EX(X[B+2]); X[B+3]=EX(X[B+3]); PIN(X); SBAR(); }while(0)
  #define VRD(i) do{ vlo[i]=vtr(vp_+(((i)>>2)*4096+((i)&3)*1024)); vhi[i]=vtr(vp_+(((i)>>2)*4096+((i)&3)*1024+512)); }while(0)
  #define KRD(jj) do{ kload2(kf,kp0+sl_next,jj); SBAR(); }while(0)
  #define STEP(C0,C1,P0,P1,t) do{ SBAR(); \
    const lds_cptr vp_=vp0+sl_prev; \
    VRD(0); SBAR(); float sacc=(P0[0]+P0[1]); \
    GAPA(C0=__builtin_amdgcn_mfma_f32_32x32x16_bf16(kf[0],qr[0],negm,0,0,0), P0[2],P0[3],P0[4],P0[5],     pw0[0]=PKW(P0,0), pw0[1]=PKW(P0,2), pw0); \
    VRD(4); SBAR(); GAPA(C1=__builtin_amdgcn_mfma_f32_32x32x16_bf16(kf[1],qr[0],negm,0,0,0), P0[6],P0[7],P0[8],P0[9],     pw0[2]=PKW(P0,4), pw0[3]=PKW(P0,6), pw0); \
    VRD(1); SBAR(); GAPA(C0=__builtin_amdgcn_mfma_f32_32x32x16_bf16(kf[2],qr[1],C0,0,0,0),   P0[10],P0[11],P0[12],P0[13], pw1[0]=PKW(P0,8), pw1[1]=PKW(P0,10), pw1); \
    VRD(5); SBAR(); GAPA(C1=__builtin_amdgcn_mfma_f32_32x32x16_bf16(kf[3],qr[1],C1,0,0,0),   P0[14],P0[15],P1[0],P1[1],   pw1[2]=PKW(P0,12),pw1[3]=PKW(P0,14), pw1); \
    VRD(2); SBAR(); GAPA(C0=__builtin_amdgcn_mfma_f32_32x32x16_bf16(kf[4],qr[2],C0,0,0,0),   P1[2],P1[3],P1[4],P1[5],     pw2[0]=PKW(P1,0), pw2[1]=PKW(P1,2), pw2); \
    VRD(6); SBAR(); GAPA(C1=__builtin_amdgcn_mfma_f32_32x32x16_bf16(kf[5],qr[2],C1,0,0,0),   P1[6],P1[7],P1[8],P1[9],     pw2[2]=PKW(P1,4), pw2[3]=PKW(P1,6), pw2); \
    VRD(3); SBAR(); GAPA(C0=__builtin_amdgcn_mfma_f32_32x32x16_bf16(kf[6],qr[3],C0,0,0,0),   P1[10],P1[11],P1[12],P1[13], pw3[0]=PKW(P1,8), pw3[1]=PKW(P1,10), pw3); \
    VRD(7); SBAR(); GAPA(C1=__builtin_amdgcn_mfma_f32_32x32x16_bf16(kf[7],qr[3],C1,0,0,0),   P1[14],P1[15],0.f,0.f,       pw3[2]=PKW(P1,12),pw3[3]=PKW(P1,14), pw3); \
    l_reg+=sacc; \
    DMA_K((t)+3,sl_cur); DMA_V((t)+1,sl_next); DMA_M((t)+2,ms_nn); \
    CMASK(C0,C1,ms_cur); \
    { float a=MX3(C0[0],C0[1],C1[0]),b_=MX3(C0[2],C0[3],C1[1]); a=MX3(a,C1[2],C1[3]); \
      _Pragma("unroll") for(int r=4;r<16;r+=4){a=MX3(a,C0[r],C0[r+1]);b_=MX3(b_,C0[r+2],C0[r+3]);a=MX3(a,C1[r],C1[r+1]);b_=MX3(b_,C1[r+2],C1[r+3]);} \
      float rm=__builtin_fmaxf(a,b_); { auto rr=__builtin_amdgcn_permlane32_swap(__float_as_uint(rm),__float_as_uint(rm),false,false); rm=__builtin_fmaxf(__uint_as_float(rr[0]),__uint_as_float(rr[1])); } \
      resc=false; \
      if(__builtin_expect(__any(rm>(float)THRL),0)){ const float dl=__builtin_fmaxf(rm,0.f); mhat+=dl; \
        _Pragma("unroll") for(int r=0;r<16;++r){C0[r]-=dl;C1[r]-=dl;} \
        _Pragma("unroll") for(int r=0;r<16;++r)negm[r]=-mhat; asm volatile("":"+v"(negm)); \
        const float f=__builtin_amdgcn_exp2f(-dl); l_reg*=f; if(hi==0)wsf[r32]=f; resc=true; } } \
    SBAR(); \
    GAPB(o[0]=__builtin_amdgcn_mfma_f32_32x32x16_bf16(PAF(0),VFR(0),o[0],0,0,0), C0,0); \
    GAPB(o[1]=__builtin_amdgcn_mfma_f32_32x32x16_bf16(PAF(0),VFR(4),o[1],0,0,0), C0,4); \
    KRD(0); GAPB(o[0]=__builtin_amdgcn_mfma_f32_32x32x16_bf16(PAF(1),VFR(1),o[0],0,0,0), C0,8); \
    KRD(1); GAPB(o[1]=__builtin_amdgcn_mfma_f32_32x32x16_bf16(PAF(1),VFR(5),o[1],0,0,0), C0,12); \
    KRD(2); GAPB(o[0]=__builtin_amdgcn_mfma_f32_32x32x16_bf16(PAF(2),VFR(2),o[0],0,0,0), C1,0); \
    KRD(3); GAPB(o[1]=__builtin_amdgcn_mfma_f32_32x32x16_bf16(PAF(2),VFR(6),o[1],0,0,0), C1,4); \
    GAPB(o[0]=__builtin_amdgcn_mfma_f32_32x32x16_bf16(PAF(3),VFR(3),o[0],0,0,0), C1,8); \
    GAPB(o[1]=__builtin_amdgcn_mfma_f32_32x32x16_bf16(PAF(3),VFR(7),o[1],0,0,0), C1,12); \
    }while(0)
  int t=1;
  for(;t+1<NT;t+=2){
    STEP(pB0,pB1,pA0,pA1,t);     WAIT_BAR(3); RESC(); ROT();
    STEP(pA0,pA1,pB0,pB1,t+1);   WAIT_BAR(3); RESC(); ROT();
  }
  STEP(pB0,pB1,pA0,pA1,NT-1); WAIT_BAR(0); RESC();
  { float sacc=pB0[0]+pB0[1]; _Pragma("unroll") for(int r=2;r<16;++r)sacc+=pB0[r]; _Pragma("unroll") for(int r=0;r<16;++r)sacc+=pB1[r]; l_reg+=sacc;
    pw0=(u32x4){PKW(pB0,0),PKW(pB0,2),PKW(pB0,4),PKW(pB0,6)};pw1=(u32x4){PKW(pB0,8),PKW(pB0,10),PKW(pB0,12),PKW(pB0,14)};pw2=(u32x4){PKW(pB1,0),PKW(pB1,2),PKW(pB1,4),PKW(pB1,6)};pw3=(u32x4){PKW(pB1,8),PKW(pB1,10),PKW(pB1,12),PKW(pB1,14)};
    SBAR(); pv(o,vb0+sl_cur,PAF(0),PAF(1),PAF(2),PAF(3)); }
  #undef PKW
  #undef PAF
  #undef VFR
  #undef PIN
  #undef MX3
  #undef GAPA
  #undef GAPB
  #undef EX
  #undef VRD
  #undef KRD
  #undef STEP
  {auto rr=__builtin_amdgcn_permlane32_swap(__float_as_uint(l_reg),__float_as_uint(l_reg),false,false);l_reg=__uint_as_float(rr[0])+__uint_as_float(rr[1]);}
  if(hi==0)wsf[32+r32]=l_reg;asm volatile("s_waitcnt lgkmcnt(0)":::"memory");
  float rli[16];
  #pragma unroll
  for(int r=0;r<16;++r)rli[r]=__builtin_amdgcn_rcpf(wsf[32+crow(r,hi)]);
  bf16*Ow=O+(rowbase+q0+wid*8)*DM+(4*j)*D;
  { bf16*stg=(bf16*)(shm+LDS_OST)+wid*2048;
    #pragma unroll
    for(int r=0;r<16;++r){const int orow=crow(r,hi);
      #pragma unroll
      for(int d0=0;d0<2;++d0)stg[orow*64+d0*32+r32]=(bf16)f2bf_s(o[d0][r]*rli[r]);}
    asm volatile("s_waitcnt lgkmcnt(0)":::"memory");
    #pragma unroll
    for(int i=0;i<4;++i){const int row=i*8+(lane>>3),ch=lane&7; const u32x4 v=*(const u32x4*)(stg+row*64+ch*8); ATTN_STORE16(Ow+(long)(row>>2)*DM+(row&3)*D+ch*8,v);} }
  asm volatile("s_waitcnt vmcnt(0) lgkmcnt(0)\n\ts_barrier":::"memory");
  #undef DMA_K
  #undef DMA_V
  #undef DMA_M
  #undef CL
  #undef CMASK
  #undef START
  #undef RESC
  #undef ROT
}
__device__ __forceinline__ void attn_phase_masked(char*lds,const bf16*Q,const bf16*K,const bf16*V,const unsigned*MASKW,bf16*O,int grid,int block,int tid){
  if(grid==256){
    const int vcu=(block&7)*32+(block>>3); const int bh=vcu>>3, s=vcu&7;
    for(int i=0;i<8;++i){ const int p=s+8*(i>>1); const int qb=(i&1)?(63-p):p; attn_unit<8>(bh>>2,bh&3,qb,Q,K,V,MASKW,O,lds,tid); }
  } else {
    for(int u=block;u<2048;u+=grid){ const int bh=u>>6, x=u&63; const int qb=(x&1)?(63-(x>>1)):(x>>1); attn_unit<8>(bh>>2,bh&3,qb,Q,K,V,MASKW,O,lds,tid); }
  }
}
#undef SBAR
#undef WAIT_BAR
}

#define RELAUNDER() (({ asm volatile("" : "+s"(pa)); G = G0; wg = wg0; asm volatile("" : "+s"(G), "+s"(wg)); gw = wg * NWAVES + wave; NGW = G * NWAVES; asm volatile("v_mbcnt_lo_u32_b32 %0, -1, 0\n\tv_mbcnt_hi_u32_b32 %0, -1, %0" : "=v"(lane)); tid = wave * 64 + lane; }), true)
struct Args { const void* in[17]; float* out; unsigned char* ws; int ph_lo, ph_hi; };
constexpr int N_PHASES = 21;

__global__ void __launch_bounds__(NTHREADS, 2) fwd(Args args) {
    extern __shared__ __attribute__((aligned(16))) unsigned char lds_raw[];
    LAS unsigned char* lds = (LAS unsigned char*)lds_raw;
#define MISC ((volatile LAS unsigned*)(lds + MISC_OFF))
    int wave = __builtin_amdgcn_readfirstlane((int)threadIdx.x >> 6); asm volatile("" : "+s"(wave));
    int lane, tid; asm volatile("v_mbcnt_lo_u32_b32 %0, -1, 0\n\tv_mbcnt_hi_u32_b32 %0, -1, %0" : "=v"(lane)); tid = wave * 64 + lane;
    const int G0 = gridDim.x, wg0 = blockIdx.x;
    int G = G0, wg = wg0, gw = wg * NWAVES + wave, NGW = G * NWAVES;
    typedef __attribute__((address_space(4))) const Args* kargs_t;
    kargs_t pa = (kargs_t)__builtin_amdgcn_kernarg_segment_ptr();
#define ws (pa->ws)
#define out (pa->out)
#define x_prompt ((const float*)pa->in[0])
#define x_sample ((const float*)pa->in[1])
#define cache_k ((const float*)pa->in[2])
#define cache_v ((const float*)pa->in[3])
#define cache_kidx ((const float*)pa->in[4])
#define state_pool ((const float*)pa->in[5])
#define page_table ((const int*)pa->in[6])
#define ln_g ((const float*)pa->in[7])
#define ln_b ((const float*)pa->in[8])
#define ffn1_wi ((const float*)pa->in[9])
#define ffn1_wo ((const float*)pa->in[10])
#define ffn2_wi ((const float*)pa->in[11])
#define ffn2_wo ((const float*)pa->in[12])
#define attn_w_in ((const float*)pa->in[13])
#define attn_w_o ((const float*)pa->in[14])
#define pool_w ((const float*)pa->in[15])
#define pool_scale ((const float*)pa->in[16])
#define W_WI ((bf16*)(ws + WS_WI))
#define W_WO ((bf16*)(ws + WS_WO))
#define W_IN ((bf16*)(ws + WS_WIN))
#define W_OA ((bf16*)(ws + WS_WOA))
#define W_POOL ((bf16*)(ws + WS_WPOOL))
#define ROPE ((f32x2*)(ws + WS_ROPE))
#define XB ((bf16*)(ws + WS_XB))
#define XA ((float*)(ws + WS_XA))
#define PRE ((float*)(ws + WS_PRE))
#define GB ((bf16*)(ws + WS_G))
#define QB ((bf16*)(ws + WS_QB))
#define OB ((bf16*)(ws + WS_OB))
#define KB ((bf16*)(ws + WS_KB))
#define VB ((bf16*)(ws + WS_VB))
#define QIB ((bf16*)(ws + WS_QIB))
#define KIB ((bf16*)(ws + WS_KIB))
#define WIF ((float*)(ws + WS_WIF))
#define MASK ((unsigned*)(ws + WS_MASK))
#define LIST ((unsigned short*)(ws + WS_LIST))
#define DB ((bf16*)(ws + WS_DB))
#define XS ((float*)(ws + WS_S + S_XS))
#define PRES ((float*)(ws + WS_S + S_PRES))
#define XSB ((bf16*)(ws + WS_S + S_XSB))
#define GS ((bf16*)(ws + WS_S + S_GS))
#define QS ((float*)(ws + WS_S + S_QS))
#define QIS ((float*)(ws + WS_S + S_QIS))
#define WIS ((float*)(ws + WS_S + S_WIS))
#define OS ((bf16*)(ws + WS_S + S_OS))
#define DS ((bf16*)(ws + WS_S + S_DS))
#define SC ((float*)(ws + WS_S + S_SC))
    for (int u = tid; u < 64; u += NTHREADS) MISC[u] = 0u;
    __syncthreads();
    const int lo = pa->ph_lo, hi = pa->ph_hi;
    if (hi - lo > 1) (void)xcd_barrier_post((unsigned*)(ws + WS_CTL) + CW_BAR, MISC + 8, tid);
    int ph = 0;
#define LAUNDER_V(x) asm volatile("" : "+v"(x))
#define LAUNDER_S(x) asm volatile("" : "+s"(x))
#ifndef SITEMASK
#define SITEMASK 0xFFFFFFFFu
#endif
#ifndef DUPMASK
#define DUPMASK 0u
#endif
#define PH_ON(k) (RELAUNDER() && ((SITEMASK >> (k)) & 1u) && ph >= lo && ph < hi)
#define REP(k) for (int rep_ = 0; rep_ < 1 + (int)((DUPMASK >> (k)) & 1u); ++rep_)
#define PH_END do { if (ph >= lo && ph + 1 < hi) { RELAUNDER(); XcdBarrier bar_; bar_.bar = (unsigned*)(ws + WS_CTL) + CW_BAR; bar_.x = xb_xcc_id(); bar_.st = (volatile LAS unsigned*)(lds + MISC_OFF) + 8; xcd_barrier(bar_, tid); } ++ph; } while (0)
    LAS float* redS = (LAS float*)(lds + RING_OFF);

    if (PH_ON(0)) REP(0) {
        LAS float* scr = (LAS float*)(lds + RING_OFF + wave * 16384);
        constexpr int I_WI = 16 * 176, I_WO = 44 * 32, I_IN = 16 * 72, I_OA = 16 * 32, I_PL = 4 * 8;
        constexpr int NIT = 4 * I_WI + 4 * I_WO + I_IN + I_OA + 4 * I_PL;
        for (int it = gw; it < NIT; it += NGW) {
            int r = it;
            if (r < 4 * I_WI) { const int mi = r / I_WI; r -= mi * I_WI; const int kb = r / 176, nb = r % 176; const int n0 = nb * 32, pn = n0 >> 8, i = n0 & 255;
                const int c0 = (i < 128) ? (128 * pn + i) : (FF + 128 * pn + (i - 128));
                tr_item(((mi & 1) ? ffn2_wi : ffn1_wi) + (size_t)(mi >> 1) * D * NWI, NWI, kb * 64, c0, 32, (bf16*)((unsigned char*)W_WI + (size_t)mi * WI_STRIDE), D, n0, scr, lane); continue; }
            r -= 4 * I_WI;
            if (r < 4 * I_WO) { const int mi = r / I_WO; r -= mi * I_WO; const int kb = r / 32, nb = r % 32;
                tr_item(((mi & 1) ? ffn2_wo : ffn1_wo) + (size_t)(mi >> 1) * FF * D, D, kb * 64, nb * 32, 32, (bf16*)((unsigned char*)W_WO + (size_t)mi * WO_STRIDE), FF, nb * 32, scr, lane); continue; }
            r -= 4 * I_WO;
            if (r < I_IN) { const int kb = r / 72, nb = r % 72; const int ncv = NPROJ - nb * 32;
                tr_item(attn_w_in, NPROJ, kb * 64, (ncv > 0) ? nb * 32 : 0, ncv, W_IN, D, nb * 32, scr, lane); continue; }
            r -= I_IN;
            if (r < I_OA) { const int kb = r / 32, nb = r % 32; tr_item(attn_w_o, D, kb * 64, nb * 32, 32, W_OA, D, nb * 32, scr, lane); continue; }
            r -= I_OA;
            { const int g = r / I_PL; r -= g * I_PL; const int kb = r / 8, nb = r % 8; tr_item(pool_w + (size_t)g * 65536, 256, kb * 64, nb * 32, 32, W_POOL, 256, g * 256 + nb * 32, scr, lane); }
        }
        for (size_t i = (size_t)wg * NTHREADS + tid; i < (size_t)(M + SBT) * D / 8; i += (size_t)G * NTHREADS) {
            const float* src = (i < (size_t)M * D / 8) ? x_prompt + i * 8 : x_sample + (i - (size_t)M * D / 8) * 8;
            bf16* dst = (i < (size_t)M * D / 8) ? XB + i * 8 : XSB + (i - (size_t)M * D / 8) * 8;
            const f32x4 a = *(const f32x4*)src, c = *(const f32x4*)(src + 4);
            v4u o; o.x = pk2(a.x, a.y); o.y = pk2(a.z, a.w); o.z = pk2(c.x, c.y); o.w = pk2(c.z, c.w); *(v4u*)dst = o;
        }
        for (int i = wg * NTHREADS + tid; i < 4097 * 8; i += G * NTHREADS) {
            const int p = i >> 3, f = i & 7; const float pos = (p < 4096) ? (float)p : (float)PAST;
            const float freq = (float)pow(500000.0, -(double)f / 8.0);
            const float ang = pos * freq;
            f32x2 cs; cs.x = (float)cos((double)ang); cs.y = (float)sin((double)ang); ROPE[i] = cs;
        }
    }
    PH_END;

    for (int f = 0; f < 4; ++f) {
        const int layer = f >> 1, which = f & 1;
        const bf16* Wi = (const bf16*)((const unsigned char*)W_WI + (size_t)(layer * 2 + which) * WI_STRIDE);
        const bf16* Wo = (const bf16*)((const unsigned char*)W_WO + (size_t)(layer * 2 + which) * WO_STRIDE);
        const float* Xres = (f == 0) ? x_prompt : XA;
        const float* XSres = (f == 0) ? x_sample : XS;
        const int lni = which ? 2 : 0;
        if (PH_ON(1)) REP(1) {
            { SDescG1 dsc{GS}; sgemm32<2>(XSB, D, Wi, D, D, 88, wg, G, redS, tid, dsc); }
            pg8::Gemm g{XB, Wi, D, D, D, 0}; pg8::StaticOrder S; S.init(M, NWI, G, wg);
            pg8::EpiSwiglu E{GB};
            pg8::gemm_phase<pg8::EpiSwiglu, pg8::StaticOrder, true, true>(lds + RING_OFF, g, S, E, tid);
        }
        PH_END;
        if (PH_ON(2)) REP(2) {
            { SDescResid dsc{XSres, PRES, 0.5f, nullptr, 0}; sgemm32<1>(GS, FF, Wo, FF, FF, 32, wg, G, redS, tid, dsc); }
            pg8::Gemm g{GB, Wo, FF, FF, FF, 0}; pg8::StaticOrder S; S.init(M, D, G, wg);
            pg8::EpiResid<false> E{Xres, PRE, 0.5f, nullptr};
            pg8::gemm_phase<pg8::EpiResid<false>, pg8::StaticOrder, true, true>(lds + RING_OFF, g, S, E, tid);
        }
        PH_END;
        if (PH_ON(3)) REP(3) {
            ln_phase<4>(ws, out, ln_g + (layer * 3 + lni) * D, ln_b + (layer * 3 + lni) * D, f == 3, f == 2, gw, NGW, lane);
        }
        PH_END;
        if (f == 0) {
            if (PH_ON(4)) REP(4) {
                { SDescProj dsc{QS, QIS, WIS, out + O_KS, out + O_VS, out + O_KIS, ROPE + 4096 * 8}; sgemm32<1>(XSB, D, W_IN, D, D, 67, wg, G, redS, tid, dsc); }
                pg8::Gemm g{XB, W_IN, D, D, D, 0}; pg8::StaticOrder S; S.init(M, NPROJP, G, wg);
                pg8::EpiProj E{ws, out};
                pg8::gemm_phase<pg8::EpiProj, pg8::StaticOrder, true, true>(lds + RING_OFF, g, S, E, tid);
            }
            PH_END;
            if (PH_ON(5)) REP(5) {
                sample_scores_phase(QIS, WIS, cache_kidx, out + O_KIS, page_table, SC, lds + RING_OFF, wg, G, tid);
                __syncthreads();
                index_select_phase(QIB, KIB, WIF, MASK, (LAS float*)(lds + RING_OFF), wg, G, tid);
            }
            PH_END;
            if (PH_ON(6)) REP(6) {
                if (wg < SBT) sample_select_attend(wg, SC, QS, cache_k, cache_v, out + O_KS, out + O_VS, page_table, OS, lds + RING_OFF, tid);
                __syncthreads();
                att::attn_phase_masked((char*)lds_raw + RING_OFF, QB, KB, VB, MASK, OB, G, wg, tid);
            }
            PH_END;
            if (PH_ON(7)) REP(7) {
                { SDescResid dsc{XS, PRES, 1.0f, nullptr, 0}; sgemm32<1>(OS, D, W_OA, D, D, 32, wg, G, redS, tid, dsc); }
                pg8::Gemm g{OB, W_OA, D, D, D, 0}; pg8::StaticOrder S; S.init(M, D, G, wg);
                pg8::EpiResid<false> E{XA, PRE, 1.0f, nullptr};
                pg8::gemm_phase<pg8::EpiResid<false>, pg8::StaticOrder, true, true>(lds + RING_OFF, g, S, E, tid);
            }
            PH_END;
            if (PH_ON(8)) REP(8) {
                ln_phase<4>(ws, out, ln_g + 1 * D, ln_b + 1 * D, false, false, gw, NGW, lane);
            }
            PH_END;
        }
        if (f == 2) {
            if (PH_ON(9)) REP(9) {
                for (int it = wg * NTHREADS + tid; it < (M / 64) * 256; it += G * NTHREADS) {
                    const int seg = it >> 8, c4 = it & 255, grp = c4 >> 6;
                    if (grp == 0) pool_seg<2>(XA, DB, seg * 64, 4 * c4);
                    else if (grp == 1) pool_seg<4>(XA, DB, seg * 64, 4 * c4);
                    else if (grp == 2) pool_seg<8>(XA, DB, seg * 64, 4 * c4);
                    else pool_seg<16>(XA, DB, seg * 64, 4 * c4);
                }
                for (int it = wg * NTHREADS + tid; it < SBT * 256; it += G * NTHREADS) {
                    const int b = it >> 8, c4 = it & 255, col = 4 * c4; const int w = 2 << (c4 >> 6);
                    const f32x4 xt = *(const f32x4*)(XS + b * D + col); f32x4 sum = xt;
                    for (int r = 1; r < w; ++r) sum = sum + *(const f32x4*)(state_pool + ((size_t)b * 15 + (15 - r)) * D + col);
                    const f32x4 d = sum * (1.0f / (float)w) - xt;
                    v2u o; o.x = pk2(d.x, d.y); o.y = pk2(d.z, d.w); *(v2u*)(DS + b * D + col) = o;
                }
                for (int it = wg * NTHREADS + tid; it < SBT * 14 * 256; it += G * NTHREADS) {
                    const int b = it / (14 * 256), rem = it % (14 * 256), r = rem >> 8, c4 = rem & 255;
                    *(f32x4*)(out + O_PS + ((size_t)b * 15 + r) * D + 4 * c4) = *(const f32x4*)(state_pool + ((size_t)b * 15 + r + 1) * D + 4 * c4);
                }
            }
            PH_END;
            if (PH_ON(10)) REP(10) {
                { SDescResid dsc{XS, PRES, 1.0f, pool_scale, 1}; sgemm32<1>(DS, D, W_POOL, 256, 256, 32, wg, G, redS, tid, dsc); }
                pg8::Gemm g{DB, W_POOL, D, 256, 256, 512}; pg8::StaticOrder S; S.init(M, D, G, wg);
                pg8::EpiResid<true> E{XA, PRE, 1.0f, pool_scale};
                pg8::gemm_phase<pg8::EpiResid<true>, pg8::StaticOrder, true, true>(lds + RING_OFF, g, S, E, tid);
            }
            PH_END;
            if (PH_ON(11)) REP(11) {
                ln_phase<4>(ws, out, ln_g + 4 * D, ln_b + 4 * D, false, false, gw, NGW, lane);
            }
            PH_END;
        }
    }
#undef PH_ON
#undef PH_END
#undef ws
#undef out
#undef MISC
}

extern "C" void kernel_launch(void* const* d_in, const int* in_sizes, int n_in, void* d_out, int out_size, void* d_ws, size_t ws_size, hipStream_t stream) {
    static int grid = 0;
    if (grid == 0) {
        if (n_in != 17 || out_size != (int)O_END || ws_size < WS_END) { fprintf(stderr, "kernel_launch: unexpected sizes n_in %d out %d ws %zu\n", n_in, out_size, ws_size); grid = -1; return; }
        int dev = 0, cus = 0, per_cu = 0;
        if (hipGetDevice(&dev) != hipSuccess || hipDeviceGetAttribute(&cus, hipDeviceAttributeMultiprocessorCount, dev) != hipSuccess) { grid = -1; return; }
        if (hipFuncSetAttribute((const void*)fwd, hipFuncAttributeMaxDynamicSharedMemorySize, LDS_BYTES) != hipSuccess) { fprintf(stderr, "kernel_launch: hipFuncSetAttribute failed\n"); grid = -1; return; }
        if (hipOccupancyMaxActiveBlocksPerMultiprocessor(&per_cu, (const void*)fwd, NTHREADS, LDS_BYTES) != hipSuccess || per_cu < 1)
            fprintf(stderr, "kernel_launch: note: occupancy query reports %d workgroups per CU\n", per_cu);
        (void)hipGetLastError();
        grid = cus;
    }
    if (grid < 0) return;
    (void)hipMemsetAsync((char*)d_ws + WS_CTL, 0, CTL_ZERO_BYTES, stream);
    Args a{};
    for (int i = 0; i < 17; ++i) a.in[i] = d_in[i];
    a.out = (float*)d_out; a.ws = (unsigned char*)d_ws;
#ifndef MK_ONE_LAUNCH
#define MK_ONE_LAUNCH 1
#endif
    if (MK_ONE_LAUNCH) {
        a.ph_lo = 0; a.ph_hi = N_PHASES;
        hipLaunchKernelGGL(fwd, dim3(grid), dim3(NTHREADS), LDS_BYTES, stream, a);
    } else {
        for (int p = 0; p < N_PHASES; ++p) { a.ph_lo = p; a.ph_hi = p + 1; hipLaunchKernelGGL(fwd, dim3(grid), dim3(NTHREADS), LDS_BYTES, stream, a); }
    }
}
```

```cpp
#include <hip/hip_runtime.h>
#include <cstdio>
#include <cstdint>
#include <cmath>
namespace pg8 {
#define PG8_LAS __attribute__((address_space(3)))
typedef unsigned short bf16_t;
typedef short bf16x8 __attribute__((ext_vector_type(8)));
typedef float f32x4 __attribute__((ext_vector_type(4)));
typedef unsigned u32x4 __attribute__((ext_vector_type(4)));
constexpr int BM = 256, BK = 64, HALF = 128, HTB = HALF * BK * 2  , STAGE_BYTES = 8 * HTB, NXCD = 8, WGM = 8;

__host__ __device__ __forceinline__ int lds_byte(int r, int c) { const int st = (r >> 4) * 2 + (c >> 5), rr = r & 15, cc = c & 31, ob = rr * 64 + cc * 2; return st * 1024 + (ob ^ (((ob >> 9) & 1) << 5)); }
__host__ __device__ __forceinline__ void stage_rc(int b, int& R, int& C) { const int st = b / 1024, sb = b % 1024, swz = sb ^ (((sb >> 9) & 1) << 5); R = (st >> 1) * 16 + swz / 64; C = (st & 1) * 32 + (swz % 64) / 2; }
__host__ __device__ __forceinline__ int perm32(int rho) { const int n = rho >> 4, i = rho & 15; return 8 * (i >> 2) + 4 * n + (i & 3); }

struct Unit { int pm, pn; };
struct Gemm { const bf16_t* A; const bf16_t* Bt; int lda, ldb, K, a_pn_step; };

struct StaticOrder {
    int nM, nN, nwg, G, c;
    __host__ __device__ void init(int M, int N, int G_, int c_) { nM = M / BM; nN = N / BM; nwg = nM * nN; G = G_; c = c_; }
    __host__ __device__ bool next(int i, Unit& u) const {
        const long L = (long)i * G + c; if (L >= nwg) return false;
        int wgid = (int)L; { const int q = nwg / NXCD, r = nwg % NXCD, xcd = wgid % NXCD, off = wgid / NXCD; wgid = (xcd < r ? xcd * (q + 1) : r * (q + 1) + (xcd - r) * q) + off; }
        const int nig = WGM * nN, gid = wgid / nig, fm = gid * WGM, gsz = (nM - fm) < WGM ? (nM - fm) : WGM;
        u.pm = fm + ((wgid % nig) % gsz); u.pn = (wgid % nig) / gsz; return true;
    }
    __device__ __forceinline__ void a_ready(const Unit&) const {}
    __device__ __forceinline__ void done(const Unit&) const {}
};
__device__ __forceinline__ unsigned cvt_pk_bf16(float lo, float hi) { unsigned r; asm volatile("v_cvt_pk_bf16_f32 %0, %1, %2" : "=v"(r) : "v"(lo), "v"(hi)); return r; }
template <class Epi, class Sched, bool ALIGN_EPI = false, bool SP2 = false>
__device__ __forceinline__ void gemm_phase(PG8_LAS unsigned char* lds, const Gemm g, const Sched& S, const Epi& E, int tid_in) {
    int tid_l = tid_in; asm volatile("" : "+v"(tid_l));
    const int tid = tid_l, wid = __builtin_amdgcn_readfirstlane(tid >> 6), lane = tid & 63, wr = wid >> 2, wc = wid & 3, fr = lane & 15, fq = lane >> 4;
    const int K = g.K, nt = K / BK;
    unsigned voffA[2], voffB[2];
#pragma unroll
    for (int i = 0; i < 2; ++i) { int R, C; stage_rc(tid * 16 + i * 8192, R, C); const int Rb = Epi::PERM ? ((R & ~31) + perm32(R & 31)) : R;
        voffA[i] = (unsigned)(R * g.lda + C) * 2u; voffB[i] = (unsigned)(Rb * g.ldb + C) * 2u; }
    const size_t kstep = (size_t)(BK * 2);
    const size_t hstepA = (size_t)HALF * g.lda * 2, hstepB = (size_t)HALF * g.ldb * 2;
    const size_t tstepA = 2 * hstepA, tstepB = 2 * hstepB;
    const unsigned ldsw = (unsigned)wid * 1024u;
    const int aoff = lds_byte(wr * 64 + fr, fq * 8), boff = lds_byte(wc * 32 + fr, fq * 8);
#define PG8_SA(b, h) (((b) * 2 + (h)) * HTB)
#define PG8_SB(b, h) ((4 + (b) * 2 + (h)) * HTB)
#define PG8_STAGE(bufoff, gbase, voff) do { _Pragma("unroll") for (int _i = 0; _i < 2; ++_i) \
        __builtin_amdgcn_global_load_lds((const unsigned*)((const char*)(gbase) + (voff)[_i]), (PG8_LAS unsigned*)(lds + (bufoff) + ldsw + _i * 8192), 16, 0, 0); } while (0)
#define PG8_LDA(dst, b, h) do { _Pragma("unroll") for (int m = 0; m < 4; ++m) _Pragma("unroll") for (int k = 0; k < 2; ++k) dst[m][k] = *(const PG8_LAS bf16x8*)(lds + PG8_SA(b, h) + aoff + m * 2048 + k * 1024); } while (0)
#define PG8_LDB(dst, b, h) do { _Pragma("unroll") for (int n = 0; n < 2; ++n) _Pragma("unroll") for (int k = 0; k < 2; ++k) dst[n][k] = *(const PG8_LAS bf16x8*)(lds + PG8_SB(b, h) + boff + n * 2048 + k * 1024); } while (0)
#define PG8_MMA(ai, bj, At, Bt) do { __builtin_amdgcn_s_setprio(1); _Pragma("unroll") for (int m = 0; m < 4; ++m) _Pragma("unroll") for (int n = 0; n < 2; ++n) _Pragma("unroll") for (int k = 0; k < 2; ++k) \
        acc[ai][bj][m][n] = __builtin_amdgcn_mfma_f32_16x16x32_bf16(Bt[n][k], At[m][k], acc[ai][bj][m][n], 0, 0, 0); __builtin_amdgcn_s_setprio(0); } while (0)
#define PG8_WAIT_V(n) asm volatile("s_waitcnt vmcnt(" #n ")" ::: "memory")
#define PG8_WAIT_L(n) asm volatile("s_waitcnt lgkmcnt(" #n ")" ::: "memory")
#define PG8_BAR __builtin_amdgcn_s_barrier()
#define PG8_SCHED __builtin_amdgcn_sched_barrier(0)
    Unit cur, nxt; int ui = 0;
    if (!S.next(0, cur)) return;
    f32x4 acc[2][2][4][2];
#pragma unroll
    for (int a = 0; a < 2; ++a)
#pragma unroll
        for (int b = 0; b < 2; ++b)
#pragma unroll
            for (int m = 0; m < 4; ++m)
#pragma unroll
                for (int n = 0; n < 2; ++n) acc[a][b][m][n] = (f32x4){0.f, 0.f, 0.f, 0.f};
    bf16x8 At[4][2], B0[2][2], B1[2][2];
    const char* cA = (const char*)g.A + (size_t)cur.pm * tstepA + (size_t)cur.pn * g.a_pn_step; const char* cB = (const char*)g.Bt + (size_t)cur.pn * tstepB;
    S.a_ready(cur);
    if constexpr (SP2) {
        PG8_STAGE(PG8_SB(0, 0), cB, voffB); PG8_STAGE(PG8_SB(0, 1), cB + hstepB, voffB); PG8_STAGE(PG8_SA(0, 0), cA, voffA); PG8_STAGE(PG8_SA(0, 1), cA + hstepA, voffA);
        if (wr == 1) PG8_BAR;
        PG8_WAIT_V(2); PG8_BAR;
        PG8_STAGE(PG8_SB(1, 0), cB + kstep, voffB); PG8_STAGE(PG8_SA(1, 0), cA + kstep, voffA); PG8_STAGE(PG8_SB(1, 1), cB + hstepB + kstep, voffB);
        PG8_WAIT_V(6); PG8_BAR;
    } else {
        PG8_STAGE(PG8_SB(0, 0), cB, voffB); PG8_STAGE(PG8_SA(0, 0), cA, voffA); PG8_STAGE(PG8_SB(0, 1), cB + hstepB, voffB); PG8_STAGE(PG8_SA(0, 1), cA + hstepA, voffA);
        if (wr == 1) PG8_BAR;
        PG8_WAIT_V(4); PG8_BAR;
        PG8_STAGE(PG8_SB(1, 0), cB + kstep, voffB); PG8_STAGE(PG8_SA(1, 0), cA + kstep, voffA); PG8_STAGE(PG8_SB(1, 1), cB + hstepB + kstep, voffB);
        PG8_WAIT_V(6); PG8_BAR;
    }
    for (;;) {
        const bool has_next = S.next(ui + 1, nxt);
        const char* nA = has_next ? (const char*)g.A + (size_t)nxt.pm * tstepA + (size_t)nxt.pn * g.a_pn_step : cA; const char* nB = has_next ? (const char*)g.Bt + (size_t)nxt.pn * tstepB : cB;
        for (int t = 0; t < nt; t += 2) {
            const bool last = (t == nt - 2);
            const char* a1 = cA + (size_t)(t + 1) * kstep;
            const char* a2 = last ? nA : cA + (size_t)(t + 2) * kstep; const char* b2 = last ? nB : cB + (size_t)(t + 2) * kstep;
            const char* a3 = a2 + kstep; const char* b3 = b2 + kstep;
            if (last && has_next) S.a_ready(nxt);
            if constexpr (SP2) {
            PG8_LDB(B0, 0, 0); PG8_LDB(B1, 0, 1); PG8_SCHED; PG8_LDA(At, 0, 0); PG8_STAGE(PG8_SA(1, 1), a1 + hstepA, voffA);
            PG8_WAIT_V(8); PG8_WAIT_L(0); PG8_BAR; PG8_MMA(0, 0, At, B0); PG8_MMA(0, 1, At, B1); PG8_BAR; PG8_SCHED;
            PG8_LDA(At, 0, 1); PG8_STAGE(PG8_SB(0, 0), b2, voffB); PG8_STAGE(PG8_SB(0, 1), b2 + hstepB, voffB); PG8_STAGE(PG8_SA(0, 0), a2, voffA);
            PG8_WAIT_V(8); PG8_WAIT_L(0); PG8_BAR; PG8_MMA(1, 0, At, B0); PG8_MMA(1, 1, At, B1); PG8_BAR; PG8_SCHED;
            PG8_LDB(B0, 1, 0); PG8_LDB(B1, 1, 1); PG8_SCHED; PG8_LDA(At, 1, 0); PG8_STAGE(PG8_SA(0, 1), a2 + hstepA, voffA);
            PG8_WAIT_V(8); PG8_WAIT_L(0); PG8_BAR; PG8_MMA(0, 0, At, B0); PG8_MMA(0, 1, At, B1); PG8_BAR; PG8_SCHED;
            PG8_LDA(At, 1, 1); PG8_STAGE(PG8_SB(1, 0), b3, voffB); PG8_STAGE(PG8_SB(1, 1), b3 + hstepB, voffB); PG8_STAGE(PG8_SA(1, 0), a3, voffA);
            PG8_WAIT_V(8); PG8_WAIT_L(0); PG8_BAR; PG8_MMA(1, 0, At, B0); PG8_MMA(1, 1, At, B1); PG8_BAR; PG8_SCHED;
            } else {
            PG8_LDB(B0, 0, 0); PG8_SCHED; PG8_LDA(At, 0, 0); PG8_STAGE(PG8_SA(1, 1), a1 + hstepA, voffA);
            PG8_WAIT_L(8); PG8_BAR; PG8_WAIT_L(0); PG8_MMA(0, 0, At, B0); PG8_BAR; PG8_SCHED;
            PG8_LDB(B1, 0, 1); PG8_STAGE(PG8_SB(0, 0), b2, voffB);
            PG8_BAR; PG8_WAIT_L(0); PG8_MMA(0, 1, At, B1); PG8_BAR;
            PG8_LDA(At, 0, 1); PG8_STAGE(PG8_SA(0, 0), a2, voffA);
            PG8_BAR; PG8_WAIT_L(0); PG8_MMA(1, 0, At, B0); PG8_BAR; PG8_SCHED;
            PG8_STAGE(PG8_SB(0, 1), b2 + hstepB, voffB);
            PG8_WAIT_V(6); PG8_BAR; PG8_MMA(1, 1, At, B1); PG8_BAR;
            PG8_LDB(B0, 1, 0); PG8_SCHED; PG8_LDA(At, 1, 0); PG8_STAGE(PG8_SA(0, 1), a2 + hstepA, voffA);
            PG8_WAIT_L(8); PG8_BAR; PG8_WAIT_L(0); PG8_MMA(0, 0, At, B0); PG8_BAR; PG8_SCHED;
            PG8_LDB(B1, 1, 1); PG8_STAGE(PG8_SB(1, 0), b3, voffB);
            PG8_BAR; PG8_WAIT_L(0); PG8_MMA(0, 1, At, B1); PG8_BAR;
            PG8_LDA(At, 1, 1); PG8_STAGE(PG8_SA(1, 0), a3, voffA);
            PG8_BAR; PG8_WAIT_L(0); PG8_MMA(1, 0, At, B0); PG8_BAR; PG8_SCHED;
            PG8_STAGE(PG8_SB(1, 1), b3 + hstepB, voffB);
            PG8_WAIT_V(6); PG8_BAR; PG8_MMA(1, 1, At, B1); PG8_BAR;
            }
        }
        if constexpr (ALIGN_EPI) { if (wr == 0) PG8_BAR; }
        if constexpr (!Epi::AFTER_DRAIN) { int l2_; asm volatile("v_mbcnt_lo_u32_b32 %0, -1, 0\n\tv_mbcnt_hi_u32_b32 %0, -1, %0" : "=v"(l2_)); E(acc, cur, wr, wc, l2_ & 15, l2_ >> 4); S.done(cur); }
        if (!has_next) break;
#pragma unroll
        for (int a = 0; a < 2; ++a)
#pragma unroll
            for (int b = 0; b < 2; ++b)
#pragma unroll
                for (int m = 0; m < 4; ++m)
#pragma unroll
                    for (int n = 0; n < 2; ++n) acc[a][b][m][n] = (f32x4){0.f, 0.f, 0.f, 0.f};
        cur = nxt; cA = nA; cB = nB; ++ui;
        if constexpr (ALIGN_EPI) { if (wr == 1) PG8_BAR; }
    }
    PG8_WAIT_V(0);
    if constexpr (!ALIGN_EPI) { if (wr == 0) PG8_BAR; }
    PG8_BAR;
    if constexpr (Epi::AFTER_DRAIN) { E.fused(acc, cur, wr, wc, fr, fq, lds, wid, lane); S.done(cur); }
#undef PG8_SA
#undef PG8_SB
#undef PG8_STAGE
#undef PG8_LDA
#undef PG8_LDB
#undef PG8_MMA
#undef PG8_WAIT_V
#undef PG8_WAIT_L
#undef PG8_BAR
#undef PG8_SCHED
}
}

constexpr int D = 1024, BATCH = 8, SEQ = 4096, M = BATCH * SEQ, SBT = 32;
constexpr int FF = 2816, NWI = 2 * FF;
constexpr int NKV = 4, KVW = 256;
constexpr int NPROJ = 2120, NPROJP = 2304;
constexpr int PAST = 16384, PAGE = 128, NPAGES = 128;
constexpr int NKEYS_S = PAST + 1, SCLD = 16448;
constexpr int TOPK = 256;
constexpr float LN_EPS = 1e-5f;
constexpr float ALPHA = 1.4142135623730951f;
constexpr float QSCALE = 0.125f * 1.4426950408889634f;
constexpr float WSCALE = 0.125f * 0.35355339059327373f;

constexpr size_t O_YP = 0, O_YS = 33554432, O_KP = 33587200, O_VP = 41975808, O_KIP = 50364416, O_PP = 52461568,
                 O_KS = 52584448, O_VS = 52592640, O_KIS = 52600832, O_PS = 52602880, O_END = 53094400;

constexpr size_t MiB = 1u << 20;
constexpr size_t WS_CTL = 0, CTL_ZERO_BYTES = 1 * MiB;
constexpr size_t WS_WI = 2 * MiB;
constexpr size_t WI_STRIDE = 11 * MiB;
constexpr size_t WS_WO = 46 * MiB;
constexpr size_t WO_STRIDE = (size_t)D * FF * 2;
constexpr size_t WS_WIN = 68 * MiB;
constexpr size_t WS_WOA = 73 * MiB;
constexpr size_t WS_WPOOL = 75 * MiB;
constexpr size_t WS_ROPE = 76 * MiB;
constexpr size_t WS_XB = 80 * MiB;
constexpr size_t WS_XA = 144 * MiB;
constexpr size_t WS_PRE = 272 * MiB;
constexpr size_t WS_G = 400 * MiB;
constexpr size_t WS_QB = 576 * MiB;
constexpr size_t WS_OB = 640 * MiB;
constexpr size_t WS_KB = 704 * MiB;
constexpr size_t WS_VB = 720 * MiB;
constexpr size_t WS_QIB = 736 * MiB;
constexpr size_t WS_KIB = 768 * MiB;
constexpr size_t WS_WIF = 772 * MiB;
constexpr size_t WS_MASK = 776 * MiB;
constexpr size_t WS_LIST = 792 * MiB;
constexpr size_t WS_DB = 808 * MiB;
constexpr size_t WS_S = 880 * MiB;
constexpr size_t S_XS = 0, S_PRES = 131072, S_XSB = 262144, S_GS = 327680, S_QS = 524288, S_QIS = 655360, S_WIS = 720896,
                 S_OS = 786432, S_DS = 851968, S_SC = 1048576;
constexpr size_t WS_END = 884 * MiB;

constexpr int CW_BAR = 4096;

constexpr int RING_OFF = 0, RING_BYTES = 131072;
constexpr int MISC_OFF = RING_BYTES;
constexpr int LDS_BYTES = 147456;
constexpr int NWAVES = 8, NTHREADS = 512;

#define GAS __attribute__((address_space(1)))
#define LAS __attribute__((address_space(3)))
typedef unsigned short bf16;
typedef unsigned v4u __attribute__((ext_vector_type(4)));
typedef unsigned v2u __attribute__((ext_vector_type(2)));
typedef float f32x4 __attribute__((ext_vector_type(4)));
typedef float f32x2 __attribute__((ext_vector_type(2)));
typedef float f32x16 __attribute__((ext_vector_type(16)));
typedef short bf16x8 __attribute__((ext_vector_type(8)));
#define LDS_WAIT() asm volatile("s_waitcnt lgkmcnt(0)" ::: "memory")
#define VM_WAIT() asm volatile("s_waitcnt vmcnt(0)" ::: "memory")
__device__ __forceinline__ unsigned f2bf(float f) { unsigned u = __builtin_bit_cast(unsigned, f); return (u + 0x7fffu + ((u >> 16) & 1u)) >> 16; }
__device__ __forceinline__ unsigned pk2(float lo, float hi) { return f2bf(lo) | (f2bf(hi) << 16); }
__device__ __forceinline__ float bf2f(unsigned short b) { return __builtin_bit_cast(float, (unsigned)b << 16); }
#define DPP_ROR(v, n) __uint_as_float((unsigned)__builtin_amdgcn_update_dpp(0, (int)__float_as_uint(v), 0x120 + (n), 0xf, 0xf, false))
#define RDL(v, l) __uint_as_float((unsigned)__builtin_amdgcn_readlane((int)__float_as_uint(v), (l)))
__device__ __forceinline__ float wave_sum(float v) {
    v += DPP_ROR(v, 1); v += DPP_ROR(v, 2); v += DPP_ROR(v, 4); v += DPP_ROR(v, 8);
    return (RDL(v, 0) + RDL(v, 16)) + (RDL(v, 32) + RDL(v, 48));
}
__device__ __forceinline__ float wave_max(float v) {
    v = fmaxf(v, DPP_ROR(v, 1)); v = fmaxf(v, DPP_ROR(v, 2)); v = fmaxf(v, DPP_ROR(v, 4)); v = fmaxf(v, DPP_ROR(v, 8));
    return fmaxf(fmaxf(RDL(v, 0), RDL(v, 16)), fmaxf(RDL(v, 32), RDL(v, 48)));
}
__device__ __forceinline__ float wave_min(float v) {
    v = fminf(v, DPP_ROR(v, 1)); v = fminf(v, DPP_ROR(v, 2)); v = fminf(v, DPP_ROR(v, 4)); v = fminf(v, DPP_ROR(v, 8));
    return fminf(fminf(RDL(v, 0), RDL(v, 16)), fminf(RDL(v, 32), RDL(v, 48)));
}
__device__ __forceinline__ float silu_f(float x) { return x * __builtin_amdgcn_rcpf(1.0f + __builtin_amdgcn_exp2f(-1.4426950408889634f * x)); }
__device__ __forceinline__ int mbcnt64(unsigned long long m) { return (int)__builtin_amdgcn_mbcnt_hi((unsigned)(m >> 32), __builtin_amdgcn_mbcnt_lo((unsigned)m, 0u)); }

namespace pg8 {
struct EpiSwiglu {
    static constexpr bool PERM = true, AFTER_DRAIN = false;
    bf16_t* G;
    __device__ __forceinline__ void operator()(const f32x4 (&acc)[2][2][4][2], const Unit& u, int wr, int wc, int fr, int fq) const {
        const int row0 = u.pm * BM + wr * 64 + fr; const int col0 = u.pn * HALF + wc * 32 + 8 * fq;
#pragma unroll
        for (int ai = 0; ai < 2; ++ai)
#pragma unroll
            for (int m = 0; m < 4; ++m) {
                bf16_t* rowp = G + (size_t)(row0 + ai * HALF + m * 16) * FF + col0;
                const f32x4 g0 = acc[ai][0][m][0], g1 = acc[ai][0][m][1], u0 = acc[ai][1][m][0], u1 = acc[ai][1][m][1];
                u32x4 w;
                w.x = cvt_pk_bf16(silu_f(g0[0]) * u0[0], silu_f(g0[1]) * u0[1]); w.y = cvt_pk_bf16(silu_f(g0[2]) * u0[2], silu_f(g0[3]) * u0[3]);
                w.z = cvt_pk_bf16(silu_f(g1[0]) * u1[0], silu_f(g1[1]) * u1[1]); w.w = cvt_pk_bf16(silu_f(g1[2]) * u1[2], silu_f(g1[3]) * u1[3]);
                *(u32x4*)rowp = w;
            }
    }
};
template <bool HAS_CS> struct EpiResid {
    static constexpr bool PERM = false, AFTER_DRAIN = false;
    const float* X; float* P; float s; const float* cs;
    __device__ __forceinline__ void operator()(const f32x4 (&acc)[2][2][4][2], const Unit& u, int wr, int wc, int fr, int fq) const {
        const int row0 = u.pm * BM + wr * 64 + fr; const int col0 = u.pn * BM + wc * 32 + 4 * fq;
        f32x4 sc[2][2];
        if (HAS_CS) {
#pragma unroll
            for (int bj = 0; bj < 2; ++bj)
#pragma unroll
                for (int n = 0; n < 2; ++n) sc[bj][n] = *(const f32x4*)(cs + col0 + bj * HALF + n * 16) * s;
        }
#pragma unroll
        for (int ai = 0; ai < 2; ++ai)
#pragma unroll
            for (int m = 0; m < 4; ++m) {
                const size_t off = (size_t)(row0 + ai * HALF + m * 16) * D + col0;
                const float* xp = X + off; float* pp = P + off;
#pragma unroll
                for (int bj = 0; bj < 2; ++bj)
#pragma unroll
                    for (int n = 0; n < 2; ++n) {
                        const f32x4 x = *(const f32x4*)(xp + bj * HALF + n * 16);
                        if (HAS_CS) *(f32x4*)(pp + bj * HALF + n * 16) = x * ALPHA + acc[ai][bj][m][n] * sc[bj][n];
                        else *(f32x4*)(pp + bj * HALF + n * 16) = x * ALPHA + acc[ai][bj][m][n] * s;
                    }
                asm volatile("" ::: "memory");
            }
    }
};
struct EpiProj {
    static constexpr bool PERM = false, AFTER_DRAIN = false;
    unsigned char* wsb; float* outb;
    __device__ __forceinline__ void operator()(const f32x4 (&acc)[2][2][4][2], const Unit& u, int wr, int wc, int fr, int fq) const {
        const int pn = u.pn;
        const int row0 = u.pm * BM + wr * 64 + fr;
        const bool rot_tile = (pn != 5) && ((wc & 1) == 0) && (pn < 8 || wc == 0);
        const f32x2* rope = (const f32x2*)(wsb + WS_ROPE);
        const float sg = (fq < 2) ? -1.f : 1.f;
        size_t bf_off, f_off = 0; int ldb_, ldf_ = 0, colmax = 256; float scl = 1.f; bool hasf = false;
        if (pn < 4)       { bf_off = WS_QB + (size_t)pn * BM * 2; ldb_ = D; scl = QSCALE; }
        else if (pn == 4) { bf_off = WS_KB; ldb_ = KVW; f_off = O_KP; ldf_ = KVW; hasf = true; }
        else if (pn == 5) { bf_off = WS_VB; ldb_ = KVW; f_off = O_VP; ldf_ = KVW; hasf = true; }
        else if (pn < 8)  { bf_off = WS_QIB + (size_t)(pn - 6) * BM * 2; ldb_ = 512; }
        else              { bf_off = WS_KIB; ldb_ = 64; f_off = O_KIP; ldf_ = 64; hasf = true; colmax = 64; }
        bf16_t* bfb = (bf16_t*)(wsb + bf_off); float* fb = outb + f_off;
#pragma unroll
        for (int ai = 0; ai < 2; ++ai)
#pragma unroll
            for (int m = 0; m < 4; ++m) {
                const int row = row0 + ai * HALF + m * 16; const int pos = row & (SEQ - 1);
#pragma unroll
                for (int bj = 0; bj < 2; ++bj)
#pragma unroll
                    for (int n = 0; n < 2; ++n) {
                        f32x4 v = acc[ai][bj][m][n];
                        const int cit = bj * HALF + wc * 32 + n * 16 + 4 * fq;
                        if (n == 0 && rot_tile && (pn < 8 || bj == 0)) {
                            const f32x2* rp = rope + pos * 8 + 4 * (fq & 1);
#pragma unroll
                            for (int j = 0; j < 4; ++j) {
                                const auto rr = __builtin_amdgcn_permlane32_swap(__float_as_uint(v[j]), __float_as_uint(v[j]), false, false);
                                const float p = __uint_as_float((fq < 2) ? rr[1] : rr[0]);
                                const f32x2 cs = rp[j];
                                v[j] = v[j] * cs.x + sg * p * cs.y;
                            }
                        }
                        if (cit < colmax) {
                            if (hasf) *(f32x4*)(fb + (size_t)row * ldf_ + cit) = v;
                            v = v * scl; v2u w; w.x = cvt_pk_bf16(v[0], v[1]); w.y = cvt_pk_bf16(v[2], v[3]);
                            *(v2u*)(bfb + (size_t)row * ldb_ + cit) = w;
                        } else if (cit < 72) {
                            *(f32x4*)((float*)(wsb + WS_WIF) + (size_t)row * 8 + (cit - 64)) = v;
                        }
                    }
                asm volatile("" ::: "memory");
            }
    }
};
}

#define XB_TMO      128
#define XB_XCNT(j)  (256  + 64 * (j))
#define XB_XSUB(j)  (1280 + 64 * (j))
#define XB_XGEN(j)  (2304 + 64 * (j))
#define XB_TOP      3328
#define XB_TOPGEN   3392
#define XCD_BAR_WORDS 3456
#define XB_SPIN_CAP (1u << 18)
__device__ __forceinline__ unsigned xb_ld(unsigned* p)              { return __hip_atomic_load(p, __ATOMIC_RELAXED, __HIP_MEMORY_SCOPE_AGENT); }
__device__ __forceinline__ unsigned xb_add(unsigned* p, unsigned v) { return __hip_atomic_fetch_add(p, v, __ATOMIC_RELAXED, __HIP_MEMORY_SCOPE_AGENT); }
__device__ __forceinline__ unsigned xb_xcc_id() { return (unsigned)__builtin_amdgcn_s_getreg((3 << 11) | 20) & 0xFu; }
#define XB_SPIN(cond, bar) do { unsigned _sp = 0; while (cond) { __builtin_amdgcn_s_sleep(1); \
    if ((++_sp & 255u) == 0u) { if (xb_ld(&(bar)[XB_TMO])) break; if (_sp > XB_SPIN_CAP) { atomicAdd(&(bar)[XB_TMO], 1u); break; } } } } while (0)
struct XcdBarrier { unsigned* bar; unsigned x; volatile LAS unsigned* st; };
__device__ __forceinline__ XcdBarrier xcd_barrier_post(unsigned* bar, volatile LAS unsigned* st, int tid) {
    XcdBarrier b; b.bar = bar; b.x = xb_xcc_id(); b.st = st;
    if (tid == 0) (void)xb_add(&bar[XB_XCNT(b.x)], 1u);
    return b;
}
__device__ __forceinline__ void xcd_barrier_complete(unsigned* bar, unsigned x, unsigned& nloc, unsigned& nx) {
    const unsigned G = gridDim.x * gridDim.y * gridDim.z;
    unsigned sum, cnt, mine, sp = 0u;
    for (;;) {
        sum = 0u; cnt = 0u; mine = 0u;
#pragma unroll
        for (unsigned j = 0; j < 16; ++j) { const unsigned c = xb_ld(&bar[XB_XCNT(j)]); sum += c; cnt += (c > 0u) ? 1u : 0u; mine = (j == x) ? c : mine; }
        if (sum == G) break;
        __builtin_amdgcn_s_sleep(1);
        if ((++sp & 255u) == 0u) { if (xb_ld(&bar[XB_TMO])) break; if (sp > XB_SPIN_CAP) { atomicAdd(&bar[XB_TMO], 1u); break; } }
    }
    nloc = mine > 0u ? mine : 1u; nx = cnt > 0u ? cnt : 1u;
}
__device__ __forceinline__ void xcd_barrier(const XcdBarrier& b, int tid) {
    asm volatile("s_waitcnt vmcnt(0)" ::: "memory");
    __syncthreads();
    if (tid == 0) {
        unsigned* bar = b.bar;
        __builtin_amdgcn_s_waitcnt(0);
        unsigned nloc = b.st[0], nx = b.st[1];
        if (nloc == 0u) { xcd_barrier_complete(bar, b.x, nloc, nx); b.st[0] = nloc; b.st[1] = nx; }
        const unsigned old = xb_add(&bar[XB_XSUB(b.x)], 1u);
        const unsigned gen = old / nloc;
        if (old + 1u == (gen + 1u) * nloc) {
            __builtin_amdgcn_fence(__ATOMIC_RELEASE, "agent");
            asm volatile("s_waitcnt vmcnt(0)" ::: "memory");
            const unsigned og = xb_add(&bar[XB_TOP], 1u);
            const unsigned tg = og / nx;
            if (og + 1u == (tg + 1u) * nx) xb_add(&bar[XB_TOPGEN], 1u);
            else XB_SPIN(xb_ld(&bar[XB_TOPGEN]) == tg, bar);
            __builtin_amdgcn_fence(__ATOMIC_ACQUIRE, "agent");
            xb_add(&bar[XB_XGEN(b.x)], 1u);
            asm volatile("s_waitcnt vmcnt(0)" ::: "memory");
        } else {
            XB_SPIN(xb_ld(&bar[XB_XGEN(b.x)]) == gen, bar);
            __builtin_amdgcn_fence(__ATOMIC_ACQUIRE, "agent");
            asm volatile("s_waitcnt vmcnt(0)" ::: "memory");
        }
    }
    __syncthreads();
}

__device__ __forceinline__ void tr_item(const float* W, int ldw, int k0, int c0, int ncv, bf16* WT, int ldt, int r0, LAS float* scr, int lane) {
#pragma unroll 8
    for (int i = 0; i < 32; ++i) { const int kk = 2 * i + (lane >> 5), c = lane & 31; scr[kk * 33 + c] = (c < ncv) ? W[(size_t)(k0 + kk) * ldw + c0 + c] : 0.f; }
    LDS_WAIT(); asm volatile("" ::: "memory");
    const int c8 = lane & 7;
#pragma unroll
    for (int j = 0; j < 4; ++j) { const int n = (lane >> 3) + 8 * j; const LAS float* s = scr + (8 * c8) * 33 + n;
        v4u o; o.x = pk2(s[0 * 33], s[1 * 33]); o.y = pk2(s[2 * 33], s[3 * 33]); o.z = pk2(s[4 * 33], s[5 * 33]); o.w = pk2(s[6 * 33], s[7 * 33]);
        *(GAS v4u*)(WT + (size_t)(r0 + n) * ldt + k0 + 8 * c8) = o; }
    LDS_WAIT(); asm volatile("" ::: "memory");
}

__device__ __forceinline__ void ln_row(const float* prow, const float* g, const float* b, float* xf, bf16* xb, float* extra, int lane) {
    const GAS f32x4* xr = (const GAS f32x4*)prow + lane;
    f32x4 v[4]; float s = 0.f;
#pragma unroll
    for (int j = 0; j < 4; ++j) { v[j] = xr[64 * j]; s += (v[j].x + v[j].y) + (v[j].z + v[j].w); }
    const float mean = wave_sum(s) * (1.f / D); float s2 = 0.f;
#pragma unroll
    for (int j = 0; j < 4; ++j) { v[j] = v[j] - mean; s2 += (v[j].x * v[j].x + v[j].y * v[j].y) + (v[j].z * v[j].z + v[j].w * v[j].w); }
    const float rstd = 1.f / sqrtf(wave_sum(s2) * (1.f / D) + LN_EPS);
#pragma unroll
    for (int j = 0; j < 4; ++j) {
        const f32x4 gg = *((const GAS f32x4*)g + lane + 64 * j), bb = *((const GAS f32x4*)b + lane + 64 * j);
        const f32x4 y = v[j] * rstd * gg + bb;
        if (xf) *((GAS f32x4*)xf + lane + 64 * j) = y;
        if (extra) *((GAS f32x4*)extra + lane + 64 * j) = y;
        if (xb) { v2u w; w.x = pk2(y.x, y.y); w.y = pk2(y.z, y.w); *((GAS v2u*)xb + lane + 64 * j) = w; }
    }
}

template <int RL>
__device__ __forceinline__ void ln_phase(unsigned char* wsb, float* outb, const float* g, const float* b, bool last, bool poolcopy, int gw, int NGW, int lane) {
    const int NR_ = M + SBT;
    for (int m0 = gw; m0 < NR_; m0 += RL * NGW) {
        const float* prow[RL]; float* xf[RL]; bf16* xb[RL]; float* extra[RL];
#pragma unroll
        for (int r = 0; r < RL; ++r) {
            int m = m0 + r * NGW; if (m >= NR_) m = m0;
            extra[r] = nullptr;
            if (m < M) {
                prow[r] = (const float*)(wsb + WS_PRE) + (size_t)m * D;
                xf[r] = last ? outb + O_YP + (size_t)m * D : (float*)(wsb + WS_XA) + (size_t)m * D;
                xb[r] = last ? nullptr : (bf16*)(wsb + WS_XB) + (size_t)m * D;
                if (poolcopy && (m & (SEQ - 1)) >= SEQ - 15) extra[r] = outb + O_PP + ((size_t)(m >> 12) * 15 + ((m & (SEQ - 1)) - (SEQ - 15))) * D;
            } else {
                const int sr = m - M;
                prow[r] = (const float*)(wsb + WS_S + S_PRES) + (size_t)sr * D;
                xf[r] = last ? outb + O_YS + (size_t)sr * D : (float*)(wsb + WS_S + S_XS) + (size_t)sr * D;
                xb[r] = last ? nullptr : (bf16*)(wsb + WS_S + S_XSB) + (size_t)sr * D;
                if (poolcopy) extra[r] = outb + O_PS + ((size_t)sr * 15 + 14) * D;
            }
        }
        f32x4 v[RL][4]; float s[RL];
#pragma unroll
        for (int r = 0; r < RL; ++r) {
            const GAS f32x4* xr = (const GAS f32x4*)prow[r] + lane; s[r] = 0.f;
#pragma unroll
            for (int j = 0; j < 4; ++j) { v[r][j] = xr[64 * j]; }
        }
#pragma unroll
        for (int r = 0; r < RL; ++r)
#pragma unroll
            for (int j = 0; j < 4; ++j) s[r] += (v[r][j].x + v[r][j].y) + (v[r][j].z + v[r][j].w);
#pragma unroll
        for (int r = 0; r < RL; ++r) s[r] = wave_sum(s[r]);
        float s2[RL];
#pragma unroll
        for (int r = 0; r < RL; ++r) { const float mean = s[r] * (1.f / D); s2[r] = 0.f;
#pragma unroll
            for (int j = 0; j < 4; ++j) { v[r][j] = v[r][j] - mean; s2[r] += (v[r][j].x * v[r][j].x + v[r][j].y * v[r][j].y) + (v[r][j].z * v[r][j].z + v[r][j].w * v[r][j].w); } }
#pragma unroll
        for (int r = 0; r < RL; ++r) s2[r] = wave_sum(s2[r]);
#pragma unroll
        for (int j = 0; j < 4; ++j) {
            const f32x4 gg = *((const GAS f32x4*)g + lane + 64 * j), bb = *((const GAS f32x4*)b + lane + 64 * j);
#pragma unroll
            for (int r = 0; r < RL; ++r) {
                const float rstd = 1.f / sqrtf(s2[r] * (1.f / D) + LN_EPS);
                const f32x4 y = v[r][j] * rstd * gg + bb;
                *((GAS f32x4*)xf[r] + lane + 64 * j) = y;
                if (extra[r]) *((GAS f32x4*)extra[r] + lane + 64 * j) = y;
                if (xb[r]) { v2u w; w.x = pk2(y.x, y.y); w.y = pk2(y.z, y.w); *((GAS v2u*)xb[r] + lane + 64 * j) = w; }
            }
        }
    }
}

template <int W>
__device__ __forceinline__ void pool_seg(const float* X, bf16* Dst, int row0, int col) {
    const int t0 = row0 & (SEQ - 1);
    f32x4 ring[W]; f32x4 sum = (f32x4){0.f, 0.f, 0.f, 0.f};
#pragma unroll
    for (int k = 0; k < W; ++k) ring[k] = (f32x4){0.f, 0.f, 0.f, 0.f};
    if (t0 > 0) {
#pragma unroll
        for (int k = 1; k < W; ++k) { ring[k] = *(const f32x4*)(X + (size_t)(row0 - W + k) * D + col); sum = sum + ring[k]; }
    }
    for (int r = 0; r < 64; r += W) {
#pragma unroll
        for (int u = 0; u < W; ++u) {
            const int row = row0 + r + u; const int t = t0 + r + u;
            const f32x4 x = *(const f32x4*)(X + (size_t)row * D + col);
            sum = sum + x - ring[u];
            ring[u] = x;
            const float inv = 1.0f / (float)((t + 1 < W) ? t + 1 : W);
            const f32x4 d = sum * inv - x;
            v2u o; o.x = pk2(d.x, d.y); o.y = pk2(d.z, d.w); *(v2u*)(Dst + (size_t)row * D + col) = o;
        }
    }
}

template <int NT, class Desc>
__device__ __forceinline__ void sgemm32(const bf16* Xb, int lda, const bf16* Bt, int ldb, int K, int nitems, int wg, int nwg, LAS float* red, int tid, const Desc& dsc) {
    asm volatile("" : "+v"(tid));
    const int lane = tid & 63, wid = tid >> 6, r = lane & 31, h = lane >> 5;
    const int kper = K >> 3;
    LAS float* T = red + 8 * NT * 1024;
    for (int it = wg; it < nitems; it += nwg) {
        f32x16 acc[NT];
#pragma unroll
        for (int nt = 0; nt < NT; ++nt) acc[nt] = (f32x16){};
        const bf16* ap = Xb + (size_t)r * lda + dsc.aoff(it) + wid * kper + h * 8;
        const bf16* bp[NT];
#pragma unroll
        for (int nt = 0; nt < NT; ++nt) bp[nt] = Bt + (size_t)(dsc.ct(it, nt) * 32 + r) * ldb + wid * kper + h * 8;
        for (int k = 0; k < kper; k += 16) {
            const bf16x8 a = *(const bf16x8*)(ap + k);
#pragma unroll
            for (int nt = 0; nt < NT; ++nt) { const bf16x8 b = *(const bf16x8*)(bp[nt] + k); acc[nt] = __builtin_amdgcn_mfma_f32_32x32x16_bf16(a, b, acc[nt], 0, 0, 0); }
        }
#pragma unroll
        for (int nt = 0; nt < NT; ++nt)
#pragma unroll
            for (int rr = 0; rr < 16; ++rr) red[(wid * NT + nt) * 1024 + rr * 64 + lane] = acc[nt][rr];
        __syncthreads();
        for (int e = tid; e < NT * 1024; e += NTHREADS) {
            const int nt = e >> 10, x = e & 1023; float s = 0.f;
#pragma unroll
            for (int w = 0; w < 8; ++w) s += red[(w * NT + nt) * 1024 + x];
            const int rr = x >> 6, l = x & 63, j = l & 31, i = (rr & 3) + 8 * (rr >> 2) + 4 * (l >> 5);
            T[nt * 1056 + i * 33 + j] = s;
        }
        __syncthreads();
        dsc.epi(it, T, tid);
        __syncthreads();
    }
}
struct SDescG1 {
    bf16* GS;
    __device__ __forceinline__ int aoff(int) const { return 0; }
    __device__ __forceinline__ int ct(int it, int nt) const { return 8 * (it >> 2) + (it & 3) + 4 * nt; }
    __device__ __forceinline__ void epi(int it, const LAS float* T, int tid) const {
        for (int e = tid; e < 1024; e += NTHREADS) { const int i = e >> 5, j = e & 31; const float g = T[i * 33 + j], u = T[1056 + i * 33 + j];
            GS[i * FF + 128 * (it >> 2) + 32 * (it & 3) + j] = (bf16)f2bf(silu_f(g) * u); }
    }
};
struct SDescResid {
    const float* X; float* P; float s; const float* cs; int agroup;
    __device__ __forceinline__ int aoff(int it) const { return agroup ? 256 * (it >> 3) : 0; }
    __device__ __forceinline__ int ct(int it, int) const { return it; }
    __device__ __forceinline__ void epi(int it, const LAS float* T, int tid) const {
        for (int e = tid; e < 1024; e += NTHREADS) { const int i = e >> 5, j = e & 31, col = it * 32 + j; float a = T[i * 33 + j] * s; if (cs) a *= cs[col];
            P[i * D + col] = ALPHA * X[i * D + col] + a; }
    }
};
struct SDescProj {
    float *QS, *QIS, *WIS, *outK, *outV, *outKI; const f32x2* rope;
    __device__ __forceinline__ int aoff(int) const { return 0; }
    __device__ __forceinline__ int ct(int it, int) const { return it; }
    __device__ __forceinline__ void epi(int it, const LAS float* T, int tid) const {
        for (int e = tid; e < 1024; e += NTHREADS) {
            const int i = e >> 5, j = e & 31, col = it * 32 + j;
            if (col >= NPROJ) continue;
            float v = T[i * 33 + j];
            const bool rot_region = (col < 1280) || (col >= 1536 && col < 2112);
            if (rot_region && ((it & 1) == 0) && j < 16) {
                const int f = j & 7; const float x1 = T[i * 33 + f], x2 = T[i * 33 + f + 8]; const f32x2 cs = rope[f];
                v = (j < 8) ? (x1 * cs.x - x2 * cs.y) : (x2 * cs.x + x1 * cs.y);
            }
            if (col < 1024) QS[i * D + col] = v * QSCALE;
            else if (col < 1280) outK[i * KVW + col - 1024] = v;
            else if (col < 1536) outV[i * KVW + col - 1280] = v;
            else if (col < 2048) QIS[i * 512 + col - 1536] = v;
            else if (col < 2112) outKI[i * 64 + col - 2048] = v;
            else WIS[i * 8 + col - 2112] = v;
        }
    }
};

#define SEL_KEY(x) ({ const unsigned u_ = __float_as_uint(x); u_ ^ ((u_ >> 31) ? 0xffffffffu : 0x80000000u); })
#define SEL_UNKEY(k) ({ const unsigned k_ = (k); __uint_as_float(k_ ^ ((k_ >> 31) ? 0x80000000u : 0xffffffffu)); })
#define SEL_BISECT() do { T = lo; bool done_ = false; \
        for (int itn = 0; itn < 14; ++itn) { \
            const float mid = lo + (hi - lo) * 0.5f; \
            if (!(mid > lo) || !(mid < hi)) { T = lo; done_ = true; break; } \
            SEL_CNT(c, >= mid); \
            if (c == TOPK) { T = mid; exact = true; done_ = true; break; } \
            if (c > TOPK) lo = mid; else hi = mid; \
            T = lo; } \
        if (!done_) { unsigned lk = SEL_KEY(lo), hk = SEL_KEY(hi); \
            while (hk - lk > 1u) { const unsigned mk = lk + ((hk - lk) >> 1); const float mid = SEL_UNKEY(mk); \
                SEL_CNT(c, >= mid); \
                if (c == TOPK) { T = mid; exact = true; done_ = true; break; } \
                if (c > TOPK) lk = mk; else hk = mk; } \
            if (!done_) T = SEL_UNKEY(lk); } } while (0)
__device__ __forceinline__ int wave_incl_scan(int x, int lane) {
#define DPP_SHR(v, n) __builtin_amdgcn_update_dpp(0, (v), 0x110 + (n), 0xf, 0xf, true)
    x += DPP_SHR(x, 1); x += DPP_SHR(x, 2); x += DPP_SHR(x, 4); x += DPP_SHR(x, 8);
#undef DPP_SHR
    const int t0 = __builtin_amdgcn_readlane(x, 15), t1 = __builtin_amdgcn_readlane(x, 31), t2 = __builtin_amdgcn_readlane(x, 47);
    const int r = lane >> 4;
    return x + ((r > 0) ? t0 : 0) + ((r > 1) ? t1 : 0) + ((r > 2) ? t2 : 0);
}
#define SEL_KEY(x) ({ const unsigned u_ = __float_as_uint(x); u_ ^ ((u_ >> 31) ? 0xffffffffu : 0x80000000u); })
#define SEL_UNKEY(k) ({ const unsigned k_ = (k); __uint_as_float(k_ ^ ((k_ >> 31) ? 0x80000000u : 0xffffffffu)); })
#define SEL_BISECT() do { T = lo; bool done_ = false; \
        for (int itn = 0; itn < 14; ++itn) { \
            const float mid = lo + (hi - lo) * 0.5f; \
            if (!(mid > lo) || !(mid < hi)) { T = lo; done_ = true; break; } \
            SEL_CNT(c, >= mid); \
            if (c == TOPK) { T = mid; exact = true; done_ = true; break; } \
            if (c > TOPK) lo = mid; else hi = mid; \
            T = lo; } \
        if (!done_) { unsigned lk = SEL_KEY(lo), hk = SEL_KEY(hi); \
            while (hk - lk > 1u) { const unsigned mk = lk + ((hk - lk) >> 1); const float mid = SEL_UNKEY(mk); \
                SEL_CNT(c, >= mid); \
                if (c == TOPK) { T = mid; exact = true; done_ = true; break; } \
                if (c > TOPK) lk = mk; else hk = mk; } \
            if (!done_) T = SEL_UNKEY(lk); } } while (0)
template <int NR>
__device__ __forceinline__ void select_row(LAS float* Srow, int t, int lane, unsigned* maskrow) {
    float v[NR];
#pragma unroll
    for (int i = 0; i < NR; ++i) { const int key = i * 64 + lane; const float x = Srow[key] + 0.0f; v[i] = (i < NR - 16 || key <= t) ? x : -INFINITY; }
#define SEL_CNT(OUT, PRED) do { int c_ = 0; _Pragma("unroll") for (int i_ = 0; i_ < NR; ++i_) c_ += __builtin_popcountll(__ballot(v[i_] PRED)); OUT = c_; } while (0)
    float T = -INFINITY; int need = 0; bool exact = true;
    if (t + 1 > TOPK) {
        float mx = -INFINITY;
#pragma unroll
        for (int i = 0; i < NR; ++i) mx = fmaxf(mx, v[i]);
        float hi = wave_max(mx), lo = wave_min(v[0]);
        bool bracketed = false; int c = 0;
        if (hi > lo) {
            const float scale = 4095.0f / (hi - lo), off = -lo * scale;
            LAS unsigned* hist = (LAS unsigned*)Srow;
            asm volatile("s_waitcnt lgkmcnt(0)" ::: "memory");
#pragma unroll
            for (int j = 0; j < 16; ++j) *(LAS v4u*)(hist + (j * 64 + lane) * 4) = (v4u){0u, 0u, 0u, 0u};
#pragma unroll
            for (int i = 0; i < NR; ++i) { const unsigned bn = (unsigned)__builtin_amdgcn_fmed3f(__builtin_fmaf(v[i], scale, off), 0.0f, 4095.0f); __hip_atomic_fetch_add(hist + bn, 1u, __ATOMIC_RELAXED, __HIP_MEMORY_SCOPE_WORKGROUP); }
            asm volatile("s_waitcnt lgkmcnt(0)" ::: "memory");
            const int hb = 4032 - 64 * lane;
            v4u h[16]; int g[16]; int tot = 0;
#pragma unroll
            for (int j = 0; j < 16; ++j) { h[j] = *(const LAS v4u*)(hist + hb + 4 * j); g[j] = (int)(h[j].x + h[j].y + h[j].z + h[j].w); tot += g[j]; }
            const int incl = wave_incl_scan(tot, lane), pre = incl - tot;
            const unsigned long long cross = __ballot(pre < TOPK && incl >= TOPK);
            if (cross) {
                const int Lx = __builtin_ctzll(cross);
                int cum = pre, jx = 0; bool found = false;
#pragma unroll
                for (int j = 15; j >= 0; --j) { const bool hit = !found && (cum + g[j] >= TOPK); if (hit) { jx = j; found = true; } if (!found) cum += g[j]; }
                const v4u hq = *(const LAS v4u*)(hist + hb + 4 * jx);
                int kx = 3; { const int q3 = (int)hq.w, q2 = (int)hq.z, q1 = (int)hq.y;
                    if (cum + q3 >= TOPK) kx = 3; else { cum += q3; if (cum + q2 >= TOPK) kx = 2; else { cum += q2; if (cum + q1 >= TOPK) kx = 1; else { cum += q1; kx = 0; } } } }
                const int bstar = __builtin_amdgcn_readlane(hb + 4 * jx + kx, Lx);
                if (bstar > 0) {
                    const float inv = (hi - lo) * (1.0f / 4095.0f);
                    float blo = lo + ((float)bstar - 1.0f) * inv, bhi = lo + ((float)bstar + 2.0f) * inv;
                    const float e0 = lo + ((float)bstar - 0.001f) * inv;
                    if (e0 > blo && e0 < bhi) { SEL_CNT(c, >= e0); if (c == TOPK) { T = e0; bracketed = true; } else if (c > TOPK) blo = e0; else bhi = e0; }
                    if (!bracketed) { lo = blo; hi = bhi; }
                    else { lo = hi = T; }
                    if (!bracketed) {
                        T = lo; exact = false;
                        SEL_BISECT();
                        bracketed = true;
                    }
                }
            }
        }
        if (!bracketed) {
            float mn = INFINITY;
#pragma unroll
            for (int i = 0; i < NR; ++i) mn = fminf(mn, (v[i] == -INFINITY) ? INFINITY : v[i]);
            lo = wave_min(mn); hi = wave_max(mx);
            SEL_CNT(c, >= hi); exact = false;
            if (c >= TOPK) T = hi;
            else {
                T = lo;
                SEL_BISECT();
            }
        }
        if (!exact) { int cgt; SEL_CNT(cgt, > T); need = TOPK - cgt; }
    } else { T = -3.0e38f; }
#undef SEL_CNT
    unsigned mlo = 0u, mhi = 0u;
    if (exact) {
#pragma unroll
        for (int i = 0; i < NR; ++i) {
            const unsigned long long m = __ballot(v[i] >= T);
            { const unsigned m0_ = (unsigned)m, m1_ = (unsigned)(m >> 32); asm volatile("s_nop 4\n\tv_writelane_b32 %0, %2, %4\n\tv_writelane_b32 %1, %3, %4" : "+v"(mlo), "+v"(mhi) : "s"(m0_), "s"(m1_), "n"(i)); }
        }
    } else {
#pragma unroll
        for (int i = 0; i < NR; ++i) {
            const bool gt = v[i] > T; bool eq = (v[i] == T) && (need > 0);
            unsigned long long meq = __ballot(eq); int k = __builtin_popcountll(meq);
            if (k > need) { eq = eq && (mbcnt64(meq) < need); meq = __ballot(eq); k = need; }
            need -= k;
            const unsigned long long m = __ballot(gt) | meq;
            { const unsigned m0_ = (unsigned)m, m1_ = (unsigned)(m >> 32); asm volatile("s_nop 4\n\tv_writelane_b32 %0, %2, %4\n\tv_writelane_b32 %1, %3, %4" : "+v"(mlo), "+v"(mhi) : "s"(m0_), "s"(m1_), "n"(i)); }
        }
    }
    v2u mw; mw.x = mlo; mw.y = mhi;
    *((v2u*)maskrow + lane) = mw;
}
__device__ __forceinline__ void index_select_phase(const bf16* QIb, const bf16* KIb, const float* WIf, unsigned* MASK,
                                                   LAS float* S, int wg, int nwg, int tid) {
    const int wid = __builtin_amdgcn_readfirstlane(tid >> 6);
    const int ngroups = M / 8;
    for (int rd = 0; rd * nwg < ngroups; ++rd) {
        { int l_ = tid; asm volatile("" : "+v"(l_)); tid = l_; }
        const int lane = tid & 63, r = lane & 31, hh = lane >> 5;
        const int o = rd * nwg + ((rd & 1) ? (nwg - 1 - wg) : wg);
        if (o < ngroups) {
            const int qg = o >> 3, b = o & 7, t0 = qg * 8, rb = b * SEQ + t0;
            const int nkt = (t0 + 8 + 31) >> 5;
            bf16x8 A[2][4]; float W[2][16];
            const bf16* kbase = KIb + (size_t)(b * SEQ + r) * 64 + hh * 8;
            bf16x8 Bn[4];
            if (wid < nkt) {
#pragma unroll
                for (int d0 = 0; d0 < 4; ++d0) Bn[d0] = *(const bf16x8*)(kbase + (size_t)wid * 32 * 64 + d0 * 16);
            }
#pragma unroll
            for (int mt = 0; mt < 2; ++mt) {
#pragma unroll
                for (int d0 = 0; d0 < 4; ++d0) A[mt][d0] = *(const bf16x8*)(QIb + (size_t)(rb + 4 * mt + (r >> 3)) * 512 + (r & 7) * 64 + d0 * 16 + hh * 8);
#pragma unroll
                for (int rr = 0; rr < 16; ++rr) W[mt][rr] = WIf[(size_t)(rb + 4 * mt + (rr >> 2)) * 8 + (rr & 3) + 4 * hh] * WSCALE;
            }
            for (int kt = wid; kt < nkt; kt += 8) {
                bf16x8 Bf[4];
#pragma unroll
                for (int d0 = 0; d0 < 4; ++d0) Bf[d0] = Bn[d0];
                if (kt + 8 < nkt) {
#pragma unroll
                    for (int d0 = 0; d0 < 4; ++d0) Bn[d0] = *(const bf16x8*)(kbase + (size_t)(kt + 8) * 32 * 64 + d0 * 16);
                }
#pragma unroll
                for (int mt = 0; mt < 2; ++mt) {
                    f32x16 acc = (f32x16){};
#pragma unroll
                    for (int d0 = 0; d0 < 4; ++d0) acc = __builtin_amdgcn_mfma_f32_32x32x16_bf16(A[mt][d0], Bf[d0], acc, 0, 0, 0);
                    float sc[4];
#pragma unroll
                    for (int qq = 0; qq < 4; ++qq) {
                        float a = 0.f;
#pragma unroll
                        for (int e = 0; e < 4; ++e) a += fmaxf(acc[4 * qq + e], 0.f) * W[mt][4 * qq + e];
                        const auto rr2 = __builtin_amdgcn_permlane32_swap(__float_as_uint(a), __float_as_uint(a), false, false);
                        sc[qq] = __uint_as_float(rr2[0]) + __uint_as_float(rr2[1]);
                    }
                    const float v0 = hh ? sc[2] : sc[0], v1 = hh ? sc[3] : sc[1];
                    S[(4 * mt + 2 * hh) * 4096 + kt * 32 + r] = v0;
                    S[(4 * mt + 2 * hh + 1) * 4096 + kt * 32 + r] = v1;
                }
            }
        }
        __syncthreads();
        if (o < ngroups) {
            int lane_s = lane; asm volatile("" : "+v"(lane_s));
            const int qg = o >> 3, b = o & 7, t = qg * 8 + wid;
            unsigned* mrow = MASK + ((size_t)b * SEQ + t) * 128;
            LAS float* Srow = S + wid * 4096;
            if (t < 1024) select_row<16>(Srow, t, lane_s, mrow);
            else if (t < 2048) select_row<32>(Srow, t, lane_s, mrow);
            else if (t < 3072) select_row<48>(Srow, t, lane_s, mrow);
            else select_row<64>(Srow, t, lane_s, mrow);
        }
        __syncthreads();
    }
}

template <class KR, class VR>
__device__ __forceinline__ void gather_attend(const LAS float* qf, const LAS int* keys, LAS float* pl, int cnt, const KR& kr, const VR& vr, bf16* orow  , int lane) {
    float s[4][4];
#pragma unroll
    for (int c = 0; c < 4; ++c) {
        const int slot = lane + 64 * c; const bool valid = slot < cnt;
        const int key = keys[valid ? slot : 0];
        const float* kp = kr(key);
        float a[4] = {0.f, 0.f, 0.f, 0.f};
#pragma unroll 4
        for (int d4 = 0; d4 < 16; ++d4) {
            const f32x4 kv = *(const f32x4*)(kp + 4 * d4);
#pragma unroll
            for (int g = 0; g < 4; ++g) { const f32x4 qv = *(const LAS f32x4*)(qf + g * 64 + 4 * d4); a[g] += (kv.x * qv.x + kv.y * qv.y) + (kv.z * qv.z + kv.w * qv.w); }
        }
#pragma unroll
        for (int g = 0; g < 4; ++g) s[c][g] = valid ? a[g] : -INFINITY;
    }
    float linv[4];
#pragma unroll
    for (int g = 0; g < 4; ++g) {
        const float mx = wave_max(fmaxf(fmaxf(s[0][g], s[1][g]), fmaxf(s[2][g], s[3][g])));
        float sum = 0.f;
#pragma unroll
        for (int c = 0; c < 4; ++c) { const float p = __builtin_amdgcn_exp2f(s[c][g] - mx); sum += p; pl[g * 256 + lane + 64 * c] = p; }
        linv[g] = 1.0f / wave_sum(sum);
    }
    LDS_WAIT(); asm volatile("" ::: "memory");
    float o[4] = {0.f, 0.f, 0.f, 0.f};
    for (int slot = 0; slot < cnt; ++slot) {
        const int key = keys[slot];
        const float vv = vr(key)[lane];
#pragma unroll
        for (int g = 0; g < 4; ++g) o[g] += pl[g * 256 + slot] * vv;
    }
#pragma unroll
    for (int g = 0; g < 4; ++g) orow[g * 64 + lane] = (bf16)f2bf(o[g] * linv[g]);
    LDS_WAIT(); asm volatile("" ::: "memory");
}
struct RowPlain { const float* base; __device__ __forceinline__ const float* operator()(int key) const { return base + (size_t)key * KVW; } };
struct RowPaged { const float* cache; const float* newrow; const int* pt; int j;
    __device__ __forceinline__ const float* operator()(int key) const {
        if (key >= PAST) return newrow;
        const int phys = pt[key >> 7];
        return cache + ((size_t)(phys * PAGE + (key & (PAGE - 1))) * NKV + j) * 64;
    } };

__device__ __forceinline__ void attn_gather_phase(const bf16* Qb, const float* outK, const float* outV, const unsigned short* LIST, bf16* Ob, LAS unsigned char* lds, int wg, int nwg, int tid) {
    asm volatile("" : "+v"(tid));
    const int lane = tid & 63, wid = tid >> 6;
    LAS float* qf = (LAS float*)(lds + wid * 8192); LAS int* keys = (LAS int*)(lds + wid * 8192 + 1024); LAS float* pl = (LAS float*)(lds + wid * 8192 + 2048);
    const int j = wid & 3;
    for (int pr = wg; pr < M / 2; pr += nwg) {
        const int row = pr * 2 + (wid >> 2); const int b = row >> 12, t = row & (SEQ - 1);
        const int cnt = (t + 1 < TOPK) ? t + 1 : TOPK;
#pragma unroll
        for (int g = 0; g < 4; ++g) qf[g * 64 + lane] = bf2f(Qb[(size_t)row * D + (4 * j + g) * 64 + lane]);
#pragma unroll
        for (int c = 0; c < 4; ++c) keys[lane + 64 * c] = (lane + 64 * c < cnt) ? (int)LIST[(size_t)row * 256 + lane + 64 * c] : 0;
        LDS_WAIT(); asm volatile("" ::: "memory");
        RowPlain kr{outK + (size_t)b * SEQ * KVW + j * 64}, vr{outV + (size_t)b * SEQ * KVW + j * 64};
        gather_attend(qf, keys, pl, cnt, kr, vr, Ob + (size_t)row * D + 4 * j * 64, lane);
    }
}

__device__ __forceinline__ void sample_scores_phase(const float* QIS, const float* WIS, const float* cki, const float* kinew, const int* ptab, float* SC, LAS unsigned char* lds, int wg, int nwg, int tid) {
    asm volatile("" : "+v"(tid));
    const int lane = tid & 63, wid = tid >> 6;
    LAS float* qs = (LAS float*)(lds + wid * 4096);
    for (int it = wg * NWAVES + wid; it < SBT * NPAGES; it += nwg * NWAVES) {
        const int b = it >> 7, pg = it & 127;
#pragma unroll
        for (int i = 0; i < 8; ++i) qs[i * 64 + lane] = QIS[b * 512 + i * 64 + lane];
        if (lane < 8) qs[512 + lane] = WIS[b * 8 + lane] * WSCALE;
        LDS_WAIT(); asm volatile("" ::: "memory");
        const int phys = ptab[b * NPAGES + pg];
#pragma unroll
        for (int kk = 0; kk < 2; ++kk) {
            const int key = lane + 64 * kk;
            const float* kp = cki + ((size_t)phys * PAGE + key) * 64;
            float dot[8] = {0.f, 0.f, 0.f, 0.f, 0.f, 0.f, 0.f, 0.f};
#pragma unroll 4
            for (int d4 = 0; d4 < 16; ++d4) {
                const f32x4 kv = *(const f32x4*)(kp + 4 * d4);
#pragma unroll
                for (int h = 0; h < 8; ++h) { const f32x4 qv = *(const LAS f32x4*)(qs + h * 64 + 4 * d4); dot[h] += (kv.x * qv.x + kv.y * qv.y) + (kv.z * qv.z + kv.w * qv.w); }
            }
            float sc = 0.f;
#pragma unroll
            for (int h = 0; h < 8; ++h) sc += fmaxf(dot[h], 0.f) * qs[512 + h];
            SC[(size_t)b * SCLD + pg * PAGE + key] = sc;
        }
        LDS_WAIT(); asm volatile("" ::: "memory");
    }
    if (wg == nwg - 1 && tid < SBT) {
        const int b = tid; float sc = 0.f;
        for (int h = 0; h < 8; ++h) { float dsum = 0.f; for (int d = 0; d < 64; ++d) dsum += QIS[b * 512 + h * 64 + d] * kinew[b * 64 + d]; sc += fmaxf(dsum, 0.f) * WIS[b * 8 + h] * WSCALE; }
        SC[(size_t)b * SCLD + PAST] = sc;
    }
}

#define SS_CNT(OUT, PRED) do { int c_ = 0; _Pragma("unroll") for (int i_ = 0; i_ < 33; ++i_) c_ += __builtin_popcountll(__ballot(v[i_] PRED)); \
        if (lane == 0) cw[par * 8 + wid] = c_; __syncthreads(); int t_ = 0; _Pragma("unroll") for (int w_ = 0; w_ < 8; ++w_) t_ += cw[par * 8 + w_]; par ^= 1; OUT = t_; } while (0)
__device__ __forceinline__ void sample_select_attend(int b, const float* SC, const float* QS, const float* ck, const float* cv, const float* knew, const float* vnew, const int* ptab,
                                                     bf16* OS, LAS unsigned char* lds, int tid) {
    asm volatile("" : "+v"(tid));
    const int lane = tid & 63, wid = tid >> 6;
    LAS int* cw = (LAS int*)(lds);
    LAS float* cwf = (LAS float*)(lds);
    LAS int* keysL = (LAS int*)(lds + 1024);
    float v[33];
#pragma unroll
    for (int i = 0; i < 33; ++i) { const int key = i * NTHREADS + tid; v[i] = (key < NKEYS_S) ? SC[(size_t)b * SCLD + key] + 0.0f : -INFINITY; }
    float mn = INFINITY, mx = -INFINITY;
#pragma unroll
    for (int i = 0; i < 33; ++i) { mx = fmaxf(mx, v[i]); mn = fminf(mn, (v[i] == -INFINITY) ? INFINITY : v[i]); }
    mn = wave_min(mn); mx = wave_max(mx);
    if (lane == 0) { cwf[16 + wid] = mn; cwf[24 + wid] = mx; }
    if (tid == 0) cw[32] = 0;
    __syncthreads();
    float lo = cwf[16], hi = cwf[24];
#pragma unroll
    for (int w = 1; w < 8; ++w) { lo = fminf(lo, cwf[16 + w]); hi = fmaxf(hi, cwf[24 + w]); }
    int par = 0; int c; float T;
    SS_CNT(c, >= hi);
    if (c >= TOPK) T = hi;
    else {
        T = lo;
        for (int itn = 0; itn < 400; ++itn) {
            const float mid = lo + (hi - lo) * 0.5f;
            if (!(mid > lo) || !(mid < hi)) { T = lo; break; }
            SS_CNT(c, >= mid);
            if (c == TOPK) { T = mid; break; }
            if (c > TOPK) lo = mid; else hi = mid;
            T = lo;
        }
    }
    int cgt; SS_CNT(cgt, > T);
    int need = TOPK - cgt;
    int ceq; SS_CNT(ceq, == T);
#pragma unroll
    for (int i = 0; i < 33; ++i) {
        const bool sel = v[i] > T; const unsigned long long m = __ballot(sel);
        if (m) { int bs = 0; if (lane == 0) bs = atomicAdd((int*)&cw[32], __builtin_popcountll(m)); bs = __builtin_amdgcn_readfirstlane(bs);
            if (sel) keysL[bs + mbcnt64(m)] = i * NTHREADS + tid; }
    }
    if (ceq <= need) {
#pragma unroll
        for (int i = 0; i < 33; ++i) {
            const bool sel = v[i] == T; const unsigned long long m = __ballot(sel);
            if (m) { int bs = 0; if (lane == 0) bs = atomicAdd((int*)&cw[32], __builtin_popcountll(m)); bs = __builtin_amdgcn_readfirstlane(bs);
                if (sel) keysL[bs + mbcnt64(m)] = i * NTHREADS + tid; }
        }
    } else {
        int taken = 0;
#pragma unroll
        for (int i = 0; i < 33; ++i) {
            const bool eq = v[i] == T; const unsigned long long m = __ballot(eq);
            if (lane == 0) cw[40 + wid] = __builtin_popcountll(m);
            __syncthreads();
            int before = taken, tot = 0;
#pragma unroll
            for (int w = 0; w < 8; ++w) { const int kw = cw[40 + w]; if (w < wid) before += kw; tot += kw; }
            const int rank = before + mbcnt64(m);
            if (eq && rank < need) keysL[cgt + rank] = i * NTHREADS + tid;
            taken += tot;
            __syncthreads();
        }
    }
    __syncthreads();
    LAS int* rowi = (LAS int*)(lds + 2048);
    if (tid < TOPK) { const int key = keysL[tid]; rowi[tid] = (key >= PAST) ? -1 : (ptab[b * NPAGES + (key >> 7)] * PAGE + (key & (PAGE - 1))); }
    __syncthreads();
    {
        const int j = wid & 3, half = wid >> 2;
        LAS float* qf = (LAS float*)(lds + 4096 + wid * 4096); LAS float* pl = qf + 256;
        LAS float* comb = (LAS float*)(lds + 36864) + wid * 264;
#pragma unroll
        for (int g = 0; g < 4; ++g) qf[g * 64 + lane] = QS[b * D + (4 * j + g) * 64 + lane];
        LDS_WAIT(); asm volatile("" ::: "memory");
        float s[2][4];
#pragma unroll
        for (int c2 = 0; c2 < 2; ++c2) {
            const int ri = rowi[half * 128 + lane + 64 * c2];
            const float* kp = (ri < 0) ? (knew + b * KVW + j * 64) : (ck + ((size_t)ri * NKV + j) * 64);
            float a[4] = {0.f, 0.f, 0.f, 0.f};
#pragma unroll
            for (int dq = 0; dq < 4; ++dq) {
#pragma unroll
                for (int d4 = 4 * dq; d4 < 4 * dq + 4; ++d4) {
                    const f32x4 kv = *(const f32x4*)(kp + 4 * d4);
#pragma unroll
                    for (int g = 0; g < 4; ++g) { const f32x4 qv = *(const LAS f32x4*)(qf + g * 64 + 4 * d4); a[g] += (kv.x * qv.x + kv.y * qv.y) + (kv.z * qv.z + kv.w * qv.w); }
                }
                asm volatile("" ::: "memory");
            }
#pragma unroll
            for (int g = 0; g < 4; ++g) s[c2][g] = a[g];
        }
        float mg[4], lg[4];
#pragma unroll
        for (int g = 0; g < 4; ++g) {
            mg[g] = wave_max(fmaxf(s[0][g], s[1][g]));
            const float p0 = __builtin_amdgcn_exp2f(s[0][g] - mg[g]), p1 = __builtin_amdgcn_exp2f(s[1][g] - mg[g]);
            pl[g * 128 + lane] = p0; pl[g * 128 + lane + 64] = p1;
            lg[g] = wave_sum(p0 + p1);
        }
        LDS_WAIT(); asm volatile("" ::: "memory");
        float o[4] = {0.f, 0.f, 0.f, 0.f};
        for (int s0 = 0; s0 < 128; s0 += 8) {
            float vv[8];
#pragma unroll
            for (int u = 0; u < 8; ++u) { const int ri = rowi[half * 128 + s0 + u]; const float* vp = (ri < 0) ? (vnew + b * KVW + j * 64) : (cv + ((size_t)ri * NKV + j) * 64); vv[u] = vp[lane]; }
#pragma unroll
            for (int u = 0; u < 8; ++u)
#pragma unroll
                for (int g = 0; g < 4; ++g) o[g] += pl[g * 128 + s0 + u] * vv[u];
        }
        if (lane < 4) { comb[lane] = (lane == 0) ? mg[0] : (lane == 1) ? mg[1] : (lane == 2) ? mg[2] : mg[3]; comb[4 + lane] = (lane == 0) ? lg[0] : (lane == 1) ? lg[1] : (lane == 2) ? lg[2] : lg[3]; }
#pragma unroll
        for (int g = 0; g < 4; ++g) comb[8 + g * 64 + lane] = o[g];
        __syncthreads();
        if (half == 0) {
            const LAS float* cb = comb + 4 * 264;
#pragma unroll
            for (int g = 0; g < 4; ++g) {
                const float ma = comb[g], mb = cb[g], mm = fmaxf(ma, mb); const float fa = __builtin_amdgcn_exp2f(ma - mm), fb = __builtin_amdgcn_exp2f(mb - mm);
                const float l = comb[4 + g] * fa + cb[4 + g] * fb; const float ov = comb[8 + g * 64 + lane] * fa + cb[8 + g * 64 + lane] * fb;
                OS[b * D + (4 * j + g) * 64 + lane] = (bf16)f2bf(ov / l);
            }
        }
    }
    __syncthreads();
}

namespace att {
using bf16=unsigned short;
using bf16x8=__attribute__((ext_vector_type(8)))short;
using s16x4=__attribute__((ext_vector_type(4)))short;
using f32x16=__attribute__((ext_vector_type(16)))float;
using u32x4=__attribute__((ext_vector_type(4)))unsigned;
constexpr int SEQ=4096,D=64,DM=1024,KVP=256;
constexpr int NW=8,QBLK=32,QB=QBLK*NW,KVBLK=64,QPU=64,NQB=SEQ/QPU;
__device__ __forceinline__ int crow(int r,int hi){return (r&3)+8*(r>>2)+4*hi;}
#define SBAR() __builtin_amdgcn_sched_barrier(0)
__device__ __forceinline__ void imask(f32x16&p0,f32x16&p1,unsigned wl,unsigned wh){
  #pragma unroll
  for(int r=0;r<16;++r){ const int c=(r&3)+8*(r>>2);
    const int m0=((int)(wl<<(31-c)))>>31, m1=((int)(wh<<(31-c)))>>31;
    p0[r]=__uint_as_float(((unsigned)m0&__float_as_uint(p0[r]))|(~(unsigned)m0&0xff800000u));
    p1[r]=__uint_as_float(((unsigned)m1&__float_as_uint(p1[r]))|(~(unsigned)m1&0xff800000u)); }
}

constexpr int NSLOT=3, SLOTB=8192;
constexpr int LDS_K=0, LDS_V=NSLOT*SLOTB, LDS_WS=2*NSLOT*SLOTB, LDS_OST=LDS_WS+NW*64*4, LDS_MR=LDS_OST+NW*4096, LDS_BYTES=LDS_MR+NW*NSLOT*256;
__device__ __forceinline__ void glds16(const void*gsrc,unsigned lds_dst){unsigned keep;
  asm volatile("s_mov_b32 %0, m0\n\ts_mov_b32 m0, %2\n\ts_nop 0\n\tglobal_load_lds_dwordx4 %1, off\n\ts_mov_b32 m0, %0":"=&s"(keep):"v"(gsrc),"s"(lds_dst):"memory");}
__device__ __forceinline__ void glds4(const void*gsrc,unsigned lds_dst){unsigned keep;
  asm volatile("s_mov_b32 %0, m0\n\ts_mov_b32 m0, %2\n\ts_nop 0\n\tglobal_load_lds_dword %1, off\n\ts_mov_b32 m0, %0":"=&s"(keep):"v"(gsrc),"s"(lds_dst):"memory");}
__device__ __forceinline__ float max3f(float a,float b,float c){float r;asm("v_max3_f32 %0, %1, %2, %3":"=v"(r):"v"(a),"v"(b),"v"(c));return r;}
__device__ __forceinline__ float max2f(float a,float b){float r;asm("v_max_f32_e32 %0, %1, %2":"=v"(r):"v"(a),"v"(b));return r;}
__device__ __forceinline__ float fadd_s(float a,float b){float r;asm("v_add_f32_e32 %0, %1, %2":"=v"(r):"v"(a),"v"(b));return r;}
__device__ __forceinline__ float fsub_s(float a,float b){float r;asm("v_sub_f32_e32 %0, %1, %2":"=v"(r):"v"(a),"v"(b));return r;}
typedef float f32x2_t __attribute__((ext_vector_type(2))); typedef __bf16 bf16x2_t __attribute__((ext_vector_type(2)));
__device__ __forceinline__ unsigned cvtpk_s(float lo,float hi){f32x2_t v={lo,hi};bf16x2_t b=__builtin_convertvector(v,bf16x2_t);return __builtin_bit_cast(unsigned,b);}
#define WAIT_BAR(N) asm volatile("s_waitcnt vmcnt(" #N ") lgkmcnt(0)\n\ts_barrier":::"memory")

__device__ __forceinline__ void qkt(f32x16&p0,f32x16&p1,const char*Kslot,const bf16x8*qr,const f32x16&negm,int r32,int hi){
  const char*kb=Kslot+hi*1024+r32*16;
  #pragma unroll
  for(int d0=0;d0<4;++d0){
    const bf16x8 b0=*reinterpret_cast<const bf16x8*>(kb+d0*2048);
    const bf16x8 b1=*reinterpret_cast<const bf16x8*>(kb+d0*2048+512);
    if(d0==0){p0=__builtin_amdgcn_mfma_f32_32x32x16_bf16(b0,qr[0],negm,0,0,0);p1=__builtin_amdgcn_mfma_f32_32x32x16_bf16(b1,qr[0],negm,0,0,0);}
    else{p0=__builtin_amdgcn_mfma_f32_32x32x16_bf16(b0,qr[d0],p0,0,0,0);p1=__builtin_amdgcn_mfma_f32_32x32x16_bf16(b1,qr[d0],p1,0,0,0);}}
}
typedef __attribute__((address_space(3))) const char* lds_cptr;
typedef short v4i16_t __attribute__((ext_vector_type(4)));
__device__ __forceinline__ void kload8(bf16x8*kf,lds_cptr kp){
  kf[0]=*(const __attribute__((address_space(3))) bf16x8*)(kp);      kf[1]=*(const __attribute__((address_space(3))) bf16x8*)(kp+512);
  kf[2]=*(const __attribute__((address_space(3))) bf16x8*)(kp+2048); kf[3]=*(const __attribute__((address_space(3))) bf16x8*)(kp+2560);
  kf[4]=*(const __attribute__((address_space(3))) bf16x8*)(kp+4096); kf[5]=*(const __attribute__((address_space(3))) bf16x8*)(kp+4608);
  kf[6]=*(const __attribute__((address_space(3))) bf16x8*)(kp+6144); kf[7]=*(const __attribute__((address_space(3))) bf16x8*)(kp+6656);
}
__device__ __forceinline__ void kload2(bf16x8*kf,lds_cptr kp,int j){ kf[2*j]=*(const __attribute__((address_space(3))) bf16x8*)(kp+j*2048); kf[2*j+1]=*(const __attribute__((address_space(3))) bf16x8*)(kp+j*2048+512); }
__device__ __forceinline__ s16x4 vtr(lds_cptr p){ return __builtin_bit_cast(s16x4,__builtin_amdgcn_ds_read_tr16_b64_v4i16((__attribute__((address_space(3))) v4i16_t*)p)); }
__device__ __forceinline__ float rowmax(const f32x16&p0,const f32x16&p1){
  float a=max3f(p0[0],p0[1],p1[0]),b=max3f(p0[2],p0[3],p1[1]);a=max3f(a,p1[2],p1[3]);
  #pragma unroll
  for(int r=4;r<16;r+=4){a=max3f(a,p0[r],p0[r+1]);b=max3f(b,p0[r+2],p0[r+3]);a=max3f(a,p1[r],p1[r+1]);b=max3f(b,p1[r+2],p1[r+3]);}
  const float m=max2f(a,b);
  auto rr=__builtin_amdgcn_permlane32_swap(__float_as_uint(m),__float_as_uint(m),false,false);
  return max2f(__uint_as_float(rr[0]),__uint_as_float(rr[1]));
}
__device__ __forceinline__ void pv(f32x16*o,int vb,bf16x8 pa0,bf16x8 pa1,bf16x8 pa2,bf16x8 pa3){
  #pragma unroll
  for(int d0=0;d0<2;++d0){s16x4 lo[4],hi[4];
    #pragma unroll
    for(int ks=0;ks<4;++ks){
      asm volatile("ds_read_b64_tr_b16 %0,%1 offset:%c2":"=&v"(lo[ks]):"v"(vb),"i"(d0*4096+ks*1024):"memory");
      asm volatile("ds_read_b64_tr_b16 %0,%1 offset:%c2":"=&v"(hi[ks]):"v"(vb),"i"(d0*4096+ks*1024+512):"memory");}
    asm volatile("s_waitcnt lgkmcnt(0)":::"memory");SBAR();
    #define PK(k) (bf16x8){lo[k][0],lo[k][1],lo[k][2],lo[k][3],hi[k][0],hi[k][1],hi[k][2],hi[k][3]}
    o[d0]=__builtin_amdgcn_mfma_f32_32x32x16_bf16(pa0,PK(0),o[d0],0,0,0);
    o[d0]=__builtin_amdgcn_mfma_f32_32x32x16_bf16(pa1,PK(1),o[d0],0,0,0);
    o[d0]=__builtin_amdgcn_mfma_f32_32x32x16_bf16(pa2,PK(2),o[d0],0,0,0);
    o[d0]=__builtin_amdgcn_mfma_f32_32x32x16_bf16(pa3,PK(3),o[d0],0,0,0);
    #undef PK
  }
}

__device__ __forceinline__ unsigned short f2bf_s(float x){ return (unsigned short)(cvtpk_s(x,x)&0xffffu); }
#ifndef ATTN_STORE16
#define ATTN_STORE16(p,v) (*(u32x4*)(p)=(v))
#endif
template<int THRL> __device__ __forceinline__ void attn_unit(int b,int j,int qb,const bf16*Q,const bf16*__restrict__ K,const bf16*__restrict__ V,const unsigned*__restrict__ MASKW,bf16*O,char*shm,int tid){
  const int lane=tid&63,r32=lane&31,hi=lane>>5; const int wid=__builtin_amdgcn_readfirstlane(tid>>6);
  const long rowbase=(long)b*SEQ; const int q0=qb*QPU;
  const bf16*Qw=Q+(rowbase+q0+wid*8)*DM+(4*j)*D;
  const bf16*Kh=K+rowbase*KVP+j*D,*Vh=V+rowbase*KVP+j*D;
  const unsigned lds0=(unsigned)(uintptr_t)shm;
  float*wsf=(float*)(shm+LDS_WS)+wid*64;
  const bf16*ksrc=Kh+(long)lane*KVP+wid*8;
  const bf16*vsrc=Vh+(long)(16*(wid&3)+(lane>>2))*KVP+(wid>>2)*32+(lane&3)*8;
  const unsigned*msrc=MASKW+(rowbase+q0+wid*8+((lane&15)>>1))*128+(lane&1);
  const unsigned kdst=lds0+LDS_K+wid*1024, vdst=lds0+LDS_V+wid*1024, mdst=lds0+LDS_MR+wid*(NSLOT*256);
  const int NT0=qb+1; int NT=(NT0+1)&~1; if(NT<4)NT=4;
  const int TL=NT-1;
  #define CL(t) (((t)<TL)?(t):TL)
  #define DMA_K(t,slot) glds16(ksrc+(long)CL(t)*KVBLK*KVP,(unsigned)__builtin_amdgcn_readfirstlane(kdst+(slot)))
  #define DMA_V(t,slot) glds16(vsrc+(long)CL(t)*KVBLK*KVP,(unsigned)__builtin_amdgcn_readfirstlane(vdst+(slot)))
  #define DMA_M(t,mslot) glds4(msrc+2*CL(t),(unsigned)__builtin_amdgcn_readfirstlane(mdst+(mslot)))
  const int vb0=(int)(lds0+LDS_V)+((lane>>4)&1)*32+(lane&3)*8+(4*hi+((lane&15)>>2))*64;
  const char*Kbase=shm+LDS_K; bf16x8 kf[8];
  const lds_cptr shm3=(lds_cptr)shm; const lds_cptr kp0=shm3+LDS_K+hi*1024+r32*16; const lds_cptr vp0=shm3+LDS_V+((lane>>4)&1)*32+(lane&3)*8+(4*hi+((lane&15)>>2))*64;
  const lds_cptr mp0=shm3+LDS_MR+wid*(NSLOT*256)+(r32>>2)*8;
  const unsigned sh4=4u*(unsigned)hi;
  DMA_K(0,0);DMA_M(0,0);DMA_V(0,0);DMA_K(1,SLOTB);DMA_M(1,256);
  bf16x8 qr[4];
  #pragma unroll
  for(int d0=0;d0<4;++d0)qr[d0]=*reinterpret_cast<const bf16x8*>(&Qw[(long)(r32>>2)*DM+(r32&3)*D+d0*16+hi*8]);
  float mhat=0.f,l_reg=0.f; float z_=0.f; asm volatile("":"+v"(z_));
  f32x16 o[2],negm;
  #pragma unroll
  for(int r=0;r<16;++r){o[0][r]=z_;o[1][r]=z_;negm[r]=z_;}
  typedef unsigned u32x2_t __attribute__((ext_vector_type(2)));
  #define CMASK(P0,P1,ms) do{ const u32x2_t mw_=*(const __attribute__((address_space(3))) u32x2_t*)(mp0+(ms)); imask(P0,P1,mw_[0]>>sh4,mw_[1]>>sh4); }while(0)
  bool resc=false;
  #define START(P0,P1) do{ const float rm=rowmax(P0,P1); resc=false; \
    { const float dl=__builtin_fmaxf(rm,-1024.f); mhat=fadd_s(mhat,dl); \
      _Pragma("unroll") for(int r=0;r<16;++r){P0[r]=fsub_s(P0[r],dl);P1[r]=fsub_s(P1[r],dl);} \
      _Pragma("unroll") for(int r=0;r<16;++r)negm[r]=-mhat; asm volatile("":"+v"(negm)); } \
    _Pragma("unroll") for(int r=0;r<16;++r)P0[r]=__builtin_amdgcn_exp2f(P0[r]); }while(0)
  #define RESC() do{ if(resc){ asm volatile("s_waitcnt lgkmcnt(0)":::"memory"); \
      _Pragma("unroll") for(int d_=0;d_<2;++d_) _Pragma("unroll") for(int r=0;r<16;++r)o[d_][r]*=wsf[crow(r,hi)]; } }while(0)
  f32x16 pA0,pA1,pB0,pB1;
  int sl_prev=0,sl_cur=0,sl_next=SLOTB;
  int ms_cur=0,ms_next=256,ms_nn=512;
  #define ROT() do{sl_prev=sl_cur;sl_cur=sl_next;sl_next=(sl_next==(NSLOT-1)*SLOTB)?0:sl_next+SLOTB; const int m_=ms_cur; ms_cur=ms_next; ms_next=ms_nn; ms_nn=m_;}while(0)
  DMA_K(2,2*SLOTB);
  WAIT_BAR(4);
  qkt(pA0,pA1,Kbase,qr,negm,r32,hi);asm volatile("s_nop 15\n\ts_nop 7":"+v"(pA0),"+v"(pA1));CMASK(pA0,pA1,ms_cur);
  START(pA0,pA1);
  _Pragma("unroll") for(int r=0;r<16;++r)pA1[r]=__builtin_amdgcn_exp2f(pA1[r]);
  WAIT_BAR(0);
  DMA_K(3,0);DMA_V(1,SLOTB);DMA_M(2,512);
  ROT();
  kload8(kf,kp0+sl_cur);
  WAIT_BAR(3);
  s16x4 vlo[8],vhi[8]; u32x4 pw0,pw1,pw2,pw3;
  #define PKW(P,B) cvtpk_s(P[B],P[B+1])
  #define PAF(k) __builtin_bit_cast(bf16x8,pw##k)
  #define VFR(i) (bf16x8){vlo[i][0],vlo[i][1],vlo[i][2],vlo[i][3],vhi[i][0],vhi[i][1],vhi[i][2],vhi[i][3]}
  #define PIN(x) asm volatile("":"+v"(x))
  #define MX3(a,b,c) __builtin_fmaxf(__builtin_fmaxf((a),(b)),(c))
  #define GAPA(MF,A0,A1,A2,A3,W0,W1,PW) do{ MF; sacc+=A0; sacc+=A1; sacc+=A2; sacc+=A3; PIN(sacc); W0; W1; PIN(PW); SBAR(); }while(0)
  #define EX(v) __builtin_amdgcn_exp2f(v)
  #define GAPB(MF,X,B) do{ MF; X[B]=EX(X[B]); X[B+1]=EX(X[B+1]); X[B+2]=EX(X[B+2]); X[B+3]=EX(X[B+3]); PIN(X); SBAR(); }while(0)
  #define VRD(i) do{ vlo[i]=vtr(vp_+(((i)>>2)*4096+((i)&3)*1024)); vhi[i]=vtr(vp_+(((i)>>2)*4096+((i)&3)*1024+512)); }while(0)
  #define KRD(jj) do{ kload2(kf,kp0+sl_next,jj); SBAR(); }while(0)
  #define STEP(C0,C1,P0,P1,t) do{ SBAR(); \
    const lds_cptr vp_=vp0+sl_prev; \
    VRD(0); SBAR(); float sacc=(P0[0]+P0[1]); \
    GAPA(C0=__builtin_amdgcn_mfma_f32_32x32x16_bf16(kf[0],qr[0],negm,0,0,0), P0[2],P0[3],P0[4],P0[5],     pw0[0]=PKW(P0,0), pw0[1]=PKW(P0,2), pw0); \
    VRD(4); SBAR(); GAPA(C1=__builtin_amdgcn_mfma_f32_32x32x16_bf16(kf[1],qr[0],negm,0,0,0), P0[6],P0[7],P0[8],P0[9],     pw0[2]=PKW(P0,4), pw0[3]=PKW(P0,6), pw0); \
    VRD(1); SBAR(); GAPA(C0=__builtin_amdgcn_mfma_f32_32x32x16_bf16(kf[2],qr[1],C0,0,0,0),   P0[10],P0[11],P0[12],P0[13], pw1[0]=PKW(P0,8), pw1[1]=PKW(P0,10), pw1); \
    VRD(5); SBAR(); GAPA(C1=__builtin_amdgcn_mfma_f32_32x32x16_bf16(kf[3],qr[1],C1,0,0,0),   P0[14],P0[15],P1[0],P1[1],   pw1[2]=PKW(P0,12),pw1[3]=PKW(P0,14), pw1); \
    VRD(2); SBAR(); GAPA(C0=__builtin_amdgcn_mfma_f32_32x32x16_bf16(kf[4],qr[2],C0,0,0,0),   P1[2],P1[3],P1[4],P1[5],     pw2[0]=PKW(P1,0), pw2[1]=PKW(P1,2), pw2); \
    VRD(6); SBAR(); GAPA(C1=__builtin_amdgcn_mfma_f32_32x32x16_bf16(kf[5],qr[2],C1,0,0,0),   P1[6],P1[7],P1[8],P1[9],     pw2[2]=PKW(P1,4), pw2[3]=PKW(P1,6), pw2); \
    VRD(3); SBAR(); GAPA(C0=__builtin_amdgcn_mfma_f32_32x32x16_bf16(kf[6],qr[3],C0,0,0,0),   P1[10],P1[11],P1[12],P1[13], pw3[0]=PKW(P1,8), pw3[1]=PKW(P1,10), pw3); \
    VRD(7); SBAR(); GAPA(C1=__builtin_amdgcn_mfma_f32_32x32x16_bf16(kf[7],qr[3],C1,0,0,0),   P1[14],P1[15],0.f,0.f,       pw3[2]=PKW(P1,12),pw3[3]=PKW(P1,14), pw3); \
    l_reg+=sacc; \
    DMA_K((t)+3,sl_cur); DMA_V((t)+1,sl_next); DMA_M((t)+2,ms_nn); \
    CMASK(C0,C1,ms_cur); \
    { float a=MX3(C0[0],C0[1],C1[0]),b_=MX3(C0[2],C0[3],C1[1]); a=MX3(a,C1[2],C1[3]); \
      _Pragma("unroll") for(int r=4;r<16;r+=4){a=MX3(a,C0[r],C0[r+1]);b_=MX3(b_,C0[r+2],C0[r+3]);a=MX3(a,C1[r],C1[r+1]);b_=MX3(b_,C1[r+2],C1[r+3]);} \
      float rm=__builtin_fmaxf(a,b_); { auto rr=__builtin_amdgcn_permlane32_swap(__float_as_uint(rm),__float_as_uint(rm),false,false); rm=__builtin_fmaxf(__uint_as_float(rr[0]),__uint_as_float(rr[1])); } \
      resc=false; \
      if(__builtin_expect(__any(rm>(float)THRL),0)){ const float dl=__builtin_fmaxf(rm,0.f); mhat+=dl; \
        _Pragma("unroll") for(int r=0;r<16;++r){C0[r]-=dl;C1[r]-=dl;} \
        _Pragma("unroll") for(int r=0;r<16;++r)negm[r]=-mhat; asm volatile("":"+v"(negm)); \
        const float f=__builtin_amdgcn_exp2f(-dl); l_reg*=f; if(hi==0)wsf[r32]=f; resc=true; } } \
    SBAR(); \
    GAPB(o[0]=__builtin_amdgcn_mfma_f32_32x32x16_bf16(PAF(0),VFR(0),o[0],0,0,0), C0,0); \
    GAPB(o[1]=__builtin_amdgcn_mfma_f32_32x32x16_bf16(PAF(0),VFR(4),o[1],0,0,0), C0,4); \
    KRD(0); GAPB(o[0]=__builtin_amdgcn_mfma_f32_32x32x16_bf16(PAF(1),VFR(1),o[0],0,0,0), C0,8); \
    KRD(1); GAPB(o[1]=__builtin_amdgcn_mfma_f32_32x32x16_bf16(PAF(1),VFR(5),o[1],0,0,0), C0,12); \
    KRD(2); GAPB(o[0]=__builtin_amdgcn_mfma_f32_32x32x16_bf16(PAF(2),VFR(2),o[0],0,0,0), C1,0); \
    KRD(3); GAPB(o[1]=__builtin_amdgcn_mfma_f32_32x32x16_bf16(PAF(2),VFR(6),o[1],0,0,0), C1,4); \
    GAPB(o[0]=__builtin_amdgcn_mfma_f32_32x32x16_bf16(PAF(3),VFR(3),o[0],0,0,0), C1,8); \
    GAPB(o[1]=__builtin_amdgcn_mfma_f32_32x32x16_bf16(PAF(3),VFR(7),o[1],0,0,0), C1,12); \
    }while(0)
  int t=1;
  for(;t+1<NT;t+=2){
    STEP(pB0,pB1,pA0,pA1,t);     WAIT_BAR(3); RESC(); ROT();
    STEP(pA0,pA1,pB0,pB1,t+1);   WAIT_BAR(3); RESC(); ROT();
  }
  STEP(pB0,pB1,pA0,pA1,NT-1); WAIT_BAR(0); RESC();
  { float sacc=pB0[0]+pB0[1]; _Pragma("unroll") for(int r=2;r<16;++r)sacc+=pB0[r]; _Pragma("unroll") for(int r=0;r<16;++r)sacc+=pB1[r]; l_reg+=sacc;
    pw0=(u32x4){PKW(pB0,0),PKW(pB0,2),PKW(pB0,4),PKW(pB0,6)};pw1=(u32x4){PKW(pB0,8),PKW(pB0,10),PKW(pB0,12),PKW(pB0,14)};pw2=(u32x4){PKW(pB1,0),PKW(pB1,2),PKW(pB1,4),PKW(pB1,6)};pw3=(u32x4){PKW(pB1,8),PKW(pB1,10),PKW(pB1,12),PKW(pB1,14)};
    SBAR(); pv(o,vb0+sl_cur,PAF(0),PAF(1),PAF(2),PAF(3)); }
  #undef PKW
  #undef PAF
  #undef VFR
  #undef PIN
  #undef MX3
  #undef GAPA
  #undef GAPB
  #undef EX
  #undef VRD
  #undef KRD
  #undef STEP
  {auto rr=__builtin_amdgcn_permlane32_swap(__float_as_uint(l_reg),__float_as_uint(l_reg),false,false);l_reg=__uint_as_float(rr[0])+__uint_as_float(rr[1]);}
  if(hi==0)wsf[32+r32]=l_reg;asm volatile("s_waitcnt lgkmcnt(0)":::"memory");
  float rli[16];
  #pragma unroll
  for(int r=0;r<16;++r)rli[r]=__builtin_amdgcn_rcpf(wsf[32+crow(r,hi)]);
  bf16*Ow=O+(rowbase+q0+wid*8)*DM+(4*j)*D;
  { bf16*stg=(bf16*)(shm+LDS_OST)+wid*2048;
    #pragma unroll
    for(int r=0;r<16;++r){const int orow=crow(r,hi);
      #pragma unroll
      for(int d0=0;d0<2;++d0)stg[orow*64+d0*32+r32]=(bf16)f2bf_s(o[d0][r]*rli[r]);}
    asm volatile("s_waitcnt lgkmcnt(0)":::"memory");
    #pragma unroll
    for(int i=0;i<4;++i){const int row=i*8+(lane>>3),ch=lane&7; const u32x4 v=*(const u32x4*)(stg+row*64+ch*8); ATTN_STORE16(Ow+(long)(row>>2)*DM+(row&3)*D+ch*8,v);} }
  asm volatile("s_waitcnt vmcnt(0) lgkmcnt(0)\n\ts_barrier":::"memory");
  #undef DMA_K
  #undef DMA_V
  #undef DMA_M
  #undef CL
  #undef CMASK
  #undef START
  #undef RESC
  #undef ROT
}
__device__ __forceinline__ void attn_phase_masked(char*lds,const bf16*Q,const bf16*K,const bf16*V,const unsigned*MASKW,bf16*O,int grid,int block,int tid){
  if(grid==256){
    const int vcu=(block&7)*32+(block>>3); const int bh=vcu>>3, s=vcu&7;
    for(int i=0;i<8;++i){ const int p=s+8*(i>>1); const int qb=(i&1)?(63-p):p; attn_unit<8>(bh>>2,bh&3,qb,Q,K,V,MASKW,O,lds,tid); }
  } else {
    for(int u=block;u<2048;u+=grid){ const int bh=u>>6, x=u&63; const int qb=(x&1)?(63-(x>>1)):(x>>1); attn_unit<8>(bh>>2,bh&3,qb,Q,K,V,MASKW,O,lds,tid); }
  }
}
#undef SBAR
#undef WAIT_BAR
}

#define RELAUNDER() (({ asm volatile("" : "+s"(pa)); G = G0; wg = wg0; asm volatile("" : "+s"(G), "+s"(wg)); gw = wg * NWAVES + wave; NGW = G * NWAVES; asm volatile("v_mbcnt_lo_u32_b32 %0, -1, 0\n\tv_mbcnt_hi_u32_b32 %0, -1, %0" : "=v"(lane)); tid = wave * 64 + lane; }), true)
struct Args { const void* in[17]; float* out; unsigned char* ws; int ph_lo, ph_hi; };
constexpr int N_PHASES = 21;

__global__ void __launch_bounds__(NTHREADS, 2) fwd(Args args) {
    extern __shared__ __attribute__((aligned(16))) unsigned char lds_raw[];
    LAS unsigned char* lds = (LAS unsigned char*)lds_raw;
#define MISC ((volatile LAS unsigned*)(lds + MISC_OFF))
    int wave = __builtin_amdgcn_readfirstlane((int)threadIdx.x >> 6); asm volatile("" : "+s"(wave));
    int lane, tid; asm volatile("v_mbcnt_lo_u32_b32 %0, -1, 0\n\tv_mbcnt_hi_u32_b32 %0, -1, %0" : "=v"(lane)); tid = wave * 64 + lane;
    const int G0 = gridDim.x, wg0 = blockIdx.x;
    int G = G0, wg = wg0, gw = wg * NWAVES + wave, NGW = G * NWAVES;
    typedef __attribute__((address_space(4))) const Args* kargs_t;
    kargs_t pa = (kargs_t)__builtin_amdgcn_kernarg_segment_ptr();
#define ws (pa->ws)
#define out (pa->out)
#define x_prompt ((const float*)pa->in[0])
#define x_sample ((const float*)pa->in[1])
#define cache_k ((const float*)pa->in[2])
#define cache_v ((const float*)pa->in[3])
#define cache_kidx ((const float*)pa->in[4])
#define state_pool ((const float*)pa->in[5])
#define page_table ((const int*)pa->in[6])
#define ln_g ((const float*)pa->in[7])
#define ln_b ((const float*)pa->in[8])
#define ffn1_wi ((const float*)pa->in[9])
#define ffn1_wo ((const float*)pa->in[10])
#define ffn2_wi ((const float*)pa->in[11])
#define ffn2_wo ((const float*)pa->in[12])
#define attn_w_in ((const float*)pa->in[13])
#define attn_w_o ((const float*)pa->in[14])
#define pool_w ((const float*)pa->in[15])
#define pool_scale ((const float*)pa->in[16])
#define W_WI ((bf16*)(ws + WS_WI))
#define W_WO ((bf16*)(ws + WS_WO))
#define W_IN ((bf16*)(ws + WS_WIN))
#define W_OA ((bf16*)(ws + WS_WOA))
#define W_POOL ((bf16*)(ws + WS_WPOOL))
#define ROPE ((f32x2*)(ws + WS_ROPE))
#define XB ((bf16*)(ws + WS_XB))
#define XA ((float*)(ws + WS_XA))
#define PRE ((float*)(ws + WS_PRE))
#define GB ((bf16*)(ws + WS_G))
#define QB ((bf16*)(ws + WS_QB))
#define OB ((bf16*)(ws + WS_OB))
#define KB ((bf16*)(ws + WS_KB))
#define VB ((bf16*)(ws + WS_VB))
#define QIB ((bf16*)(ws + WS_QIB))
#define KIB ((bf16*)(ws + WS_KIB))
#define WIF ((float*)(ws + WS_WIF))
#define MASK ((unsigned*)(ws + WS_MASK))
#define LIST ((unsigned short*)(ws + WS_LIST))
#define DB ((bf16*)(ws + WS_DB))
#define XS ((float*)(ws + WS_S + S_XS))
#define PRES ((float*)(ws + WS_S + S_PRES))
#define XSB ((bf16*)(ws + WS_S + S_XSB))
#define GS ((bf16*)(ws + WS_S + S_GS))
#define QS ((float*)(ws + WS_S + S_QS))
#define QIS ((float*)(ws + WS_S + S_QIS))
#define WIS ((float*)(ws + WS_S + S_WIS))
#define OS ((bf16*)(ws + WS_S + S_OS))
#define DS ((bf16*)(ws + WS_S + S_DS))
#define SC ((float*)(ws + WS_S + S_SC))
    for (int u = tid; u < 64; u += NTHREADS) MISC[u] = 0u;
    __syncthreads();
    const int lo = pa->ph_lo, hi = pa->ph_hi;
    if (hi - lo > 1) (void)xcd_barrier_post((unsigned*)(ws + WS_CTL) + CW_BAR, MISC + 8, tid);
    int ph = 0;
#define LAUNDER_V(x) asm volatile("" : "+v"(x))
#define LAUNDER_S(x) asm volatile("" : "+s"(x))
#ifndef SITEMASK
#define SITEMASK 0xFFFFFFFFu
#endif
#ifndef DUPMASK
#define DUPMASK 0u
#endif
#define PH_ON(k) (RELAUNDER() && ((SITEMASK >> (k)) & 1u) && ph >= lo && ph < hi)
#define REP(k) for (int rep_ = 0; rep_ < 1 + (int)((DUPMASK >> (k)) & 1u); ++rep_)
#define PH_END do { if (ph >= lo && ph + 1 < hi) { RELAUNDER(); XcdBarrier bar_; bar_.bar = (unsigned*)(ws + WS_CTL) + CW_BAR; bar_.x = xb_xcc_id(); bar_.st = (volatile LAS unsigned*)(lds + MISC_OFF) + 8; xcd_barrier(bar_, tid); } ++ph; } while (0)
    LAS float* redS = (LAS float*)(lds + RING_OFF);

    if (PH_ON(0)) REP(0) {
        LAS float* scr = (LAS float*)(lds + RING_OFF + wave * 16384);
        constexpr int I_WI = 16 * 176, I_WO = 44 * 32, I_IN = 16 * 72, I_OA = 16 * 32, I_PL = 4 * 8;
        constexpr int NIT = 4 * I_WI + 4 * I_WO + I_IN + I_OA + 4 * I_PL;
        for (int it = gw; it < NIT; it += NGW) {
            int r = it;
            if (r < 4 * I_WI) { const int mi = r / I_WI; r -= mi * I_WI; const int kb = r / 176, nb = r % 176; const int n0 = nb * 32, pn = n0 >> 8, i = n0 & 255;
                const int c0 = (i < 128) ? (128 * pn + i) : (FF + 128 * pn + (i - 128));
                tr_item(((mi & 1) ? ffn2_wi : ffn1_wi) + (size_t)(mi >> 1) * D * NWI, NWI, kb * 64, c0, 32, (bf16*)((unsigned char*)W_WI + (size_t)mi * WI_STRIDE), D, n0, scr, lane); continue; }
            r -= 4 * I_WI;
            if (r < 4 * I_WO) { const int mi = r / I_WO; r -= mi * I_WO; const int kb = r / 32, nb = r % 32;
                tr_item(((mi & 1) ? ffn2_wo : ffn1_wo) + (size_t)(mi >> 1) * FF * D, D, kb * 64, nb * 32, 32, (bf16*)((unsigned char*)W_WO + (size_t)mi * WO_STRIDE), FF, nb * 32, scr, lane); continue; }
            r -= 4 * I_WO;
            if (r < I_IN) { const int kb = r / 72, nb = r % 72; const int ncv = NPROJ - nb * 32;
                tr_item(attn_w_in, NPROJ, kb * 64, (ncv > 0) ? nb * 32 : 0, ncv, W_IN, D, nb * 32, scr, lane); continue; }
            r -= I_IN;
            if (r < I_OA) { const int kb = r / 32, nb = r % 32; tr_item(attn_w_o, D, kb * 64, nb * 32, 32, W_OA, D, nb * 32, scr, lane); continue; }
            r -= I_OA;
            { const int g = r / I_PL; r -= g * I_PL; const int kb = r / 8, nb = r % 8; tr_item(pool_w + (size_t)g * 65536, 256, kb * 64, nb * 32, 32, W_POOL, 256, g * 256 + nb * 32, scr, lane); }
        }
        for (size_t i = (size_t)wg * NTHREADS + tid; i < (size_t)(M + SBT) * D / 8; i += (size_t)G * NTHREADS) {
            const float* src = (i < (size_t)M * D / 8) ? x_prompt + i * 8 : x_sample + (i - (size_t)M * D / 8) * 8;
            bf16* dst = (i < (size_t)M * D / 8) ? XB + i * 8 : XSB + (i - (size_t)M * D / 8) * 8;
            const f32x4 a = *(const f32x4*)src, c = *(const f32x4*)(src + 4);
            v4u o; o.x = pk2(a.x, a.y); o.y = pk2(a.z, a.w); o.z = pk2(c.x, c.y); o.w = pk2(c.z, c.w); *(v4u*)dst = o;
        }
        for (int i = wg * NTHREADS + tid; i < 4097 * 8; i += G * NTHREADS) {
            const int p = i >> 3, f = i & 7; const float pos = (p < 4096) ? (float)p : (float)PAST;
            const float freq = (float)pow(500000.0, -(double)f / 8.0);
            const float ang = pos * freq;
            f32x2 cs; cs.x = (float)cos((double)ang); cs.y = (float)sin((double)ang); ROPE[i] = cs;
        }
    }
    PH_END;

    for (int f = 0; f < 4; ++f) {
        const int layer = f >> 1, which = f & 1;
        const bf16* Wi = (const bf16*)((const unsigned char*)W_WI + (size_t)(layer * 2 + which) * WI_STRIDE);
        const bf16* Wo = (const bf16*)((const unsigned char*)W_WO + (size_t)(layer * 2 + which) * WO_STRIDE);
        const float* Xres = (f == 0) ? x_prompt : XA;
        const float* XSres = (f == 0) ? x_sample : XS;
        const int lni = which ? 2 : 0;
        if (PH_ON(1)) REP(1) {
            { SDescG1 dsc{GS}; sgemm32<2>(XSB, D, Wi, D, D, 88, wg, G, redS, tid, dsc); }
            pg8::Gemm g{XB, Wi, D, D, D, 0}; pg8::StaticOrder S; S.init(M, NWI, G, wg);
            pg8::EpiSwiglu E{GB};
            pg8::gemm_phase<pg8::EpiSwiglu, pg8::StaticOrder, true, true>(lds + RING_OFF, g, S, E, tid);
        }
        PH_END;
        if (PH_ON(2)) REP(2) {
            { SDescResid dsc{XSres, PRES, 0.5f, nullptr, 0}; sgemm32<1>(GS, FF, Wo, FF, FF, 32, wg, G, redS, tid, dsc); }
            pg8::Gemm g{GB, Wo, FF, FF, FF, 0}; pg8::StaticOrder S; S.init(M, D, G, wg);
            pg8::EpiResid<false> E{Xres, PRE, 0.5f, nullptr};
            pg8::gemm_phase<pg8::EpiResid<false>, pg8::StaticOrder, true, true>(lds + RING_OFF, g, S, E, tid);
        }
        PH_END;
        if (PH_ON(3)) REP(3) {
            ln_phase<4>(ws, out, ln_g + (layer * 3 + lni) * D, ln_b + (layer * 3 + lni) * D, f == 3, f == 2, gw, NGW, lane);
        }
        PH_END;
        if (f == 0) {
            if (PH_ON(4)) REP(4) {
                { SDescProj dsc{QS, QIS, WIS, out + O_KS, out + O_VS, out + O_KIS, ROPE + 4096 * 8}; sgemm32<1>(XSB, D, W_IN, D, D, 67, wg, G, redS, tid, dsc); }
                pg8::Gemm g{XB, W_IN, D, D, D, 0}; pg8::StaticOrder S; S.init(M, NPROJP, G, wg);
                pg8::EpiProj E{ws, out};
                pg8::gemm_phase<pg8::EpiProj, pg8::StaticOrder, true, true>(lds + RING_OFF, g, S, E, tid);
            }
            PH_END;
            if (PH_ON(5)) REP(5) {
                sample_scores_phase(QIS, WIS, cache_kidx, out + O_KIS, page_table, SC, lds + RING_OFF, wg, G, tid);
                __syncthreads();
                index_select_phase(QIB, KIB, WIF, MASK, (LAS float*)(lds + RING_OFF), wg, G, tid);
            }
            PH_END;
            if (PH_ON(6)) REP(6) {
                if (wg < SBT) sample_select_attend(wg, SC, QS, cache_k, cache_v, out + O_KS, out + O_VS, page_table, OS, lds + RING_OFF, tid);
                __syncthreads();
                att::attn_phase_masked((char*)lds_raw + RING_OFF, QB, KB, VB, MASK, OB, G, wg, tid);
            }
            PH_END;
            if (PH_ON(7)) REP(7) {
                { SDescResid dsc{XS, PRES, 1.0f, nullptr, 0}; sgemm32<1>(OS, D, W_OA, D, D, 32, wg, G, redS, tid, dsc); }
                pg8::Gemm g{OB, W_OA, D, D, D, 0}; pg8::StaticOrder S; S.init(M, D, G, wg);
                pg8::EpiResid<false> E{XA, PRE, 1.0f, nullptr};
                pg8::gemm_phase<pg8::EpiResid<false>, pg8::StaticOrder, true, true>(lds + RING_OFF, g, S, E, tid);
            }
            PH_END;
            if (PH_ON(8)) REP(8) {
                ln_phase<4>(ws, out, ln_g + 1 * D, ln_b + 1 * D, false, false, gw, NGW, lane);
            }
            PH_END;
        }
        if (f == 2) {
            if (PH_ON(9)) REP(9) {
                for (int it = wg * NTHREADS + tid; it < (M / 64) * 256; it += G * NTHREADS) {
                    const int seg = it >> 8, c4 = it & 255, grp = c4 >> 6;
                    if (grp == 0) pool_seg<2>(XA, DB, seg * 64, 4 * c4);
                    else if (grp == 1) pool_seg<4>(XA, DB, seg * 64, 4 * c4);
                    else if (grp == 2) pool_seg<8>(XA, DB, seg * 64, 4 * c4);
                    else pool_seg<16>(XA, DB, seg * 64, 4 * c4);
                }
                for (int it = wg * NTHREADS + tid; it < SBT * 256; it += G * NTHREADS) {
                    const int b = it >> 8, c4 = it & 255, col = 4 * c4; const int w = 2 << (c4 >> 6);
                    const f32x4 xt = *(const f32x4*)(XS + b * D + col); f32x4 sum = xt;
                    for (int r = 1; r < w; ++r) sum = sum + *(const f32x4*)(state_pool + ((size_t)b * 15 + (15 - r)) * D + col);
                    const f32x4 d = sum * (1.0f / (float)w) - xt;
                    v2u o; o.x = pk2(d.x, d.y); o.y = pk2(d.z, d.w); *(v2u*)(DS + b * D + col) = o;
                }
                for (int it = wg * NTHREADS + tid; it < SBT * 14 * 256; it += G * NTHREADS) {
                    const int b = it / (14 * 256), rem = it % (14 * 256), r = rem >> 8, c4 = rem & 255;
                    *(f32x4*)(out + O_PS + ((size_t)b * 15 + r) * D + 4 * c4) = *(const f32x4*)(state_pool + ((size_t)b * 15 + r + 1) * D + 4 * c4);
                }
            }
            PH_END;
            if (PH_ON(10)) REP(10) {
                { SDescResid dsc{XS, PRES, 1.0f, pool_scale, 1}; sgemm32<1>(DS, D, W_POOL, 256, 256, 32, wg, G, redS, tid, dsc); }
                pg8::Gemm g{DB, W_POOL, D, 256, 256, 512}; pg8::StaticOrder S; S.init(M, D, G, wg);
                pg8::EpiResid<true> E{XA, PRE, 1.0f, pool_scale};
                pg8::gemm_phase<pg8::EpiResid<true>, pg8::StaticOrder, true, true>(lds + RING_OFF, g, S, E, tid);
            }
            PH_END;
            if (PH_ON(11)) REP(11) {
                ln_phase<4>(ws, out, ln_g + 4 * D, ln_b + 4 * D, false, false, gw, NGW, lane);
            }
            PH_END;
        }
    }
#undef PH_ON
#undef PH_END
#undef ws
#undef out
#undef MISC
}

extern "C" void kernel_launch(void* const* d_in, const int* in_sizes, int n_in, void* d_out, int out_size, void* d_ws, size_t ws_size, hipStream_t stream) {
    static int grid = 0;
    if (grid == 0) {
        if (n_in != 17 || out_size != (int)O_END || ws_size < WS_END) { fprintf(stderr, "kernel_launch: unexpected sizes n_in %d out %d ws %zu\n", n_in, out_size, ws_size); grid = -1; return; }
        int dev = 0, cus = 0, per_cu = 0;
        if (hipGetDevice(&dev) != hipSuccess || hipDeviceGetAttribute(&cus, hipDeviceAttributeMultiprocessorCount, dev) != hipSuccess) { grid = -1; return; }
        if (hipFuncSetAttribute((const void*)fwd, hipFuncAttributeMaxDynamicSharedMemorySize, LDS_BYTES) != hipSuccess) { fprintf(stderr, "kernel_launch: hipFuncSetAttribute failed\n"); grid = -1; return; }
        if (hipOccupancyMaxActiveBlocksPerMultiprocessor(&per_cu, (const void*)fwd, NTHREADS, LDS_BYTES) != hipSuccess || per_cu < 1)
            fprintf(stderr, "kernel_launch: note: occupancy query reports %d workgroups per CU\n", per_cu);
        (void)hipGetLastError();
        grid = cus;
    }
    if (grid < 0) return;
    (void)hipMemsetAsync((char*)d_ws + WS_CTL, 0, CTL_ZERO_BYTES, stream);
    Args a{};
    for (int i = 0; i < 17; ++i) a.in[i] = d_in[i];
    a.out = (float*)d_out; a.ws = (unsigned char*)d_ws;
#ifndef MK_ONE_LAUNCH
#define MK_ONE_LAUNCH 1
#endif
    if (MK_ONE_LAUNCH) {
        a.ph_lo = 0; a.ph_hi = N_PHASES;
        hipLaunchKernelGGL(fwd, dim3(grid), dim3(NTHREADS), LDS_BYTES, stream, a);
    } else {
        for (int p = 0; p < N_PHASES; ++p) { a.ph_lo = p; a.ph_hi = p + 1; hipLaunchKernelGGL(fwd, dim3(grid), dim3(NTHREADS), LDS_BYTES, stream, a); }
    }
}
```
